# Optimizing an MI355X kernel written in HIP

```python
import math
import jax, jax.numpy as jnp
from jax import lax
import numpy as np

D_MODEL = 2048
BATCH = 4
SEQ = 2048
DEPTH = 4
DEC_BATCH = 32
DEC_SEQ = 1
PAST_LEN = 16384
PAGE_SIZE = 128

HEAD_DIM = 64
ATTN_WIDTH = D_MODEL // 2
N_HEADS = ATTN_WIDTH // HEAD_DIM
N_KV_HEADS = N_HEADS // 4
GROUP = N_HEADS // N_KV_HEADS
Q_DIM = N_HEADS * HEAD_DIM
KV_DIM = N_KV_HEADS * HEAD_DIM
CONV_DIM = D_MODEL - ATTN_WIDTH
CONV_WIDTH = 3
MIX_DIM = Q_DIM + CONV_DIM
IN_DIM = Q_DIM + 2 * KV_DIM + 3 * CONV_DIM
WINDOW = 128
BLOCK = 128
NUM_BUCKETS = 32
MAX_DISTANCE = 128
N_META = 16
D_FF = ((8 * D_MODEL // 3 + 255) // 256) * 256
RMS_EPS = 1e-6
SCALE = HEAD_DIM ** -0.5

kernel_name = "hymba_swa_shortconv_step"


def rms_norm(x, g):
    xf = x.astype(jnp.float32)
    y = xf * lax.rsqrt(jnp.mean(xf * xf, axis=-1, keepdims=True) + RMS_EPS)
    return (y * g.astype(jnp.float32)).astype(x.dtype)


def t5_bucket(d):
    max_exact = NUM_BUCKETS // 2
    df = jnp.maximum(d, 1).astype(jnp.float32)
    large = max_exact + (jnp.log(df / max_exact) / math.log(MAX_DISTANCE / max_exact)
                         * (NUM_BUCKETS - max_exact)).astype(jnp.int32)
    large = jnp.minimum(large, NUM_BUCKETS - 1)
    return jnp.where(d < max_exact, d, large)


def rel_bias_lookup(table, d):
    b = table[t5_bucket(jnp.maximum(d, 0))]
    return jnp.transpose(b, (2, 0, 1)).reshape(N_KV_HEADS, GROUP, *d.shape).astype(jnp.float32)


def sink_softmax(s, sink):
    sk = sink.astype(jnp.float32).reshape(N_KV_HEADS, GROUP)[:, :, None, None]
    m = jnp.maximum(jnp.max(s, axis=-1, keepdims=True), sk)
    e = jnp.exp(s - m)
    return e / (jnp.sum(e, axis=-1, keepdims=True) + jnp.exp(sk - m))


def split_proj(z):
    o1 = Q_DIM
    o2 = o1 + KV_DIM
    o3 = o2 + KV_DIM
    o4 = o3 + CONV_DIM
    o5 = o4 + CONV_DIM
    return jnp.split(z, [o1, o2, o3, o4, o5], axis=-1)


def band_pattern(L):
    pad = (-L) % BLOCK
    nb = (L + pad) // BLOCK
    i = jnp.arange(BLOCK)[:, None]
    j = jnp.arange(2 * BLOCK)[None, :]
    d = BLOCK + i - j
    n = jnp.arange(nb)[:, None, None]
    k_abs = (n - 1) * BLOCK + j
    mask = (d >= 0) & (d <= WINDOW) & (k_abs >= pad)
    return d, mask


def swa_prompt(q, k, v, sink, bias, mask):
    B, L = q.shape[:2]
    pad = (-L) % BLOCK
    nb = (L + pad) // BLOCK
    qp = (jnp.pad(q, ((0, 0), (pad, 0), (0, 0))) * SCALE).reshape(
        B, nb, BLOCK, N_KV_HEADS, GROUP, HEAD_DIM)

    def band(t):
        tp = jnp.pad(t, ((0, 0), (pad, 0), (0, 0))).reshape(B, nb, BLOCK, N_KV_HEADS, HEAD_DIM)
        prev = jnp.pad(tp[:, :-1], ((0, 0), (1, 0), (0, 0), (0, 0), (0, 0)))
        return jnp.concatenate([prev, tp], axis=2)

    kk, vv = band(k), band(v)
    s = jnp.einsum('bnqkgd,bnskd->bnkgqs', qp, kk).astype(jnp.float32) + bias
    s = jnp.where(mask[None, :, None, None], s, -jnp.inf)
    p = sink_softmax(s, sink).astype(v.dtype)
    o = jnp.einsum('bnkgqs,bnskd->bnqkgd', p, vv).reshape(B, nb * BLOCK, Q_DIM)
    return o[:, pad:]


def swa_sample(q, k, v, kbuf, vbuf, sink, table):
    DB, T = q.shape[:2]
    WB = kbuf.shape[1]
    qs = (q * SCALE).reshape(DB, T, N_KV_HEADS, GROUP, HEAD_DIM)
    kk = jnp.concatenate([kbuf.astype(k.dtype), k.reshape(DB, T, N_KV_HEADS, HEAD_DIM)], axis=1)
    vv = jnp.concatenate([vbuf.astype(v.dtype), v.reshape(DB, T, N_KV_HEADS, HEAD_DIM)], axis=1)
    d = (WB + jnp.arange(T))[:, None] - jnp.arange(WB + T)[None, :]
    mask = (d >= 0) & (d <= WINDOW)
    s = jnp.einsum('btkgd,bskd->bkgts', qs, kk).astype(jnp.float32) + rel_bias_lookup(table, d)
    s = jnp.where(mask, s, -jnp.inf)
    p = sink_softmax(s, sink).astype(v.dtype)
    o = jnp.einsum('bkgts,bskd->btkgd', p, vv).reshape(DB, T, Q_DIM)
    return o, kk[:, -WB:], vv[:, -WB:]


def causal_conv(u_ext, w, T):
    return sum(w[i] * u_ext[:, i:i + T] for i in range(CONV_WIDTH))


def swiglu(x, wg, wu, wd):
    return (jax.nn.silu(x @ wg) * (x @ wu)) @ wd


def setup_inputs(seed: int = 0) -> dict:
    key = jax.random.key(seed)
    ks = jax.random.split(key, 20)
    W_BUF = min(WINDOW, PAST_LEN)
    nrm = jax.random.normal
    return {
        "x_prompt": nrm(ks[0], (BATCH, SEQ, D_MODEL), jnp.float32),
        "x_sample": nrm(ks[1], (DEC_BATCH, DEC_SEQ, D_MODEL), jnp.float32),
        "cache_k": nrm(ks[2], (DEPTH, DEC_BATCH, W_BUF, N_KV_HEADS, HEAD_DIM), jnp.float32),
        "cache_v": nrm(ks[3], (DEPTH, DEC_BATCH, W_BUF, N_KV_HEADS, HEAD_DIM), jnp.float32),
        "state_conv": nrm(ks[4], (DEPTH, DEC_BATCH, CONV_WIDTH - 1, CONV_DIM), jnp.float32),
        "meta_tokens": nrm(ks[5], (N_META, D_MODEL), jnp.float32),
        "rel_bias": 0.5 * nrm(ks[6], (NUM_BUCKETS, N_HEADS), jnp.float32),
        "w_in": nrm(ks[7], (DEPTH, D_MODEL, IN_DIM), jnp.float32) * D_MODEL ** -0.5,
        "conv_w": nrm(ks[8], (DEPTH, CONV_WIDTH, CONV_DIM), jnp.float32) * CONV_WIDTH ** -0.5,
        "attn_sinks": nrm(ks[9], (DEPTH, N_HEADS), jnp.float32),
        "w_out": nrm(ks[10], (DEPTH, MIX_DIM, D_MODEL), jnp.float32) * MIX_DIM ** -0.5,
        "norm_pre_mix": 1.0 + 0.05 * nrm(ks[11], (DEPTH, D_MODEL), jnp.float32),
        "norm_post_mix": 1.0 + 0.05 * nrm(ks[12], (DEPTH, D_MODEL), jnp.float32),
        "norm_pre_ffn": 1.0 + 0.05 * nrm(ks[13], (DEPTH, D_MODEL), jnp.float32),
        "norm_post_ffn": 1.0 + 0.05 * nrm(ks[14], (DEPTH, D_MODEL), jnp.float32),
        "w_gate": nrm(ks[15], (DEPTH, D_MODEL, D_FF), jnp.float32) * D_MODEL ** -0.5,
        "w_up": nrm(ks[16], (DEPTH, D_MODEL, D_FF), jnp.float32) * D_MODEL ** -0.5,
        "w_down": nrm(ks[17], (DEPTH, D_FF, D_MODEL), jnp.float32) * D_FF ** -0.5,
    }


def reference(x_prompt, x_sample, cache_k, cache_v, state_conv, meta_tokens, rel_bias,
              w_in, conv_w, attn_sinks, w_out, norm_pre_mix, norm_post_mix,
              norm_pre_ffn, norm_post_ffn, w_gate, w_up, w_down):
    B = x_prompt.shape[0]
    meta = jnp.broadcast_to(meta_tokens[None].astype(x_prompt.dtype), (B, N_META, D_MODEL))
    hp = jnp.concatenate([meta, x_prompt], axis=1)
    hs = x_sample
    L = hp.shape[1]
    T = hs.shape[1]
    d_band, mask_band = band_pattern(L)
    bias_band = rel_bias_lookup(rel_bias, d_band)

    kp_l, vp_l, cp_l, ks_l, vs_l, cs_l = [], [], [], [], [], []
    for l in range(DEPTH):
        xn = rms_norm(hp, norm_pre_mix[l])
        q, k, v, gb, gc, hc = split_proj(xn @ w_in[l])
        a = swa_prompt(q, k, v, attn_sinks[l], bias_band, mask_band)
        u = gc * hc
        u_ext = jnp.pad(u, ((0, 0), (CONV_WIDTH - 1, 0), (0, 0)))
        c = gb * causal_conv(u_ext, conv_w[l], L)
        mix = jnp.concatenate([a, c], axis=-1) @ w_out[l]
        hp = hp + rms_norm(mix, norm_post_mix[l])
        kp_l.append(k.reshape(B, L, N_KV_HEADS, HEAD_DIM)[:, -WINDOW:])
        vp_l.append(v.reshape(B, L, N_KV_HEADS, HEAD_DIM)[:, -WINDOW:])
        cp_l.append(u[:, -(CONV_WIDTH - 1):])
        hp = hp + rms_norm(swiglu(rms_norm(hp, norm_pre_ffn[l]), w_gate[l], w_up[l], w_down[l]),
                           norm_post_ffn[l])

        xn = rms_norm(hs, norm_pre_mix[l])
        q, k, v, gb, gc, hc = split_proj(xn @ w_in[l])
        a, kb_new, vb_new = swa_sample(q, k, v, cache_k[l], cache_v[l], attn_sinks[l], rel_bias)
        u = gc * hc
        u_ext = jnp.concatenate([state_conv[l].astype(u.dtype), u], axis=1)
        c = gb * causal_conv(u_ext, conv_w[l], T)
        mix = jnp.concatenate([a, c], axis=-1) @ w_out[l]
        hs = hs + rms_norm(mix, norm_post_mix[l])
        ks_l.append(kb_new)
        vs_l.append(vb_new)
        cs_l.append(u_ext[:, -(CONV_WIDTH - 1):])
        hs = hs + rms_norm(swiglu(rms_norm(hs, norm_pre_ffn[l]), w_gate[l], w_up[l], w_down[l]),
                           norm_post_ffn[l])

    y_prompt = hp[:, N_META:]
    y_sample = hs
    k_prompt = jnp.stack(kp_l)
    v_prompt = jnp.stack(vp_l)
    conv_prompt = jnp.stack(cp_l)
    k_sample = jnp.stack(ks_l)
    v_sample = jnp.stack(vs_l)
    conv_sample = jnp.stack(cs_l)
    return (y_prompt, y_sample, k_prompt, v_prompt, conv_prompt, k_sample, v_sample, conv_sample)
```

```cpp
#include <hip/hip_runtime.h>
#include <hip/hip_cooperative_groups.h>
#include <cstdio>
#include <cstdint>
namespace cg = cooperative_groups;

#define LAS __attribute__((address_space(3)))
typedef unsigned short bf16_t;
typedef short bf16x8 __attribute__((ext_vector_type(8)));
typedef float f32x4 __attribute__((ext_vector_type(4)));
typedef float f32x2 __attribute__((ext_vector_type(2)));
typedef unsigned u32x4 __attribute__((ext_vector_type(4)));
typedef unsigned u32x2 __attribute__((ext_vector_type(2)));

constexpr int D = 2048, NBATCH = 4, SEQ = 2048, NMETA = 16, LSEQ = SEQ + NMETA, DEPTH = 4, DB = 32, WIN = 128;
constexpr int MPROMPT = NBATCH * LSEQ;
constexpr int MREAL = MPROMPT + DB;
constexpr int MP = 8448;
constexpr int INDIM = 4608, DFF = 5632, NGU = 2 * DFF, CDIM = 1024;
constexpr int ZQ = 0, ZK = 1024, ZV = 1280, ZGB = 1536, ZGC = 2560, ZHC = 3584;
constexpr float RMS_EPS = 1e-6f;
constexpr int NHEADS = 16;

constexpr size_t O_YP = 0, O_YS = 16777216, O_KP = 16842752, O_VP = 17367040, O_CP = 17891328, O_KS = 17924096, O_VS = 22118400, O_CS = 26312704;

constexpr size_t SZ_WIN = (size_t)INDIM * D * 2, SZ_WOUT = (size_t)D * D * 2, SZ_WGU = (size_t)NGU * D * 2, SZ_WDN = (size_t)D * DFF * 2;
constexpr size_t WS_WIN = 0;
constexpr size_t WS_WOUT = WS_WIN + DEPTH * SZ_WIN;
constexpr size_t WS_WGU = WS_WOUT + DEPTH * SZ_WOUT;
constexpr size_t WS_WDN = WS_WGU + DEPTH * SZ_WGU;
constexpr size_t WS_ZACT = WS_WDN + DEPTH * SZ_WDN;
constexpr size_t WS_MIXIN = WS_ZACT + (size_t)MP * DFF * 2;
constexpr size_t WS_MIXB = WS_MIXIN + (size_t)MP * D * 2;
constexpr size_t WS_H = WS_MIXB + (size_t)MP * D * 2;
constexpr size_t WS_HB = WS_H + (size_t)MP * D * 4;
constexpr size_t WS_RS = WS_HB + (size_t)MP * D * 2;
constexpr size_t WS_END = WS_RS + (size_t)MP * 4;

constexpr int RING_BYTES = 131072, BIAS_OFF = RING_BYTES, LDS_BYTES = 147456;
constexpr int BIAS_STRIDE = 132;

__device__ __forceinline__ unsigned cvt_pk_bf16(float lo, float hi) { unsigned r; asm volatile("v_cvt_pk_bf16_f32 %0, %1, %2" : "=v"(r) : "v"(lo), "v"(hi)); return r; }
__device__ __forceinline__ float bf_lo(unsigned u) { return __uint_as_float(u << 16); }
__device__ __forceinline__ float bf_hi(unsigned u) { return __uint_as_float(u & 0xffff0000u); }
__device__ __forceinline__ float wave_sum(float v) {
#pragma unroll
    for (int o = 1; o < 64; o <<= 1) v += __shfl_xor(v, o);
    return v;
}
__device__ __forceinline__ float wave_max(float v) {
#pragma unroll
    for (int o = 1; o < 64; o <<= 1) v = fmaxf(v, __shfl_xor(v, o));
    return v;
}
#define LDS_WAIT() asm volatile("s_waitcnt lgkmcnt(0)" ::: "memory")

namespace pg8 {
constexpr int BM = 256, BK = 64, HALF = 128, HTB = HALF * BK * 2, STAGE_BYTES = 8 * HTB, NXCD = 8, WGM = 8;
__host__ __device__ __forceinline__ int lds_byte(int r, int c) { const int st = (r >> 4) * 2 + (c >> 5), rr = r & 15, cc = c & 31, ob = rr * 64 + cc * 2; return st * 1024 + (ob ^ (((ob >> 9) & 1) << 5)); }
__host__ __device__ __forceinline__ void stage_rc(int b, int& R, int& C) { const int st = b / 1024, sb = b % 1024, swz = sb ^ (((sb >> 9) & 1) << 5); R = (st >> 1) * 16 + swz / 64; C = (st & 1) * 32 + (swz % 64) / 2; }
__host__ __device__ __forceinline__ int perm32(int rho) { const int n = rho >> 4, i = rho & 15; return 8 * (i >> 2) + 4 * n + (i & 3); }

struct Unit { int pm, pn; };
struct Gemm { const bf16_t* A; const bf16_t* Bt; int M, N, K; };

struct StaticOrder {
    int nM, nN, nwg, G, c;
    __host__ __device__ void init(int M, int N, int G_, int c_) { nM = M / BM; nN = N / BM; nwg = nM * nN; G = G_; c = c_; }
    __host__ __device__ bool next(int i, Unit& u) const {
        const long L = (long)i * G + c; if (L >= nwg) return false;
        int wgid = (int)L; { const int q = nwg / NXCD, r = nwg % NXCD, xcd = wgid % NXCD, off = wgid / NXCD; wgid = (xcd < r ? xcd * (q + 1) : r * (q + 1) + (xcd - r) * q) + off; }
        const int nig = WGM * nN, gid = wgid / nig, fm = gid * WGM, gsz = (nM - fm) < WGM ? (nM - fm) : WGM;
        u.pm = fm + ((wgid % nig) % gsz); u.pn = (wgid % nig) / gsz; return true;
    }
};

template <int MODE> struct Epi {
    static constexpr bool PERM = true;
    bf16_t* O; int ldc; const float* rs;
    __device__ __forceinline__ void operator()(const f32x4 (&acc)[2][2][4][2], const Unit& u, int wr, int wc, int fr, int fq) const {
        const int row0 = u.pm * BM + wr * 64 + fr;
        if constexpr (MODE == 0) {
            const int col0 = u.pn * BM + wc * 32 + 8 * fq;
#pragma unroll
            for (int ai = 0; ai < 2; ++ai)
#pragma unroll
                for (int m = 0; m < 4; ++m) {
                    const int row = row0 + ai * HALF + m * 16;
                    const float s = rs ? rs[row] : 1.f;
                    bf16_t* rowp = O + (size_t)row * ldc + col0;
#pragma unroll
                    for (int bj = 0; bj < 2; ++bj) {
                        const f32x4 v0 = acc[ai][bj][m][0] * s, v1 = acc[ai][bj][m][1] * s;
                        u32x4 w; w.x = cvt_pk_bf16(v0[0], v0[1]); w.y = cvt_pk_bf16(v0[2], v0[3]); w.z = cvt_pk_bf16(v1[0], v1[1]); w.w = cvt_pk_bf16(v1[2], v1[3]);
                        *(u32x4*)(rowp + bj * HALF) = w;
                    }
                }
        } else {
            const int col0 = u.pn * HALF + wc * 32 + 8 * fq;
#pragma unroll
            for (int ai = 0; ai < 2; ++ai)
#pragma unroll
                for (int m = 0; m < 4; ++m) {
                    const int row = row0 + ai * HALF + m * 16;
                    const float s = rs[row];
                    float o[8];
#pragma unroll
                    for (int n = 0; n < 2; ++n)
#pragma unroll
                        for (int j = 0; j < 4; ++j) {
                            const float g = acc[ai][0][m][n][j] * s, up = acc[ai][1][m][n][j] * s;
                            o[n * 4 + j] = g * __builtin_amdgcn_rcpf(1.f + __expf(-g)) * up;
                        }
                    u32x4 w; w.x = cvt_pk_bf16(o[0], o[1]); w.y = cvt_pk_bf16(o[2], o[3]); w.z = cvt_pk_bf16(o[4], o[5]); w.w = cvt_pk_bf16(o[6], o[7]);
                    *(u32x4*)(O + (size_t)row * ldc + col0) = w;
                }
        }
    }
};

template <int K, class EpiT, class Sched>
__device__ __forceinline__ void gemm_phase(LAS unsigned char* lds, const Gemm g, const Sched& S, const EpiT& E) {
    int tid_ = threadIdx.x; asm volatile("" : "+v"(tid_));
    const int tid = tid_, wid = __builtin_amdgcn_readfirstlane(tid >> 6), lane = tid & 63, wr = wid >> 2, wc = wid & 3, fr = lane & 15, fq = lane >> 4;
    constexpr int nt = K / BK;
    unsigned voffA[2], voffB[2];
#pragma unroll
    for (int i = 0; i < 2; ++i) { int R, C; stage_rc(tid * 16 + i * 8192, R, C); const int Rb = EpiT::PERM ? ((R & ~31) + perm32(R & 31)) : R;
        voffA[i] = (unsigned)(R * K + C) * 2u; voffB[i] = (unsigned)(Rb * K + C) * 2u; }
    const size_t kstep = (size_t)(BK * 2);
    const size_t hstep = (size_t)HALF * K * 2;
    const size_t tstep = 2 * hstep;
    const unsigned ldsw = (unsigned)wid * 1024u;
    const int aoff = lds_byte(wr * 64 + fr, fq * 8), boff = lds_byte(wc * 32 + fr, fq * 8);
#define PG8_SA(b, h) (((b) * 2 + (h)) * HTB)
#define PG8_SB(b, h) ((4 + (b) * 2 + (h)) * HTB)
#define PG8_STAGE(bufoff, gbase, voff) do { _Pragma("unroll") for (int _i = 0; _i < 2; ++_i) \
        __builtin_amdgcn_global_load_lds((const unsigned*)((const char*)(gbase) + (voff)[_i]), (LAS unsigned*)(lds + (bufoff) + ldsw + _i * 8192), 16, 0, 0); } while (0)
#define PG8_LDA(dst, b, h) do { _Pragma("unroll") for (int m = 0; m < 4; ++m) _Pragma("unroll") for (int k = 0; k < 2; ++k) dst[m][k] = *(const LAS bf16x8*)(lds + PG8_SA(b, h) + aoff + m * 2048 + k * 1024); } while (0)
#define PG8_LDB(dst, b, h) do { _Pragma("unroll") for (int n = 0; n < 2; ++n) _Pragma("unroll") for (int k = 0; k < 2; ++k) dst[n][k] = *(const LAS bf16x8*)(lds + PG8_SB(b, h) + boff + n * 2048 + k * 1024); } while (0)
#define PG8_MMA(ai, bj, At, Bt) do { __builtin_amdgcn_s_setprio(1); _Pragma("unroll") for (int m = 0; m < 4; ++m) _Pragma("unroll") for (int n = 0; n < 2; ++n) _Pragma("unroll") for (int k = 0; k < 2; ++k) \
        acc[ai][bj][m][n] = __builtin_amdgcn_mfma_f32_16x16x32_bf16(Bt[n][k], At[m][k], acc[ai][bj][m][n], 0, 0, 0); __builtin_amdgcn_s_setprio(0); } while (0)
#define PG8_WAIT_V(n) asm volatile("s_waitcnt vmcnt(" #n ")" ::: "memory")
#define PG8_WAIT_L(n) asm volatile("s_waitcnt lgkmcnt(" #n ")" ::: "memory")
#define PG8_BAR __builtin_amdgcn_s_barrier()
#define PG8_SCHED __builtin_amdgcn_sched_barrier(0)
    Unit cur, nxt; int ui = 0;
    if (!S.next(0, cur)) return;
    f32x4 acc[2][2][4][2];
#pragma unroll
    for (int a = 0; a < 2; ++a)
#pragma unroll
        for (int b = 0; b < 2; ++b)
#pragma unroll
            for (int m = 0; m < 4; ++m)
#pragma unroll
                for (int n = 0; n < 2; ++n) acc[a][b][m][n] = (f32x4){0.f, 0.f, 0.f, 0.f};
    bf16x8 At[4][2], B0[2][2], B1[2][2];
    const char* cA = (const char*)g.A + (size_t)cur.pm * tstep; const char* cB = (const char*)g.Bt + (size_t)cur.pn * tstep;
    PG8_STAGE(PG8_SB(0, 0), cB, voffB); PG8_STAGE(PG8_SB(0, 1), cB + hstep, voffB); PG8_STAGE(PG8_SA(0, 0), cA, voffA); PG8_STAGE(PG8_SA(0, 1), cA + hstep, voffA);
    if (wr == 1) PG8_BAR;
    PG8_WAIT_V(2); PG8_BAR;
    PG8_STAGE(PG8_SB(1, 0), cB + kstep, voffB); PG8_STAGE(PG8_SA(1, 0), cA + kstep, voffA); PG8_STAGE(PG8_SB(1, 1), cB + hstep + kstep, voffB);
    PG8_WAIT_V(6); PG8_BAR;
    for (;;) {
        const bool has_next = S.next(ui + 1, nxt);
        const char* nA = has_next ? (const char*)g.A + (size_t)nxt.pm * tstep : cA; const char* nB = has_next ? (const char*)g.Bt + (size_t)nxt.pn * tstep : cB;
        for (int t = 0; t < nt; t += 2) {
            const bool last = (t == nt - 2);
            const char* a1 = cA + (size_t)(t + 1) * kstep;
            const char* a2 = last ? nA : cA + (size_t)(t + 2) * kstep; const char* b2 = last ? nB : cB + (size_t)(t + 2) * kstep;
            const char* a3 = a2 + kstep; const char* b3 = b2 + kstep;
            PG8_LDB(B0, 0, 0); PG8_LDB(B1, 0, 1); PG8_SCHED; PG8_LDA(At, 0, 0); PG8_STAGE(PG8_SA(1, 1), a1 + hstep, voffA);
            PG8_WAIT_V(8); PG8_WAIT_L(0); PG8_BAR; PG8_MMA(0, 0, At, B0); PG8_MMA(0, 1, At, B1); PG8_BAR; PG8_SCHED;
            PG8_LDA(At, 0, 1); PG8_STAGE(PG8_SB(0, 0), b2, voffB); PG8_STAGE(PG8_SB(0, 1), b2 + hstep, voffB); PG8_STAGE(PG8_SA(0, 0), a2, voffA);
            PG8_WAIT_V(8); PG8_WAIT_L(0); PG8_BAR; PG8_MMA(1, 0, At, B0); PG8_MMA(1, 1, At, B1); PG8_BAR; PG8_SCHED;
            PG8_LDB(B0, 1, 0); PG8_LDB(B1, 1, 1); PG8_SCHED; PG8_LDA(At, 1, 0); PG8_STAGE(PG8_SA(0, 1), a2 + hstep, voffA);
            PG8_WAIT_V(8); PG8_WAIT_L(0); PG8_BAR; PG8_MMA(0, 0, At, B0); PG8_MMA(0, 1, At, B1); PG8_BAR; PG8_SCHED;
            PG8_LDA(At, 1, 1); PG8_STAGE(PG8_SB(1, 0), b3, voffB); PG8_STAGE(PG8_SB(1, 1), b3 + hstep, voffB); PG8_STAGE(PG8_SA(1, 0), a3, voffA);
            PG8_WAIT_V(8); PG8_WAIT_L(0); PG8_BAR; PG8_MMA(1, 0, At, B0); PG8_MMA(1, 1, At, B1); PG8_BAR; PG8_SCHED;
        }
        if (wr == 0) PG8_BAR;
        E(acc, cur, wr, wc, fr, fq);
        if (!has_next) break;
#pragma unroll
        for (int a = 0; a < 2; ++a)
#pragma unroll
            for (int b = 0; b < 2; ++b)
#pragma unroll
                for (int m = 0; m < 4; ++m)
#pragma unroll
                    for (int n = 0; n < 2; ++n) acc[a][b][m][n] = (f32x4){0.f, 0.f, 0.f, 0.f};
        cur = nxt; cA = nA; cB = nB; ++ui;
        if (wr == 1) PG8_BAR;
    }
    PG8_WAIT_V(0);
    PG8_BAR;
#undef PG8_SA
#undef PG8_SB
#undef PG8_STAGE
#undef PG8_LDA
#undef PG8_LDB
#undef PG8_MMA
#undef PG8_WAIT_V
#undef PG8_WAIT_L
#undef PG8_BAR
#undef PG8_SCHED
}
}

struct Params {
    const float *x_prompt, *x_sample, *cache_k, *cache_v, *state_conv, *meta, *rel_bias, *w_in, *conv_w, *sinks, *w_out,
        *n_pre_mix, *n_post_mix, *n_pre_ffn, *n_post_ffn, *w_gate, *w_up, *w_down;
    float* out; unsigned char* ws;
};

__device__ __forceinline__ void transpose_item(const float* __restrict__ W, int K, int N, bf16_t* WT, const float* __restrict__ gain, int mode, LAS float* scr, int item, int lane) {
    const int nblk = N / 32, kb = item / nblk, nb = item % nblk, k0 = 64 * kb, n0 = 32 * nb;
#pragma unroll 8
    for (int i = 0; i < 32; ++i) { const int kk = 2 * i + (lane >> 5); float w = W[(size_t)(k0 + kk) * N + n0 + (lane & 31)]; if (gain) w *= gain[k0 + kk]; scr[kk * 33 + (lane & 31)] = w; }
    LDS_WAIT(); asm volatile("" ::: "memory");
    const int c = lane & 7;
    int rbase = n0;
    if (mode) rbase = ((n0 >> 7) << 8) + (n0 & 127) + (mode == 2 ? 128 : 0);
#pragma unroll
    for (int j = 0; j < 4; ++j) { const int n = (lane >> 3) + 8 * j; const LAS float* s = scr + (8 * c) * 33 + n;
        u32x4 o; o.x = cvt_pk_bf16(s[0 * 33], s[1 * 33]); o.y = cvt_pk_bf16(s[2 * 33], s[3 * 33]); o.z = cvt_pk_bf16(s[4 * 33], s[5 * 33]); o.w = cvt_pk_bf16(s[6 * 33], s[7 * 33]);
        *(u32x4*)(WT + (size_t)(rbase + n) * K + k0 + 8 * c) = o; }
    LDS_WAIT(); asm volatile("" ::: "memory");
}

__device__ __forceinline__ void prologue(const Params& p, LAS unsigned char* lds, int wid, int lane) {
    LAS float* scr = (LAS float*)(lds + wid * 16384);
    const int gw = blockIdx.x * 8 + wid, NGW = gridDim.x * 8;
    constexpr int I_IN = (D / 64) * (INDIM / 32), I_OUT = (D / 64) * (D / 32), I_G = (D / 64) * (DFF / 32), I_DN = (DFF / 64) * (D / 32);
    constexpr int I_LAYER = I_IN + I_OUT + 2 * I_G + I_DN;
    bf16_t* win = (bf16_t*)(p.ws + WS_WIN); bf16_t* wout = (bf16_t*)(p.ws + WS_WOUT); bf16_t* wgu = (bf16_t*)(p.ws + WS_WGU); bf16_t* wdn = (bf16_t*)(p.ws + WS_WDN);
    for (int it = gw; it < DEPTH * I_LAYER; it += NGW) {
        const int l = it / I_LAYER; int r = it % I_LAYER;
        if (r < I_IN) { transpose_item(p.w_in + (size_t)l * D * INDIM, D, INDIM, win + (size_t)l * INDIM * D, p.n_pre_mix + l * D, 0, scr, r, lane); continue; } r -= I_IN;
        if (r < I_OUT) { transpose_item(p.w_out + (size_t)l * D * D, D, D, wout + (size_t)l * D * D, nullptr, 0, scr, r, lane); continue; } r -= I_OUT;
        if (r < I_G) { transpose_item(p.w_gate + (size_t)l * D * DFF, D, DFF, wgu + (size_t)l * NGU * D, p.n_pre_ffn + l * D, 1, scr, r, lane); continue; } r -= I_G;
        if (r < I_G) { transpose_item(p.w_up + (size_t)l * D * DFF, D, DFF, wgu + (size_t)l * NGU * D, p.n_pre_ffn + l * D, 2, scr, r, lane); continue; } r -= I_G;
        transpose_item(p.w_down + (size_t)l * DFF * D, DFF, D, wdn + (size_t)l * D * DFF, nullptr, 0, scr, r, lane);
    }
    float* H = (float*)(p.ws + WS_H); bf16_t* HB = (bf16_t*)(p.ws + WS_HB); float* RS = (float*)(p.ws + WS_RS);
    for (int m = gw; m < MREAL; m += NGW) {
        const float* src;
        if (m < MPROMPT) { const int b = m / LSEQ, t = m % LSEQ; src = t < NMETA ? p.meta + (size_t)t * D : p.x_prompt + ((size_t)b * SEQ + (t - NMETA)) * D; }
        else src = p.x_sample + (size_t)(m - MPROMPT) * D;
        const f32x4* xr = (const f32x4*)src + lane; f32x4* hr = (f32x4*)(H + (size_t)m * D) + lane; u32x2* hb = (u32x2*)(HB + (size_t)m * D) + lane;
        float ss = 0.f;
#pragma unroll
        for (int j = 0; j < 8; ++j) { const f32x4 v = xr[64 * j]; ss += (v.x * v.x + v.y * v.y) + (v.z * v.z + v.w * v.w); hr[64 * j] = v; u32x2 w; w.x = cvt_pk_bf16(v.x, v.y); w.y = cvt_pk_bf16(v.z, v.w); hb[64 * j] = w; }
        ss = wave_sum(ss);
        if (lane == 0) RS[m] = 1.f / sqrtf(ss * (1.f / D) + RMS_EPS);
    }
}

__device__ __forceinline__ void postnorm(const Params& p, const float* __restrict__ g, bool last, int wid, int lane) {
    const int gw = blockIdx.x * 8 + wid, NGW = gridDim.x * 8;
    float* H = (float*)(p.ws + WS_H); bf16_t* HB = (bf16_t*)(p.ws + WS_HB); float* RS = (float*)(p.ws + WS_RS); const bf16_t* MIXB = (const bf16_t*)(p.ws + WS_MIXB);
    for (int m = gw; m < MREAL; m += NGW) {
        const u32x2* mr = (const u32x2*)(MIXB + (size_t)m * D) + lane;
        f32x4 mv[8]; float ss = 0.f;
#pragma unroll
        for (int j = 0; j < 8; ++j) { const u32x2 w = mr[64 * j]; mv[j] = (f32x4){bf_lo(w.x), bf_hi(w.x), bf_lo(w.y), bf_hi(w.y)}; ss += (mv[j].x * mv[j].x + mv[j].y * mv[j].y) + (mv[j].z * mv[j].z + mv[j].w * mv[j].w); }
        ss = wave_sum(ss);
        const float r = 1.f / sqrtf(ss * (1.f / D) + RMS_EPS);
        f32x4* hr = (f32x4*)(H + (size_t)m * D) + lane; u32x2* hb = (u32x2*)(HB + (size_t)m * D) + lane; const f32x4* gr = (const f32x4*)g + lane;
        float* yrow = nullptr;
        if (last) { if (m < MPROMPT) { const int b = m / LSEQ, t = m % LSEQ; if (t >= NMETA) yrow = p.out + O_YP + ((size_t)b * SEQ + (t - NMETA)) * D; } else yrow = p.out + O_YS + (size_t)(m - MPROMPT) * D; }
        float s2 = 0.f;
#pragma unroll
        for (int j = 0; j < 8; ++j) {
            const f32x4 hv = hr[64 * j] + mv[j] * r * gr[64 * j];
            s2 += (hv.x * hv.x + hv.y * hv.y) + (hv.z * hv.z + hv.w * hv.w);
            hr[64 * j] = hv; u32x2 w; w.x = cvt_pk_bf16(hv.x, hv.y); w.y = cvt_pk_bf16(hv.z, hv.w); hb[64 * j] = w;
            if (yrow) ((f32x4*)yrow)[lane + 64 * j] = hv;
        }
        s2 = wave_sum(s2);
        if (lane == 0) RS[m] = 1.f / sqrtf(s2 * (1.f / D) + RMS_EPS);
    }
}

constexpr int AT_KR = 208, AT_KS = 72, AT_VS = 216, AT_PS = 168;
constexpr int AT_K_OFF = 0, AT_V_OFF = AT_KR * AT_KS * 2  , AT_P_OFF = AT_V_OFF + 64 * AT_VS * 2  , AT_P_WAVE = 16 * AT_PS * 2  ;

__device__ __forceinline__ void attn_prompt_unit(LAS unsigned char* lds, int b, int kvh, int qt, const bf16_t* __restrict__ z, bf16_t* mixin, const float* __restrict__ sinks, int tid, int wid, int lane) {
    LAS bf16_t* Ks = (LAS bf16_t*)(lds + AT_K_OFF);
    LAS bf16_t* Vt = (LAS bf16_t*)(lds + AT_V_OFF);
    LAS bf16_t* Pw = (LAS bf16_t*)(lds + AT_P_OFF + wid * AT_P_WAVE);
    const LAS float* biasL = (const LAS float*)(lds + BIAS_OFF);
    const int q0 = qt * 64, rowb = b * LSEQ;
    for (int c = tid; c < AT_KR * 8; c += 512) {
        const int kr = c >> 3, ch = c & 7; int t = q0 - 144 + kr; t = t < 0 ? 0 : (t > LSEQ - 1 ? LSEQ - 1 : t);
        const bf16_t* src = z + (size_t)(rowb + t) * INDIM + kvh * 64 + ch * 8;
        const u32x4 kv = *(const u32x4*)(src + ZK);
        const u32x4 vv = *(const u32x4*)(src + ZV);
        *(LAS u32x4*)(Ks + kr * AT_KS + ch * 8) = kv;
        LAS bf16_t* vd = Vt + (ch * 8) * AT_VS + kr;
        vd[0 * AT_VS] = (bf16_t)(vv.x & 0xffffu); vd[1 * AT_VS] = (bf16_t)(vv.x >> 16);
        vd[2 * AT_VS] = (bf16_t)(vv.y & 0xffffu); vd[3 * AT_VS] = (bf16_t)(vv.y >> 16);
        vd[4 * AT_VS] = (bf16_t)(vv.z & 0xffffu); vd[5 * AT_VS] = (bf16_t)(vv.z >> 16);
        vd[6 * AT_VS] = (bf16_t)(vv.w & 0xffffu); vd[7 * AT_VS] = (bf16_t)(vv.w >> 16);
    }
    __syncthreads();
    const int h = kvh * 4 + (wid & 3), i16 = lane & 15, g = lane >> 4;
    const float sink = sinks[h];
#pragma unroll 1
    for (int tile = 0; tile < 2; ++tile) {
        const int tq0 = q0 + (wid >> 2) * 32 + tile * 16;
        if (tq0 >= LSEQ) continue;
        const int koff = tq0 - q0;
        const int t = tq0 + i16; const int tq = t > LSEQ - 1 ? LSEQ - 1 : t;
        const bf16_t* qp = z + (size_t)(rowb + tq) * INDIM + ZQ + h * 64 + 8 * g;
        const bf16x8 qf0 = *(const bf16x8*)qp, qf1 = *(const bf16x8*)(qp + 32);
        f32x4 s[10];
#pragma unroll
        for (int nt = 0; nt < 10; ++nt) {
            const LAS bf16_t* kp = Ks + (koff + nt * 16 + i16) * AT_KS + 8 * g;
            const bf16x8 k0 = *(const LAS bf16x8*)kp, k1 = *(const LAS bf16x8*)(kp + 32);
            f32x4 a = (f32x4){0.f, 0.f, 0.f, 0.f};
            a = __builtin_amdgcn_mfma_f32_16x16x32_bf16(k0, qf0, a, 0, 0, 0);
            a = __builtin_amdgcn_mfma_f32_16x16x32_bf16(k1, qf1, a, 0, 0, 0);
            s[nt] = a;
        }
        float mx = sink;
#pragma unroll
        for (int nt = 0; nt < 10; ++nt)
#pragma unroll
            for (int r = 0; r < 4; ++r) {
                const int kk = nt * 16 + 4 * g + r; const int dist = 144 + i16 - kk; const int tk = tq0 - 144 + kk;
                const bool ok = dist >= 0 && dist <= WIN && tk >= 0;
                const int dc = dist < 0 ? 0 : (dist > WIN ? WIN : dist);
                const float v = ok ? s[nt][r] * 0.125f + biasL[h * BIAS_STRIDE + dc] : -INFINITY;
                s[nt][r] = v; mx = fmaxf(mx, v);
            }
        mx = fmaxf(mx, __shfl_xor(mx, 16)); mx = fmaxf(mx, __shfl_xor(mx, 32));
        float sum = 0.f;
#pragma unroll
        for (int nt = 0; nt < 10; ++nt) {
            const float e0 = __expf(s[nt][0] - mx), e1 = __expf(s[nt][1] - mx), e2 = __expf(s[nt][2] - mx), e3 = __expf(s[nt][3] - mx);
            sum += (e0 + e1) + (e2 + e3);
            u32x2 w; w.x = cvt_pk_bf16(e0, e1); w.y = cvt_pk_bf16(e2, e3);
            *(LAS u32x2*)(Pw + i16 * AT_PS + nt * 16 + 4 * g) = w;
        }
        sum += __shfl_xor(sum, 16); sum += __shfl_xor(sum, 32);
        const float inv = 1.f / (sum + __expf(sink - mx));
        LDS_WAIT(); __builtin_amdgcn_wave_barrier();
        f32x4 o[4];
#pragma unroll
        for (int dn = 0; dn < 4; ++dn) o[dn] = (f32x4){0.f, 0.f, 0.f, 0.f};
#pragma unroll
        for (int ks = 0; ks < 5; ++ks) {
            const bf16x8 pf = *(const LAS bf16x8*)(Pw + i16 * AT_PS + ks * 32 + 8 * g);
#pragma unroll
            for (int dn = 0; dn < 4; ++dn) {
                const bf16x8 vf = *(const LAS bf16x8*)(Vt + (dn * 16 + i16) * AT_VS + koff + ks * 32 + 8 * g);
                o[dn] = __builtin_amdgcn_mfma_f32_16x16x32_bf16(vf, pf, o[dn], 0, 0, 0);
            }
        }
        if (t < LSEQ) {
            bf16_t* op = mixin + (size_t)(rowb + t) * D + h * 64 + 4 * g;
#pragma unroll
            for (int dn = 0; dn < 4; ++dn) { u32x2 w; w.x = cvt_pk_bf16(o[dn][0] * inv, o[dn][1] * inv); w.y = cvt_pk_bf16(o[dn][2] * inv, o[dn][3] * inv); *(u32x2*)(op + dn * 16) = w; }
        }
        LDS_WAIT(); __builtin_amdgcn_wave_barrier();
    }
    __syncthreads();
}

__device__ __forceinline__ void attn_sample_wave(LAS unsigned char* lds, int l, int b, int h, const Params& p, const bf16_t* __restrict__ z, bf16_t* mixin, int wid, int lane) {
    LAS float* qs = (LAS float*)(lds + wid * 1024);
    LAS float* ps = qs + 64;
    const LAS float* biasL = (const LAS float*)(lds + BIAS_OFF);
    const int kvh = h >> 2;
    const bf16_t* zr = z + (size_t)(MPROMPT + b) * INDIM;
    const float qv = __uint_as_float((unsigned)zr[ZQ + h * 64 + lane] << 16) * 0.125f;
    qs[lane] = qv;
    LDS_WAIT(); __builtin_amdgcn_wave_barrier();
    const float* ck = p.cache_k + (((size_t)l * DB + b) * WIN) * 256 + kvh * 64;
    const float* cv = p.cache_v + (((size_t)l * DB + b) * WIN) * 256 + kvh * 64;
    float sc0 = 0.f, sc1 = 0.f;
    {
        const f32x4* k0 = (const f32x4*)(ck + (size_t)lane * 256); const f32x4* k1 = (const f32x4*)(ck + (size_t)(lane + 64) * 256);
#pragma unroll
        for (int d4 = 0; d4 < 16; ++d4) { const f32x4 q4 = *(const LAS f32x4*)(qs + 4 * d4); const f32x4 a = k0[d4], c = k1[d4];
            sc0 += (a.x * q4.x + a.y * q4.y) + (a.z * q4.z + a.w * q4.w); sc1 += (c.x * q4.x + c.y * q4.y) + (c.z * q4.z + c.w * q4.w); }
    }
    const float knew = __uint_as_float((unsigned)zr[ZK + kvh * 64 + lane] << 16);
    const float sc2 = wave_sum(qv * knew);
    const float sink = p.sinks[l * NHEADS + h];
    const float v0 = sc0 + biasL[h * BIAS_STRIDE + (WIN - lane)], v1 = sc1 + biasL[h * BIAS_STRIDE + (64 - lane)], v2 = sc2 + biasL[h * BIAS_STRIDE];
    float mx = wave_max(fmaxf(v0, v1)); mx = fmaxf(mx, fmaxf(v2, sink));
    const float e0 = __expf(v0 - mx), e1 = __expf(v1 - mx), e2 = __expf(v2 - mx);
    const float sum = wave_sum(e0 + e1) + e2 + __expf(sink - mx);
    ps[lane] = e0; ps[lane + 64] = e1;
    LDS_WAIT(); __builtin_amdgcn_wave_barrier();
    float o = 0.f;
#pragma unroll 8
    for (int s = 0; s < WIN; ++s) o += ps[s] * cv[(size_t)s * 256 + lane];
    o += e2 * __uint_as_float((unsigned)zr[ZV + kvh * 64 + lane] << 16);
    o /= sum;
    const unsigned ob = cvt_pk_bf16(o, o);
    mixin[(size_t)(MPROMPT + b) * D + h * 64 + lane] = (bf16_t)(ob & 0xffffu);
    LDS_WAIT(); __builtin_amdgcn_wave_barrier();
}

__device__ __forceinline__ void conv_row(int l, int m, const Params& p, const bf16_t* __restrict__ z, bf16_t* mixin, int lane) {
    const float* cw = p.conv_w + (size_t)l * 3 * CDIM;
#pragma unroll
    for (int j = 0; j < 2; ++j) {
        const int c0 = lane * 8 + 512 * j;
        const bf16_t* zr = z + (size_t)m * INDIM;
        const u32x4 gbv = *(const u32x4*)(zr + ZGB + c0), gcv = *(const u32x4*)(zr + ZGC + c0), hcv = *(const u32x4*)(zr + ZHC + c0);
        float u0[8], u1[8], u2[8], gb[8];
        const unsigned gbw[4] = {gbv.x, gbv.y, gbv.z, gbv.w}, gcw[4] = {gcv.x, gcv.y, gcv.z, gcv.w}, hcw[4] = {hcv.x, hcv.y, hcv.z, hcv.w};
#pragma unroll
        for (int i = 0; i < 4; ++i) { gb[2 * i] = bf_lo(gbw[i]); gb[2 * i + 1] = bf_hi(gbw[i]); u0[2 * i] = bf_lo(gcw[i]) * bf_lo(hcw[i]); u0[2 * i + 1] = bf_hi(gcw[i]) * bf_hi(hcw[i]); }
        if (m < MPROMPT) {
            const int b = m / LSEQ, t = m % LSEQ;
#pragma unroll
            for (int i = 0; i < 8; ++i) { u1[i] = 0.f; u2[i] = 0.f; }
            if (t >= 1) { const bf16_t* z1 = zr - INDIM; const u32x4 a = *(const u32x4*)(z1 + ZGC + c0), c = *(const u32x4*)(z1 + ZHC + c0);
                const unsigned aw[4] = {a.x, a.y, a.z, a.w}, cw4[4] = {c.x, c.y, c.z, c.w};
#pragma unroll
                for (int i = 0; i < 4; ++i) { u1[2 * i] = bf_lo(aw[i]) * bf_lo(cw4[i]); u1[2 * i + 1] = bf_hi(aw[i]) * bf_hi(cw4[i]); } }
            if (t >= 2) { const bf16_t* z2 = zr - 2 * INDIM; const u32x4 a = *(const u32x4*)(z2 + ZGC + c0), c = *(const u32x4*)(z2 + ZHC + c0);
                const unsigned aw[4] = {a.x, a.y, a.z, a.w}, cw4[4] = {c.x, c.y, c.z, c.w};
#pragma unroll
                for (int i = 0; i < 4; ++i) { u2[2 * i] = bf_lo(aw[i]) * bf_lo(cw4[i]); u2[2 * i + 1] = bf_hi(aw[i]) * bf_hi(cw4[i]); } }
            if (t >= LSEQ - 2) { float* co = p.out + O_CP + (((size_t)l * NBATCH + b) * 2 + (t - (LSEQ - 2))) * CDIM + c0;
                *(f32x4*)co = (f32x4){u0[0], u0[1], u0[2], u0[3]}; *(f32x4*)(co + 4) = (f32x4){u0[4], u0[5], u0[6], u0[7]}; }
        } else {
            const int b = m - MPROMPT;
            const float* st = p.state_conv + (((size_t)l * DB + b) * 2) * CDIM + c0;
            const f32x4 s0a = *(const f32x4*)st, s0b = *(const f32x4*)(st + 4), s1a = *(const f32x4*)(st + CDIM), s1b = *(const f32x4*)(st + CDIM + 4);
            u2[0] = s0a.x; u2[1] = s0a.y; u2[2] = s0a.z; u2[3] = s0a.w; u2[4] = s0b.x; u2[5] = s0b.y; u2[6] = s0b.z; u2[7] = s0b.w;
            u1[0] = s1a.x; u1[1] = s1a.y; u1[2] = s1a.z; u1[3] = s1a.w; u1[4] = s1b.x; u1[5] = s1b.y; u1[6] = s1b.z; u1[7] = s1b.w;
            float* co = p.out + O_CS + (((size_t)l * DB + b) * 2) * CDIM + c0;
            *(f32x4*)co = s1a; *(f32x4*)(co + 4) = s1b;
            *(f32x4*)(co + CDIM) = (f32x4){u0[0], u0[1], u0[2], u0[3]}; *(f32x4*)(co + CDIM + 4) = (f32x4){u0[4], u0[5], u0[6], u0[7]};
        }
        const f32x4 w0a = *(const f32x4*)(cw + c0), w0b = *(const f32x4*)(cw + c0 + 4), w1a = *(const f32x4*)(cw + CDIM + c0), w1b = *(const f32x4*)(cw + CDIM + c0 + 4),
                    w2a = *(const f32x4*)(cw + 2 * CDIM + c0), w2b = *(const f32x4*)(cw + 2 * CDIM + c0 + 4);
        const float w0[8] = {w0a.x, w0a.y, w0a.z, w0a.w, w0b.x, w0b.y, w0b.z, w0b.w}, w1[8] = {w1a.x, w1a.y, w1a.z, w1a.w, w1b.x, w1b.y, w1b.z, w1b.w},
                    w2[8] = {w2a.x, w2a.y, w2a.z, w2a.w, w2b.x, w2b.y, w2b.z, w2b.w};
        float r[8];
#pragma unroll
        for (int i = 0; i < 8; ++i) r[i] = gb[i] * (w0[i] * u2[i] + w1[i] * u1[i] + w2[i] * u0[i]);
        u32x4 w; w.x = cvt_pk_bf16(r[0], r[1]); w.y = cvt_pk_bf16(r[2], r[3]); w.z = cvt_pk_bf16(r[4], r[5]); w.w = cvt_pk_bf16(r[6], r[7]);
        *(u32x4*)(mixin + (size_t)m * D + 1024 + c0) = w;
    }
}

__device__ __forceinline__ void kv_prompt_row(int l, int idx, const Params& p, const bf16_t* __restrict__ z, int lane) {
    const int b = idx >> 7, w = idx & 127;
    const bf16_t* zr = z + (size_t)(b * LSEQ + (LSEQ - WIN) + w) * INDIM;
    const u32x2 kv = *(const u32x2*)(zr + ZK + 4 * lane), vv = *(const u32x2*)(zr + ZV + 4 * lane);
    const size_t o = (((size_t)l * NBATCH + b) * WIN + w) * 256 + 4 * lane;
    *(f32x4*)(p.out + O_KP + o) = (f32x4){bf_lo(kv.x), bf_hi(kv.x), bf_lo(kv.y), bf_hi(kv.y)};
    *(f32x4*)(p.out + O_VP + o) = (f32x4){bf_lo(vv.x), bf_hi(vv.x), bf_lo(vv.y), bf_hi(vv.y)};
}
__device__ __forceinline__ void kv_sample_row(int l, int idx, const Params& p, const bf16_t* __restrict__ z, int lane) {
    const int b = idx >> 7, w = idx & 127;
    const size_t o = (((size_t)l * DB + b) * WIN + w) * 256 + 4 * lane;
    f32x4 kq, vq;
    if (w < WIN - 1) { kq = *(const f32x4*)(p.cache_k + o + 256); vq = *(const f32x4*)(p.cache_v + o + 256); }
    else { const bf16_t* zr = z + (size_t)(MPROMPT + b) * INDIM; const u32x2 kv = *(const u32x2*)(zr + ZK + 4 * lane), vv = *(const u32x2*)(zr + ZV + 4 * lane);
        kq = (f32x4){bf_lo(kv.x), bf_hi(kv.x), bf_lo(kv.y), bf_hi(kv.y)}; vq = (f32x4){bf_lo(vv.x), bf_hi(vv.x), bf_lo(vv.y), bf_hi(vv.y)}; }
    *(f32x4*)(p.out + O_KS + o) = kq; *(f32x4*)(p.out + O_VS + o) = vq;
}

constexpr int NU_ATT = NBATCH * 4 * 33;
constexpr int NU_SATT = DB * 2;
constexpr int NU_CONV = (MREAL + 63) / 64;
constexpr int NU_KVP = NBATCH * WIN / 64;
constexpr int NU_KVS = DB * WIN / 64;
constexpr int NU_B = NU_ATT + NU_SATT + NU_CONV + NU_KVP + NU_KVS;

__device__ __forceinline__ void mixer_phase(const Params& p, int l, LAS unsigned char* lds, int tid, int wid, int lane) {
    const bf16_t* z = (const bf16_t*)(p.ws + WS_ZACT); bf16_t* mixin = (bf16_t*)(p.ws + WS_MIXIN);
    for (int u = blockIdx.x; u < NU_B; u += gridDim.x) {
        int r = u;
        if (r < NU_ATT) { const int qt = r % 33, bk = r / 33; attn_prompt_unit(lds, bk >> 2, bk & 3, qt, z, mixin, p.sinks + l * NHEADS, tid, wid, lane); continue; } r -= NU_ATT;
        if (r < NU_SATT) { attn_sample_wave(lds, l, r >> 1, (r & 1) * 8 + wid, p, z, mixin, wid, lane); continue; } r -= NU_SATT;
        if (r < NU_CONV) { for (int i = 0; i < 8; ++i) { const int m = r * 64 + wid * 8 + i; if (m < MREAL) conv_row(l, m, p, z, mixin, lane); } continue; } r -= NU_CONV;
        if (r < NU_KVP) { for (int i = 0; i < 8; ++i) kv_prompt_row(l, r * 64 + wid * 8 + i, p, z, lane); continue; } r -= NU_KVP;
        for (int i = 0; i < 8; ++i) kv_sample_row(l, r * 64 + wid * 8 + i, p, z, lane);
    }
}

__global__ void __launch_bounds__(512, 2) hymba_fwd(Params p) {
    extern __shared__ __attribute__((aligned(16))) unsigned char lds_raw[];
    LAS unsigned char* lds = (LAS unsigned char*)lds_raw;
    cg::grid_group grid = cg::this_grid();
    const int tid = threadIdx.x, lane = tid & 63, wid = __builtin_amdgcn_readfirstlane(tid >> 6);

    {
        LAS float* biasL = (LAS float*)(lds + BIAS_OFF);
        for (int i = tid; i < NHEADS * 129; i += 512) {
            const int h = i / 129, d = i % 129;
            int bkt;
            if (d < 16) bkt = d;
            else { const float df = (float)d; bkt = 16 + (int)(logf(df / 16.f) / logf(8.f) * 16.f); bkt = bkt > 31 ? 31 : bkt; }
            biasL[h * BIAS_STRIDE + d] = p.rel_bias[bkt * NHEADS + h];
        }
    }
    prologue(p, lds, wid, lane);
    grid.sync();

    bf16_t* ZACT = (bf16_t*)(p.ws + WS_ZACT); bf16_t* MIXIN = (bf16_t*)(p.ws + WS_MIXIN); bf16_t* MIXB = (bf16_t*)(p.ws + WS_MIXB);
    const bf16_t* HB = (const bf16_t*)(p.ws + WS_HB); const float* RS = (const float*)(p.ws + WS_RS);
#pragma unroll 1
    for (int l = 0; l < DEPTH; ++l) {
        {
            pg8::Gemm g{HB, (const bf16_t*)(p.ws + WS_WIN + l * SZ_WIN), MP, INDIM, D}; pg8::Epi<0> E{ZACT, INDIM, RS};
            pg8::StaticOrder S; S.init(MP, INDIM, (int)gridDim.x, (int)blockIdx.x);
            pg8::gemm_phase<D, pg8::Epi<0>, pg8::StaticOrder>(lds, g, S, E);
        }
        grid.sync();
#ifndef NO_MIX
        { int t2 = threadIdx.x; asm volatile("" : "+v"(t2)); mixer_phase(p, l, lds, t2, __builtin_amdgcn_readfirstlane(t2 >> 6), t2 & 63); }
#endif
        grid.sync();
        {
            pg8::Gemm g{MIXIN, (const bf16_t*)(p.ws + WS_WOUT + l * SZ_WOUT), MP, D, D}; pg8::Epi<0> E{MIXB, D, nullptr};
            pg8::StaticOrder S; S.init(MP, D, (int)gridDim.x, (int)blockIdx.x);
            pg8::gemm_phase<D, pg8::Epi<0>, pg8::StaticOrder>(lds, g, S, E);
        }
        grid.sync();
        { int t2 = threadIdx.x; asm volatile("" : "+v"(t2)); postnorm(p, p.n_post_mix + l * D, false, __builtin_amdgcn_readfirstlane(t2 >> 6), t2 & 63); }
        grid.sync();
        {
            pg8::Gemm g{HB, (const bf16_t*)(p.ws + WS_WGU + l * SZ_WGU), MP, NGU, D}; pg8::Epi<1> E{ZACT, DFF, RS};
            pg8::StaticOrder S; S.init(MP, NGU, (int)gridDim.x, (int)blockIdx.x);
            pg8::gemm_phase<D, pg8::Epi<1>, pg8::StaticOrder>(lds, g, S, E);
        }
        grid.sync();
        {
            pg8::Gemm g{ZACT, (const bf16_t*)(p.ws + WS_WDN + l * SZ_WDN), MP, D, DFF}; pg8::Epi<0> E{MIXB, D, nullptr};
            pg8::StaticOrder S; S.init(MP, D, (int)gridDim.x, (int)blockIdx.x);
            pg8::gemm_phase<DFF, pg8::Epi<0>, pg8::StaticOrder>(lds, g, S, E);
        }
        grid.sync();
        { int t2 = threadIdx.x; asm volatile("" : "+v"(t2)); postnorm(p, p.n_post_ffn + l * D, l == DEPTH - 1, __builtin_amdgcn_readfirstlane(t2 >> 6), t2 & 63); }
        if (l != DEPTH - 1) grid.sync();
    }
}

extern "C" void kernel_launch(void* const* d_in, const int* in_sizes, int n_in, void* d_out, int out_size, void* d_ws, size_t ws_size, hipStream_t stream) {
    static int grid_blocks = 0;
    if (grid_blocks == 0) {
        if (n_in != 18 || ws_size < WS_END) { fprintf(stderr, "kernel_launch: unexpected inputs (n_in %d, ws %zu, need %zu)\n", n_in, ws_size, (size_t)WS_END); grid_blocks = -1; return; }
        int dev = 0, cus = 0, per_cu = 0;
        hipGetDevice(&dev);
        hipDeviceGetAttribute(&cus, hipDeviceAttributeMultiprocessorCount, dev);
        hipFuncSetAttribute((const void*)hymba_fwd, hipFuncAttributeMaxDynamicSharedMemorySize, LDS_BYTES);
        hipOccupancyMaxActiveBlocksPerMultiprocessor(&per_cu, (const void*)hymba_fwd, 512, LDS_BYTES);
        if (per_cu < 1) per_cu = 1;
        grid_blocks = cus * per_cu;
    }
    if (grid_blocks < 0) return;
    Params p{};
    const float** pp = (const float**)&p;
    for (int i = 0; i < 18; ++i) pp[i] = (const float*)d_in[i];
    p.out = (float*)d_out; p.ws = (unsigned char*)d_ws;
    void* args[] = {&p};
    hipError_t e = hipLaunchCooperativeKernel((const void*)hymba_fwd, dim3(grid_blocks), dim3(512), args, LDS_BYTES, stream);
    if (e != hipSuccess) fprintf(stderr, "cooperative launch failed: %s (grid %d)\n", hipGetErrorString(e), grid_blocks);
}
```

```cpp
#include <hip/hip_runtime.h>
#include <hip/hip_cooperative_groups.h>
#include <cstdio>
#include <cstdint>
namespace cg = cooperative_groups;
#define REP_PRO 1
#define REP_MIX 1
#define REP_GIN 1
#define REP_GOUT 1
#define REP_GGU 1
#define REP_GDN 1
#define EXTRA_SYNC 0
#define GSYNC() do { xcd_barrier(xb); for (int e_ = 0; e_ < EXTRA_SYNC; ++e_) xcd_barrier(xb); } while (0)

#define LAS __attribute__((address_space(3)))
typedef unsigned short bf16_t;
typedef short bf16x8 __attribute__((ext_vector_type(8)));
typedef float f32x4 __attribute__((ext_vector_type(4)));
typedef float f32x2 __attribute__((ext_vector_type(2)));
typedef unsigned u32x4 __attribute__((ext_vector_type(4)));
typedef unsigned u32x2 __attribute__((ext_vector_type(2)));

constexpr int D = 2048, NBATCH = 4, SEQ = 2048, NMETA = 16, LSEQ = SEQ + NMETA, DEPTH = 4, DB = 32, WIN = 128;
constexpr int MPROMPT = NBATCH * LSEQ;
constexpr int MREAL = MPROMPT + DB;
constexpr int MP = 8448;
constexpr int INDIM = 4608, DFF = 5632, NGU = 2 * DFF, CDIM = 1024;
constexpr int ZQ = 0, ZK = 1024, ZV = 1280, ZGB = 1536, ZGC = 2560, ZHC = 3584;
constexpr float RMS_EPS = 1e-6f;
constexpr int NHEADS = 16;

constexpr size_t O_YP = 0, O_YS = 16777216, O_KP = 16842752, O_VP = 17367040, O_CP = 17891328, O_KS = 17924096, O_VS = 22118400, O_CS = 26312704;

constexpr size_t SZ_WIN = (size_t)INDIM * D * 2, SZ_WOUT = (size_t)D * D * 2, SZ_WGU = (size_t)NGU * D * 2, SZ_WDN = (size_t)D * DFF * 2;
constexpr size_t WS_WIN = 0;
constexpr size_t WS_WOUT = WS_WIN + DEPTH * SZ_WIN;
constexpr size_t WS_WGU = WS_WOUT + DEPTH * SZ_WOUT;
constexpr size_t WS_WDN = WS_WGU + DEPTH * SZ_WGU;
constexpr size_t WS_ZACT = WS_WDN + DEPTH * SZ_WDN;
constexpr size_t WS_MIXIN = WS_ZACT + (size_t)MP * DFF * 2;
constexpr size_t WS_MIXB = WS_MIXIN + (size_t)MP * D * 2;
constexpr size_t WS_MIXB1 = WS_MIXB + (size_t)MP * D * 2;
constexpr size_t WS_H = WS_MIXB1 + (size_t)MP * D * 2;
constexpr size_t WS_HB = WS_H + (size_t)MP * D * 4;
constexpr size_t WS_RS = WS_HB + (size_t)MP * D * 2;
constexpr size_t WS_BAR = WS_RS + (size_t)MP * 4;
constexpr size_t WS_END = WS_BAR + 16384;

constexpr int RING_BYTES = 131072, BIAS_OFF = RING_BYTES, LDS_BYTES = 147456;
constexpr int BIAS_STRIDE = 132;
constexpr int MISC_OFF = BIAS_OFF + NHEADS * BIAS_STRIDE * 4;

__device__ __forceinline__ unsigned cvt_pk_bf16(float lo, float hi) { unsigned r; asm volatile("v_cvt_pk_bf16_f32 %0, %1, %2" : "=v"(r) : "v"(lo), "v"(hi)); return r; }
__device__ __forceinline__ float bf_lo(unsigned u) { return __uint_as_float(u << 16); }
__device__ __forceinline__ float bf_hi(unsigned u) { return __uint_as_float(u & 0xffff0000u); }
__device__ __forceinline__ float wave_sum(float v) {
#pragma unroll
    for (int o = 1; o < 64; o <<= 1) v += __shfl_xor(v, o);
    return v;
}
__device__ __forceinline__ float wave_max(float v) {
#pragma unroll
    for (int o = 1; o < 64; o <<= 1) v = fmaxf(v, __shfl_xor(v, o));
    return v;
}
#define LDS_WAIT() asm volatile("s_waitcnt lgkmcnt(0)" ::: "memory")


#define XB_TMO      128
#define XB_XCNT(j)  (256  + 64 * (j))
#define XB_XSUB(j)  (1280 + 64 * (j))
#define XB_XGEN(j)  (2304 + 64 * (j))
#define XB_TOP      3328
#define XB_TOPGEN   3392
#define XCD_BAR_WORDS 3456
#define XB_SPIN_CAP (1u << 18)
__device__ __forceinline__ unsigned xb_ld(unsigned* p)              { return __hip_atomic_load(p, __ATOMIC_RELAXED, __HIP_MEMORY_SCOPE_AGENT); }
__device__ __forceinline__ unsigned xb_add(unsigned* p, unsigned v) { return __hip_atomic_fetch_add(p, v, __ATOMIC_RELAXED, __HIP_MEMORY_SCOPE_AGENT); }
__device__ __forceinline__ unsigned xb_xcc_id() { return (unsigned)__builtin_amdgcn_s_getreg((3 << 11) | 20) & 0xFu; }
#define XB_SPIN(cond, bar) do { unsigned _sp = 0; while (cond) { __builtin_amdgcn_s_sleep(1); \
    if ((++_sp & 255u) == 0u) { if (xb_ld(&(bar)[XB_TMO])) break; if (_sp > XB_SPIN_CAP) { atomicAdd(&(bar)[XB_TMO], 1u); break; } } } } while (0)
struct XcdBarrier { unsigned* bar; unsigned x; volatile LAS unsigned* st; };
__device__ __forceinline__ XcdBarrier xcd_barrier_post(unsigned* bar, volatile LAS unsigned* st) {
    XcdBarrier b; b.bar = bar; b.x = xb_xcc_id(); b.st = st;
    if (threadIdx.x == 0) (void)xb_add(&bar[XB_XCNT(b.x)], 1u);
    return b;
}
__device__ __forceinline__ void xcd_barrier_complete(unsigned* bar, unsigned x, unsigned& nloc, unsigned& nx) {
    const unsigned G = gridDim.x * gridDim.y * gridDim.z;
    unsigned sum, cnt, mine, sp = 0u;
    for (;;) {
        sum = 0u; cnt = 0u; mine = 0u;
#pragma unroll
        for (unsigned j = 0; j < 16; ++j) { const unsigned c = xb_ld(&bar[XB_XCNT(j)]); sum += c; cnt += (c > 0u) ? 1u : 0u; mine = (j == x) ? c : mine; }
        if (sum == G) break;
        __builtin_amdgcn_s_sleep(1);
        if ((++sp & 255u) == 0u) { if (xb_ld(&bar[XB_TMO])) break; if (sp > XB_SPIN_CAP) { atomicAdd(&bar[XB_TMO], 1u); break; } }
    }
    nloc = mine > 0u ? mine : 1u; nx = cnt > 0u ? cnt : 1u;
}
__device__ __forceinline__ void xcd_barrier(const XcdBarrier& b) {
    asm volatile("s_waitcnt vmcnt(0)" ::: "memory");
    __syncthreads();
    if (threadIdx.x == 0) {
        unsigned* bar = b.bar;
        __builtin_amdgcn_s_waitcnt(0);
        unsigned nloc = b.st[0], nx = b.st[1];
        if (nloc == 0u) { xcd_barrier_complete(bar, b.x, nloc, nx); b.st[0] = nloc; b.st[1] = nx; }
        const unsigned old = xb_add(&bar[XB_XSUB(b.x)], 1u);
        const unsigned gen = old / nloc;
        if (old + 1u == (gen + 1u) * nloc) {
            __builtin_amdgcn_fence(__ATOMIC_RELEASE, "agent");
            asm volatile("s_waitcnt vmcnt(0)" ::: "memory");
            const unsigned og = xb_add(&bar[XB_TOP], 1u);
            const unsigned tg = og / nx;
            if (og + 1u == (tg + 1u) * nx) xb_add(&bar[XB_TOPGEN], 1u);
            else XB_SPIN(xb_ld(&bar[XB_TOPGEN]) == tg, bar);
            __builtin_amdgcn_fence(__ATOMIC_ACQUIRE, "agent");
            xb_add(&bar[XB_XGEN(b.x)], 1u);
            asm volatile("s_waitcnt vmcnt(0)" ::: "memory");
        } else {
            XB_SPIN(xb_ld(&bar[XB_XGEN(b.x)]) == gen, bar);
            __builtin_amdgcn_fence(__ATOMIC_ACQUIRE, "agent");
            asm volatile("s_waitcnt vmcnt(0)" ::: "memory");
        }
    }
    __syncthreads();
}

namespace pg8 {
constexpr int BM = 256, BK = 64, HALF = 128, HTB = HALF * BK * 2, STAGE_BYTES = 8 * HTB, NXCD = 8, WGM = 8;
__host__ __device__ __forceinline__ int lds_byte(int r, int c) { const int st = (r >> 4) * 2 + (c >> 5), rr = r & 15, cc = c & 31, ob = rr * 64 + cc * 2; return st * 1024 + (ob ^ (((ob >> 9) & 1) << 5)); }
__host__ __device__ __forceinline__ void stage_rc(int b, int& R, int& C) { const int st = b / 1024, sb = b % 1024, swz = sb ^ (((sb >> 9) & 1) << 5); R = (st >> 1) * 16 + swz / 64; C = (st & 1) * 32 + (swz % 64) / 2; }
__host__ __device__ __forceinline__ int perm32(int rho) { const int n = rho >> 4, i = rho & 15; return 8 * (i >> 2) + 4 * n + (i & 3); }

struct Unit { int pm, pn, kt0, len, part; };
struct Gemm { const bf16_t* A; const bf16_t* Bt; int M, N, K; };

struct StaticOrder {
    int nM, nN, nwg, G, c, nt;
    __host__ __device__ void init(int M, int N, int K, int G_, int c_) { nM = M / BM; nN = N / BM; nwg = nM * nN; G = G_; c = c_; nt = K / BK; }
    __host__ __device__ bool next(int i, Unit& u) const {
        const long L = (long)i * G + c; if (L >= nwg) return false;
        int wgid = (int)L; { const int q = nwg / NXCD, r = nwg % NXCD, xcd = wgid % NXCD, off = wgid / NXCD; wgid = (xcd < r ? xcd * (q + 1) : r * (q + 1) + (xcd - r) * q) + off; }
        const int nig = WGM * nN, gid = wgid / nig, fm = gid * WGM, gsz = (nM - fm) < WGM ? (nM - fm) : WGM;
        u.pm = fm + ((wgid % nig) % gsz); u.pn = (wgid % nig) / gsz; u.kt0 = 0; u.len = nt; u.part = 0; return true;
    }
};
template <int PP> struct StreamKOrder {
    static constexpr int NTILE = (MP / BM) * 8, TP = NTILE * PP;
    int q0, q1;
    __device__ void init(int G, int v) { q0 = (int)((long)v * TP / G); q1 = (int)((long)(v + 1) * TP / G); }
    __device__ bool next(int i, Unit& u) const {
        const int t = q0 / PP + i, s = t * PP; const int a = q0 > s ? q0 : s, b = q1 < s + PP ? q1 : s + PP;
        if (a >= b) return false;
        u.pm = t >> 3; u.pn = t & 7; u.kt0 = 2 * (a - s); u.len = 2 * (b - a); u.part = a > s ? 1 : 0; return true;
    }
    static __device__ __forceinline__ bool is_split(int t, int G) { const int s = t * PP; return (int)(((long)(s + 1) * G - 1) / TP) != (int)(((long)(s + PP) * G - 1) / TP); }
};

template <int MODE> struct Epi {
    static constexpr bool PERM = true;
    bf16_t* O; int ldc; const float* rs; bf16_t* O1;
    __device__ __forceinline__ void operator()(const f32x4 (&acc)[2][2][4][2], const Unit& u, int wr, int wc, int fr, int fq) const {
        const int row0 = u.pm * BM + wr * 64 + fr;
        if constexpr (MODE == 0) {
            const int col0 = u.pn * BM + wc * 32 + 8 * fq;
#pragma unroll
            for (int ai = 0; ai < 2; ++ai)
#pragma unroll
                for (int m = 0; m < 4; ++m) {
                    const int row = row0 + ai * HALF + m * 16;
                    const float s = rs ? rs[row] : 1.f;
                    bf16_t* rowp = (u.part ? O1 : O) + (size_t)row * ldc + col0;
#pragma unroll
                    for (int bj = 0; bj < 2; ++bj) {
                        const f32x4 v0 = acc[ai][bj][m][0] * s, v1 = acc[ai][bj][m][1] * s;
                        u32x4 w; w.x = cvt_pk_bf16(v0[0], v0[1]); w.y = cvt_pk_bf16(v0[2], v0[3]); w.z = cvt_pk_bf16(v1[0], v1[1]); w.w = cvt_pk_bf16(v1[2], v1[3]);
                        *(u32x4*)(rowp + bj * HALF) = w;
                    }
                }
        } else {
            const int col0 = u.pn * HALF + wc * 32 + 8 * fq;
#pragma unroll
            for (int ai = 0; ai < 2; ++ai)
#pragma unroll
                for (int m = 0; m < 4; ++m) {
                    const int row = row0 + ai * HALF + m * 16;
                    const float s = rs[row];
                    float o[8];
#pragma unroll
                    for (int n = 0; n < 2; ++n)
#pragma unroll
                        for (int j = 0; j < 4; ++j) {
                            const float g = acc[ai][0][m][n][j] * s, up = acc[ai][1][m][n][j] * s;
                            o[n * 4 + j] = g * __builtin_amdgcn_rcpf(1.f + __expf(-g)) * up;
                        }
                    u32x4 w; w.x = cvt_pk_bf16(o[0], o[1]); w.y = cvt_pk_bf16(o[2], o[3]); w.z = cvt_pk_bf16(o[4], o[5]); w.w = cvt_pk_bf16(o[6], o[7]);
                    *(u32x4*)(O + (size_t)row * ldc + col0) = w;
                }
        }
    }
};

template <int K, class EpiT, class Sched>
__device__ __forceinline__ void gemm_phase(LAS unsigned char* lds, const Gemm g, const Sched& S, const EpiT& E) {
    int tid_ = threadIdx.x; asm volatile("" : "+v"(tid_));
    const int tid = tid_, wid = __builtin_amdgcn_readfirstlane(tid >> 6), lane = tid & 63, wr = wid >> 2, wc = wid & 3, fr = lane & 15, fq = lane >> 4;
    unsigned voffA[2], voffB[2];
#pragma unroll
    for (int i = 0; i < 2; ++i) { int R, C; stage_rc(tid * 16 + i * 8192, R, C); const int Rb = EpiT::PERM ? ((R & ~31) + perm32(R & 31)) : R;
        voffA[i] = (unsigned)(R * K + C) * 2u; voffB[i] = (unsigned)(Rb * K + C) * 2u; }
    const size_t kstep = (size_t)(BK * 2);
    const size_t hstep = (size_t)HALF * K * 2;
    const size_t tstep = 2 * hstep;
    const unsigned ldsw = (unsigned)wid * 1024u;
    const int aoff = lds_byte(wr * 64 + fr, fq * 8), boff = lds_byte(wc * 32 + fr, fq * 8);
#define PG8_SA(b, h) (((b) * 2 + (h)) * HTB)
#define PG8_SB(b, h) ((4 + (b) * 2 + (h)) * HTB)
#define PG8_STAGE(bufoff, gbase, voff) do { _Pragma("unroll") for (int _i = 0; _i < 2; ++_i) \
        __builtin_amdgcn_global_load_lds((const unsigned*)((const char*)(gbase) + (voff)[_i]), (LAS unsigned*)(lds + (bufoff) + ldsw + _i * 8192), 16, 0, 0); } while (0)
#define PG8_LDA(dst, b, h) do { _Pragma("unroll") for (int m = 0; m < 4; ++m) _Pragma("unroll") for (int k = 0; k < 2; ++k) dst[m][k] = *(const LAS bf16x8*)(lds + PG8_SA(b, h) + aoff + m * 2048 + k * 1024); } while (0)
#define PG8_LDB(dst, b, h) do { _Pragma("unroll") for (int n = 0; n < 2; ++n) _Pragma("unroll") for (int k = 0; k < 2; ++k) dst[n][k] = *(const LAS bf16x8*)(lds + PG8_SB(b, h) + boff + n * 2048 + k * 1024); } while (0)
#define PG8_MMA(ai, bj, At, Bt) do { __builtin_amdgcn_s_setprio(1); _Pragma("unroll") for (int m = 0; m < 4; ++m) _Pragma("unroll") for (int n = 0; n < 2; ++n) _Pragma("unroll") for (int k = 0; k < 2; ++k) \
        acc[ai][bj][m][n] = __builtin_amdgcn_mfma_f32_16x16x32_bf16(Bt[n][k], At[m][k], acc[ai][bj][m][n], 0, 0, 0); __builtin_amdgcn_s_setprio(0); } while (0)
#define PG8_WAIT_V(n) asm volatile("s_waitcnt vmcnt(" #n ")" ::: "memory")
#define PG8_WAIT_L(n) asm volatile("s_waitcnt lgkmcnt(" #n ")" ::: "memory")
#define PG8_BAR __builtin_amdgcn_s_barrier()
#define PG8_SCHED __builtin_amdgcn_sched_barrier(0)
    Unit cur, nxt; int ui = 0;
    if (!S.next(0, cur)) return;
    f32x4 acc[2][2][4][2];
#pragma unroll
    for (int a = 0; a < 2; ++a)
#pragma unroll
        for (int b = 0; b < 2; ++b)
#pragma unroll
            for (int m = 0; m < 4; ++m)
#pragma unroll
                for (int n = 0; n < 2; ++n) acc[a][b][m][n] = (f32x4){0.f, 0.f, 0.f, 0.f};
    bf16x8 At[4][2], B0[2][2], B1[2][2];
    const char* cA = (const char*)g.A + (size_t)cur.pm * tstep + (size_t)cur.kt0 * kstep; const char* cB = (const char*)g.Bt + (size_t)cur.pn * tstep + (size_t)cur.kt0 * kstep;
    PG8_STAGE(PG8_SB(0, 0), cB, voffB); PG8_STAGE(PG8_SB(0, 1), cB + hstep, voffB); PG8_STAGE(PG8_SA(0, 0), cA, voffA); PG8_STAGE(PG8_SA(0, 1), cA + hstep, voffA);
    if (wr == 1) PG8_BAR;
    PG8_WAIT_V(2); PG8_BAR;
    PG8_STAGE(PG8_SB(1, 0), cB + kstep, voffB); PG8_STAGE(PG8_SA(1, 0), cA + kstep, voffA); PG8_STAGE(PG8_SB(1, 1), cB + hstep + kstep, voffB);
    PG8_WAIT_V(6); PG8_BAR;
    for (;;) {
        const bool has_next = S.next(ui + 1, nxt);
        const char* nA = has_next ? (const char*)g.A + (size_t)nxt.pm * tstep + (size_t)nxt.kt0 * kstep : cA; const char* nB = has_next ? (const char*)g.Bt + (size_t)nxt.pn * tstep + (size_t)nxt.kt0 * kstep : cB;
        const int nt = cur.len;
        for (int t = 0; t < nt; t += 2) {
            const bool last = (t == nt - 2);
            const char* a1 = cA + (size_t)(t + 1) * kstep;
            const char* a2 = last ? nA : cA + (size_t)(t + 2) * kstep; const char* b2 = last ? nB : cB + (size_t)(t + 2) * kstep;
            const char* a3 = a2 + kstep; const char* b3 = b2 + kstep;
            PG8_LDB(B0, 0, 0); PG8_LDB(B1, 0, 1); PG8_SCHED; PG8_LDA(At, 0, 0); PG8_STAGE(PG8_SA(1, 1), a1 + hstep, voffA);
            PG8_WAIT_V(8); PG8_WAIT_L(0); PG8_BAR; PG8_MMA(0, 0, At, B0); PG8_MMA(0, 1, At, B1); PG8_BAR; PG8_SCHED;
            PG8_LDA(At, 0, 1); PG8_STAGE(PG8_SB(0, 0), b2, voffB); PG8_STAGE(PG8_SB(0, 1), b2 + hstep, voffB); PG8_STAGE(PG8_SA(0, 0), a2, voffA);
            PG8_WAIT_V(8); PG8_WAIT_L(0); PG8_BAR; PG8_MMA(1, 0, At, B0); PG8_MMA(1, 1, At, B1); PG8_BAR; PG8_SCHED;
            PG8_LDB(B0, 1, 0); PG8_LDB(B1, 1, 1); PG8_SCHED; PG8_LDA(At, 1, 0); PG8_STAGE(PG8_SA(0, 1), a2 + hstep, voffA);
            PG8_WAIT_V(8); PG8_WAIT_L(0); PG8_BAR; PG8_MMA(0, 0, At, B0); PG8_MMA(0, 1, At, B1); PG8_BAR; PG8_SCHED;
            PG8_LDA(At, 1, 1); PG8_STAGE(PG8_SB(1, 0), b3, voffB); PG8_STAGE(PG8_SB(1, 1), b3 + hstep, voffB); PG8_STAGE(PG8_SA(1, 0), a3, voffA);
            PG8_WAIT_V(8); PG8_WAIT_L(0); PG8_BAR; PG8_MMA(1, 0, At, B0); PG8_MMA(1, 1, At, B1); PG8_BAR; PG8_SCHED;
        }
        if (wr == 0) PG8_BAR;
        E(acc, cur, wr, wc, fr, fq);
        if (!has_next) break;
#pragma unroll
        for (int a = 0; a < 2; ++a)
#pragma unroll
            for (int b = 0; b < 2; ++b)
#pragma unroll
                for (int m = 0; m < 4; ++m)
#pragma unroll
                    for (int n = 0; n < 2; ++n) acc[a][b][m][n] = (f32x4){0.f, 0.f, 0.f, 0.f};
        cur = nxt; cA = nA; cB = nB; ++ui;
        if (wr == 1) PG8_BAR;
    }
    PG8_WAIT_V(0);
    PG8_BAR;
#undef PG8_SA
#undef PG8_SB
#undef PG8_STAGE
#undef PG8_LDA
#undef PG8_LDB
#undef PG8_MMA
#undef PG8_WAIT_V
#undef PG8_WAIT_L
#undef PG8_BAR
#undef PG8_SCHED
}
}

struct Params {
    const float *x_prompt, *x_sample, *cache_k, *cache_v, *state_conv, *meta, *rel_bias, *w_in, *conv_w, *sinks, *w_out,
        *n_pre_mix, *n_post_mix, *n_pre_ffn, *n_post_ffn, *w_gate, *w_up, *w_down;
    float* out; unsigned char* ws;
};

__device__ __forceinline__ void transpose_item(const float* __restrict__ W, int K, int N, bf16_t* WT, const float* __restrict__ gain, int mode, LAS unsigned* scr, int item, int lane) {
    const int nblk = N / 64, kb = item / nblk, nb = item % nblk, k0 = 64 * kb, n0 = 64 * nb;
    const int c4 = lane & 15, kq = lane >> 4;
    f32x4 v0[8], v1[8];
#pragma unroll
    for (int i = 0; i < 8; ++i) { const int kp = kq + 4 * i; const float* s = W + (size_t)(k0 + 2 * kp) * N + n0 + 4 * c4; v0[i] = *(const f32x4*)s; v1[i] = *(const f32x4*)(s + N); }
#pragma unroll
    for (int i = 0; i < 8; ++i) { const int kp = kq + 4 * i;
        float g0 = 1.f, g1 = 1.f; if (gain) { g0 = gain[k0 + 2 * kp]; g1 = gain[k0 + 2 * kp + 1]; }
        LAS unsigned* d = scr + (4 * c4) * 33 + kp;
        d[0] = cvt_pk_bf16(v0[i].x * g0, v1[i].x * g1); d[33] = cvt_pk_bf16(v0[i].y * g0, v1[i].y * g1); d[66] = cvt_pk_bf16(v0[i].z * g0, v1[i].z * g1); d[99] = cvt_pk_bf16(v0[i].w * g0, v1[i].w * g1); }
    LDS_WAIT(); __builtin_amdgcn_wave_barrier(); asm volatile("" ::: "memory");
    int rbase = n0;
    if (mode) rbase = ((n0 >> 7) << 8) + (n0 & 127) + (mode == 2 ? 128 : 0);
    const int kc = lane & 7;
#pragma unroll
    for (int j = 0; j < 8; ++j) { const int n = (lane >> 3) + 8 * j; const LAS unsigned* s = scr + n * 33 + 4 * kc;
        u32x4 o; o.x = s[0]; o.y = s[1]; o.z = s[2]; o.w = s[3];
        *(u32x4*)(WT + (size_t)(rbase + n) * K + k0 + 8 * kc) = o; }
    LDS_WAIT(); __builtin_amdgcn_wave_barrier(); asm volatile("" ::: "memory");
}

__device__ __forceinline__ void prologue(const Params& p, LAS unsigned char* lds, int wid, int lane) {
    LAS unsigned* scr = (LAS unsigned*)(lds + wid * 16384);
    const int gw = blockIdx.x * 8 + wid, NGW = gridDim.x * 8;
    constexpr int I_IN = (D / 64) * (INDIM / 64), I_OUT = (D / 64) * (D / 64), I_G = (D / 64) * (DFF / 64), I_DN = (DFF / 64) * (D / 64);
    constexpr int I_LAYER = I_IN + I_OUT + 2 * I_G + I_DN;
    bf16_t* win = (bf16_t*)(p.ws + WS_WIN); bf16_t* wout = (bf16_t*)(p.ws + WS_WOUT); bf16_t* wgu = (bf16_t*)(p.ws + WS_WGU); bf16_t* wdn = (bf16_t*)(p.ws + WS_WDN);
    for (int it = gw; it < DEPTH * I_LAYER; it += NGW) {
        const int l = it / I_LAYER; int r = it % I_LAYER;
        if (r < I_IN) { transpose_item(p.w_in + (size_t)l * D * INDIM, D, INDIM, win + (size_t)l * INDIM * D, p.n_pre_mix + l * D, 0, scr, r, lane); continue; } r -= I_IN;
        if (r < I_OUT) { transpose_item(p.w_out + (size_t)l * D * D, D, D, wout + (size_t)l * D * D, nullptr, 0, scr, r, lane); continue; } r -= I_OUT;
        if (r < I_G) { transpose_item(p.w_gate + (size_t)l * D * DFF, D, DFF, wgu + (size_t)l * NGU * D, p.n_pre_ffn + l * D, 1, scr, r, lane); continue; } r -= I_G;
        if (r < I_G) { transpose_item(p.w_up + (size_t)l * D * DFF, D, DFF, wgu + (size_t)l * NGU * D, p.n_pre_ffn + l * D, 2, scr, r, lane); continue; } r -= I_G;
        transpose_item(p.w_down + (size_t)l * DFF * D, DFF, D, wdn + (size_t)l * D * DFF, nullptr, 0, scr, r, lane);
    }
    float* H = (float*)(p.ws + WS_H); bf16_t* HB = (bf16_t*)(p.ws + WS_HB); float* RS = (float*)(p.ws + WS_RS);
    for (int m = gw; m < MREAL; m += NGW) {
        const float* src;
        if (m < MPROMPT) { const int b = m / LSEQ, t = m % LSEQ; src = t < NMETA ? p.meta + (size_t)t * D : p.x_prompt + ((size_t)b * SEQ + (t - NMETA)) * D; }
        else src = p.x_sample + (size_t)(m - MPROMPT) * D;
        const f32x4* xr = (const f32x4*)src + lane; f32x4* hr = (f32x4*)(H + (size_t)m * D) + lane; u32x2* hb = (u32x2*)(HB + (size_t)m * D) + lane;
        float ss = 0.f;
#pragma unroll
        for (int j = 0; j < 8; ++j) { const f32x4 v = xr[64 * j]; ss += (v.x * v.x + v.y * v.y) + (v.z * v.z + v.w * v.w); hr[64 * j] = v; u32x2 w; w.x = cvt_pk_bf16(v.x, v.y); w.y = cvt_pk_bf16(v.z, v.w); hb[64 * j] = w; }
        ss = wave_sum(ss);
        if (lane == 0) RS[m] = 1.f / sqrtf(ss * (1.f / D) + RMS_EPS);
    }
}

template <int PP> __device__ __forceinline__ void postnorm(const Params& p, const float* __restrict__ g, bool last, int wid, int lane) {
    const int gw = blockIdx.x * 8 + wid, NGW = gridDim.x * 8;
    float* H = (float*)(p.ws + WS_H); bf16_t* HB = (bf16_t*)(p.ws + WS_HB); float* RS = (float*)(p.ws + WS_RS); const bf16_t* MIXB = (const bf16_t*)(p.ws + WS_MIXB); const bf16_t* MIXB1 = (const bf16_t*)(p.ws + WS_MIXB1);
    for (int m = gw; m < MREAL; m += NGW) {
        const u32x2* mr = (const u32x2*)(MIXB + (size_t)m * D) + lane; const u32x2* mr1 = (const u32x2*)(MIXB1 + (size_t)m * D) + lane;
        f32x4* hr = (f32x4*)(H + (size_t)m * D) + lane; u32x2* hb = (u32x2*)(HB + (size_t)m * D) + lane; const f32x4* gr = (const f32x4*)g + lane;
        const int tile0 = (m >> 8) * 8;
        u32x2 w0[8], w1[8]; f32x4 hv[8], gv[8];
#pragma unroll
        for (int j = 0; j < 8; ++j) { w0[j] = mr[64 * j]; w1[j] = mr1[64 * j]; }
#pragma unroll
        for (int j = 0; j < 8; ++j) { hv[j] = hr[64 * j]; gv[j] = gr[64 * j]; }
        f32x4 mv[8]; float ss = 0.f;
#pragma unroll
        for (int j = 0; j < 8; ++j) { mv[j] = (f32x4){bf_lo(w0[j].x), bf_hi(w0[j].x), bf_lo(w0[j].y), bf_hi(w0[j].y)};
            if (pg8::StreamKOrder<PP>::is_split(tile0 + j, (int)gridDim.x)) mv[j] += (f32x4){bf_lo(w1[j].x), bf_hi(w1[j].x), bf_lo(w1[j].y), bf_hi(w1[j].y)};
            ss += (mv[j].x * mv[j].x + mv[j].y * mv[j].y) + (mv[j].z * mv[j].z + mv[j].w * mv[j].w); }
        ss = wave_sum(ss);
        const float r = 1.f / sqrtf(ss * (1.f / D) + RMS_EPS);
        float* yrow = nullptr;
        if (last) { if (m < MPROMPT) { const int b = m / LSEQ, t = m % LSEQ; if (t >= NMETA) yrow = p.out + O_YP + ((size_t)b * SEQ + (t - NMETA)) * D; } else yrow = p.out + O_YS + (size_t)(m - MPROMPT) * D; }
        float s2 = 0.f;
#pragma unroll
        for (int j = 0; j < 8; ++j) {
            const f32x4 hn = hv[j] + mv[j] * r * gv[j];
            s2 += (hn.x * hn.x + hn.y * hn.y) + (hn.z * hn.z + hn.w * hn.w);
            hr[64 * j] = hn; u32x2 w; w.x = cvt_pk_bf16(hn.x, hn.y); w.y = cvt_pk_bf16(hn.z, hn.w); hb[64 * j] = w;
            if (yrow) ((f32x4*)yrow)[lane + 64 * j] = hn;
        }
        s2 = wave_sum(s2);
        if (lane == 0) RS[m] = 1.f / sqrtf(s2 * (1.f / D) + RMS_EPS);
    }
}

constexpr int AT_KR = 208, AT_KS = 72, AT_VS = 216, AT_PS = 168;
constexpr int AT_K_OFF = 0, AT_V_OFF = AT_KR * AT_KS * 2  , AT_P_OFF = AT_V_OFF + 64 * AT_VS * 2  , AT_P_WAVE = 16 * AT_PS * 2  ;

__device__ __forceinline__ void attn_prompt_unit(LAS unsigned char* lds, int b, int kvh, int qt, const bf16_t* __restrict__ z, bf16_t* mixin, const float* __restrict__ sinks, int tid, int wid, int lane) {
    LAS bf16_t* Ks = (LAS bf16_t*)(lds + AT_K_OFF);
    LAS bf16_t* Vt = (LAS bf16_t*)(lds + AT_V_OFF);
    LAS bf16_t* Pw = (LAS bf16_t*)(lds + AT_P_OFF + wid * AT_P_WAVE);
    const LAS float* biasL = (const LAS float*)(lds + BIAS_OFF);
    const int q0 = qt * 64, rowb = b * LSEQ;
    for (int c = tid; c < AT_KR * 8; c += 512) {
        const int kr = c >> 3, ch = c & 7; int t = q0 - 144 + kr; t = t < 0 ? 0 : (t > LSEQ - 1 ? LSEQ - 1 : t);
        const bf16_t* src = z + (size_t)(rowb + t) * INDIM + kvh * 64 + ch * 8;
        const u32x4 kv = *(const u32x4*)(src + ZK);
        const u32x4 vv = *(const u32x4*)(src + ZV);
        *(LAS u32x4*)(Ks + kr * AT_KS + ch * 8) = kv;
        LAS bf16_t* vd = Vt + (ch * 8) * AT_VS + kr;
        vd[0 * AT_VS] = (bf16_t)(vv.x & 0xffffu); vd[1 * AT_VS] = (bf16_t)(vv.x >> 16);
        vd[2 * AT_VS] = (bf16_t)(vv.y & 0xffffu); vd[3 * AT_VS] = (bf16_t)(vv.y >> 16);
        vd[4 * AT_VS] = (bf16_t)(vv.z & 0xffffu); vd[5 * AT_VS] = (bf16_t)(vv.z >> 16);
        vd[6 * AT_VS] = (bf16_t)(vv.w & 0xffffu); vd[7 * AT_VS] = (bf16_t)(vv.w >> 16);
    }
    __syncthreads();
    const int h = kvh * 4 + (wid & 3), i16 = lane & 15, g = lane >> 4;
    const float sink = sinks[h];
#pragma unroll 1
    for (int tile = 0; tile < 2; ++tile) {
        const int tq0 = q0 + (wid >> 2) * 32 + tile * 16;
        if (tq0 >= LSEQ) continue;
        const int koff = tq0 - q0;
        const int t = tq0 + i16; const int tq = t > LSEQ - 1 ? LSEQ - 1 : t;
        const bf16_t* qp = z + (size_t)(rowb + tq) * INDIM + ZQ + h * 64 + 8 * g;
        const bf16x8 qf0 = *(const bf16x8*)qp, qf1 = *(const bf16x8*)(qp + 32);
        f32x4 s[10];
#pragma unroll
        for (int nt = 0; nt < 10; ++nt) {
            const LAS bf16_t* kp = Ks + (koff + nt * 16 + i16) * AT_KS + 8 * g;
            const bf16x8 k0 = *(const LAS bf16x8*)kp, k1 = *(const LAS bf16x8*)(kp + 32);
            f32x4 a = (f32x4){0.f, 0.f, 0.f, 0.f};
            a = __builtin_amdgcn_mfma_f32_16x16x32_bf16(k0, qf0, a, 0, 0, 0);
            a = __builtin_amdgcn_mfma_f32_16x16x32_bf16(k1, qf1, a, 0, 0, 0);
            s[nt] = a;
        }
        float mx = sink;
#pragma unroll
        for (int nt = 0; nt < 10; ++nt)
#pragma unroll
            for (int r = 0; r < 4; ++r) {
                const int kk = nt * 16 + 4 * g + r; const int dist = 144 + i16 - kk; const int tk = tq0 - 144 + kk;
                const bool ok = dist >= 0 && dist <= WIN && tk >= 0;
                const int dc = dist < 0 ? 0 : (dist > WIN ? WIN : dist);
                const float v = ok ? s[nt][r] * 0.125f + biasL[h * BIAS_STRIDE + dc] : -INFINITY;
                s[nt][r] = v; mx = fmaxf(mx, v);
            }
        mx = fmaxf(mx, __shfl_xor(mx, 16)); mx = fmaxf(mx, __shfl_xor(mx, 32));
        float sum = 0.f;
#pragma unroll
        for (int nt = 0; nt < 10; ++nt) {
            const float e0 = __expf(s[nt][0] - mx), e1 = __expf(s[nt][1] - mx), e2 = __expf(s[nt][2] - mx), e3 = __expf(s[nt][3] - mx);
            sum += (e0 + e1) + (e2 + e3);
            u32x2 w; w.x = cvt_pk_bf16(e0, e1); w.y = cvt_pk_bf16(e2, e3);
            *(LAS u32x2*)(Pw + i16 * AT_PS + nt * 16 + 4 * g) = w;
        }
        sum += __shfl_xor(sum, 16); sum += __shfl_xor(sum, 32);
        const float inv = 1.f / (sum + __expf(sink - mx));
        LDS_WAIT(); __builtin_amdgcn_wave_barrier();
        f32x4 o[4];
#pragma unroll
        for (int dn = 0; dn < 4; ++dn) o[dn] = (f32x4){0.f, 0.f, 0.f, 0.f};
#pragma unroll
        for (int ks = 0; ks < 5; ++ks) {
            const bf16x8 pf = *(const LAS bf16x8*)(Pw + i16 * AT_PS + ks * 32 + 8 * g);
#pragma unroll
            for (int dn = 0; dn < 4; ++dn) {
                const bf16x8 vf = *(const LAS bf16x8*)(Vt + (dn * 16 + i16) * AT_VS + koff + ks * 32 + 8 * g);
                o[dn] = __builtin_amdgcn_mfma_f32_16x16x32_bf16(vf, pf, o[dn], 0, 0, 0);
            }
        }
        if (t < LSEQ) {
            bf16_t* op = mixin + (size_t)(rowb + t) * D + h * 64 + 4 * g;
#pragma unroll
            for (int dn = 0; dn < 4; ++dn) { u32x2 w; w.x = cvt_pk_bf16(o[dn][0] * inv, o[dn][1] * inv); w.y = cvt_pk_bf16(o[dn][2] * inv, o[dn][3] * inv); *(u32x2*)(op + dn * 16) = w; }
        }
        LDS_WAIT(); __builtin_amdgcn_wave_barrier();
    }
    __syncthreads();
}

__device__ __forceinline__ void attn_sample_wave(LAS unsigned char* lds, int l, int b, int h, const Params& p, const bf16_t* __restrict__ z, bf16_t* mixin, int wid, int lane) {
    LAS float* qs = (LAS float*)(lds + wid * 1024);
    LAS float* ps = qs + 64;
    const LAS float* biasL = (const LAS float*)(lds + BIAS_OFF);
    const int kvh = h >> 2;
    const bf16_t* zr = z + (size_t)(MPROMPT + b) * INDIM;
    const float qv = __uint_as_float((unsigned)zr[ZQ + h * 64 + lane] << 16) * 0.125f;
    qs[lane] = qv;
    LDS_WAIT(); __builtin_amdgcn_wave_barrier();
    const float* ck = p.cache_k + (((size_t)l * DB + b) * WIN) * 256 + kvh * 64;
    const float* cv = p.cache_v + (((size_t)l * DB + b) * WIN) * 256 + kvh * 64;
    float sc0 = 0.f, sc1 = 0.f;
    {
        const f32x4* k0 = (const f32x4*)(ck + (size_t)lane * 256); const f32x4* k1 = (const f32x4*)(ck + (size_t)(lane + 64) * 256);
#pragma unroll
        for (int d4 = 0; d4 < 16; ++d4) { const f32x4 q4 = *(const LAS f32x4*)(qs + 4 * d4); const f32x4 a = k0[d4], c = k1[d4];
            sc0 += (a.x * q4.x + a.y * q4.y) + (a.z * q4.z + a.w * q4.w); sc1 += (c.x * q4.x + c.y * q4.y) + (c.z * q4.z + c.w * q4.w); }
    }
    const float knew = __uint_as_float((unsigned)zr[ZK + kvh * 64 + lane] << 16);
    const float sc2 = wave_sum(qv * knew);
    const float sink = p.sinks[l * NHEADS + h];
    const float v0 = sc0 + biasL[h * BIAS_STRIDE + (WIN - lane)], v1 = sc1 + biasL[h * BIAS_STRIDE + (64 - lane)], v2 = sc2 + biasL[h * BIAS_STRIDE];
    float mx = wave_max(fmaxf(v0, v1)); mx = fmaxf(mx, fmaxf(v2, sink));
    const float e0 = __expf(v0 - mx), e1 = __expf(v1 - mx), e2 = __expf(v2 - mx);
    const float sum = wave_sum(e0 + e1) + e2 + __expf(sink - mx);
    ps[lane] = e0; ps[lane + 64] = e1;
    LDS_WAIT(); __builtin_amdgcn_wave_barrier();
    float o = 0.f;
#pragma unroll 8
    for (int s = 0; s < WIN; ++s) o += ps[s] * cv[(size_t)s * 256 + lane];
    o += e2 * __uint_as_float((unsigned)zr[ZV + kvh * 64 + lane] << 16);
    o /= sum;
    const unsigned ob = cvt_pk_bf16(o, o);
    mixin[(size_t)(MPROMPT + b) * D + h * 64 + lane] = (bf16_t)(ob & 0xffffu);
    LDS_WAIT(); __builtin_amdgcn_wave_barrier();
}

__device__ __forceinline__ void conv_row(int l, int m, const Params& p, const bf16_t* __restrict__ z, bf16_t* mixin, int lane) {
    const float* cw = p.conv_w + (size_t)l * 3 * CDIM;
#pragma unroll
    for (int j = 0; j < 2; ++j) {
        const int c0 = lane * 8 + 512 * j;
        const bf16_t* zr = z + (size_t)m * INDIM;
        const u32x4 gbv = *(const u32x4*)(zr + ZGB + c0), gcv = *(const u32x4*)(zr + ZGC + c0), hcv = *(const u32x4*)(zr + ZHC + c0);
        float u0[8], u1[8], u2[8], gb[8];
        const unsigned gbw[4] = {gbv.x, gbv.y, gbv.z, gbv.w}, gcw[4] = {gcv.x, gcv.y, gcv.z, gcv.w}, hcw[4] = {hcv.x, hcv.y, hcv.z, hcv.w};
#pragma unroll
        for (int i = 0; i < 4; ++i) { gb[2 * i] = bf_lo(gbw[i]); gb[2 * i + 1] = bf_hi(gbw[i]); u0[2 * i] = bf_lo(gcw[i]) * bf_lo(hcw[i]); u0[2 * i + 1] = bf_hi(gcw[i]) * bf_hi(hcw[i]); }
        if (m < MPROMPT) {
            const int b = m / LSEQ, t = m % LSEQ;
#pragma unroll
            for (int i = 0; i < 8; ++i) { u1[i] = 0.f; u2[i] = 0.f; }
            if (t >= 1) { const bf16_t* z1 = zr - INDIM; const u32x4 a = *(const u32x4*)(z1 + ZGC + c0), c = *(const u32x4*)(z1 + ZHC + c0);
                const unsigned aw[4] = {a.x, a.y, a.z, a.w}, cw4[4] = {c.x, c.y, c.z, c.w};
#pragma unroll
                for (int i = 0; i < 4; ++i) { u1[2 * i] = bf_lo(aw[i]) * bf_lo(cw4[i]); u1[2 * i + 1] = bf_hi(aw[i]) * bf_hi(cw4[i]); } }
            if (t >= 2) { const bf16_t* z2 = zr - 2 * INDIM; const u32x4 a = *(const u32x4*)(z2 + ZGC + c0), c = *(const u32x4*)(z2 + ZHC + c0);
                const unsigned aw[4] = {a.x, a.y, a.z, a.w}, cw4[4] = {c.x, c.y, c.z, c.w};
#pragma unroll
                for (int i = 0; i < 4; ++i) { u2[2 * i] = bf_lo(aw[i]) * bf_lo(cw4[i]); u2[2 * i + 1] = bf_hi(aw[i]) * bf_hi(cw4[i]); } }
            if (t >= LSEQ - 2) { float* co = p.out + O_CP + (((size_t)l * NBATCH + b) * 2 + (t - (LSEQ - 2))) * CDIM + c0;
                *(f32x4*)co = (f32x4){u0[0], u0[1], u0[2], u0[3]}; *(f32x4*)(co + 4) = (f32x4){u0[4], u0[5], u0[6], u0[7]}; }
        } else {
            const int b = m - MPROMPT;
            const float* st = p.state_conv + (((size_t)l * DB + b) * 2) * CDIM + c0;
            const f32x4 s0a = *(const f32x4*)st, s0b = *(const f32x4*)(st + 4), s1a = *(const f32x4*)(st + CDIM), s1b = *(const f32x4*)(st + CDIM + 4);
            u2[0] = s0a.x; u2[1] = s0a.y; u2[2] = s0a.z; u2[3] = s0a.w; u2[4] = s0b.x; u2[5] = s0b.y; u2[6] = s0b.z; u2[7] = s0b.w;
            u1[0] = s1a.x; u1[1] = s1a.y; u1[2] = s1a.z; u1[3] = s1a.w; u1[4] = s1b.x; u1[5] = s1b.y; u1[6] = s1b.z; u1[7] = s1b.w;
            float* co = p.out + O_CS + (((size_t)l * DB + b) * 2) * CDIM + c0;
            *(f32x4*)co = s1a; *(f32x4*)(co + 4) = s1b;
            *(f32x4*)(co + CDIM) = (f32x4){u0[0], u0[1], u0[2], u0[3]}; *(f32x4*)(co + CDIM + 4) = (f32x4){u0[4], u0[5], u0[6], u0[7]};
        }
        const f32x4 w0a = *(const f32x4*)(cw + c0), w0b = *(const f32x4*)(cw + c0 + 4), w1a = *(const f32x4*)(cw + CDIM + c0), w1b = *(const f32x4*)(cw + CDIM + c0 + 4),
                    w2a = *(const f32x4*)(cw + 2 * CDIM + c0), w2b = *(const f32x4*)(cw + 2 * CDIM + c0 + 4);
        const float w0[8] = {w0a.x, w0a.y, w0a.z, w0a.w, w0b.x, w0b.y, w0b.z, w0b.w}, w1[8] = {w1a.x, w1a.y, w1a.z, w1a.w, w1b.x, w1b.y, w1b.z, w1b.w},
                    w2[8] = {w2a.x, w2a.y, w2a.z, w2a.w, w2b.x, w2b.y, w2b.z, w2b.w};
        float r[8];
#pragma unroll
        for (int i = 0; i < 8; ++i) r[i] = gb[i] * (w0[i] * u2[i] + w1[i] * u1[i] + w2[i] * u0[i]);
        u32x4 w; w.x = cvt_pk_bf16(r[0], r[1]); w.y = cvt_pk_bf16(r[2], r[3]); w.z = cvt_pk_bf16(r[4], r[5]); w.w = cvt_pk_bf16(r[6], r[7]);
        *(u32x4*)(mixin + (size_t)m * D + 1024 + c0) = w;
    }
}

__device__ __forceinline__ void kv_prompt_row(int l, int idx, const Params& p, const bf16_t* __restrict__ z, int lane) {
    const int b = idx >> 7, w = idx & 127;
    const bf16_t* zr = z + (size_t)(b * LSEQ + (LSEQ - WIN) + w) * INDIM;
    const u32x2 kv = *(const u32x2*)(zr + ZK + 4 * lane), vv = *(const u32x2*)(zr + ZV + 4 * lane);
    const size_t o = (((size_t)l * NBATCH + b) * WIN + w) * 256 + 4 * lane;
    *(f32x4*)(p.out + O_KP + o) = (f32x4){bf_lo(kv.x), bf_hi(kv.x), bf_lo(kv.y), bf_hi(kv.y)};
    *(f32x4*)(p.out + O_VP + o) = (f32x4){bf_lo(vv.x), bf_hi(vv.x), bf_lo(vv.y), bf_hi(vv.y)};
}
__device__ __forceinline__ void kv_sample_row(int l, int idx, const Params& p, const bf16_t* __restrict__ z, int lane) {
    const int b = idx >> 7, w = idx & 127;
    const size_t o = (((size_t)l * DB + b) * WIN + w) * 256 + 4 * lane;
    f32x4 kq, vq;
    if (w < WIN - 1) { kq = *(const f32x4*)(p.cache_k + o + 256); vq = *(const f32x4*)(p.cache_v + o + 256); }
    else { const bf16_t* zr = z + (size_t)(MPROMPT + b) * INDIM; const u32x2 kv = *(const u32x2*)(zr + ZK + 4 * lane), vv = *(const u32x2*)(zr + ZV + 4 * lane);
        kq = (f32x4){bf_lo(kv.x), bf_hi(kv.x), bf_lo(kv.y), bf_hi(kv.y)}; vq = (f32x4){bf_lo(vv.x), bf_hi(vv.x), bf_lo(vv.y), bf_hi(vv.y)}; }
    *(f32x4*)(p.out + O_KS + o) = kq; *(f32x4*)(p.out + O_VS + o) = vq;
}

constexpr int NU_ATT = NBATCH * 4 * 33;
constexpr int NU_SATT = DB * 2;
constexpr int NU_CONV = (MREAL + 63) / 64;
constexpr int NU_KVP = NBATCH * WIN / 64;
constexpr int NU_KVS = DB * WIN / 64;
constexpr int NU_B = NU_ATT + NU_SATT + NU_CONV + NU_KVP + NU_KVS;

__device__ __forceinline__ void mixer_phase(const Params& p, int l, LAS unsigned char* lds, int tid, int wid, int lane) {
    const bf16_t* z = (const bf16_t*)(p.ws + WS_ZACT); bf16_t* mixin = (bf16_t*)(p.ws + WS_MIXIN);
    for (int u = blockIdx.x; u < NU_B; u += gridDim.x) {
        int r = u;
        if (r < NU_ATT) { const int qt = r % 33, bk = r / 33; attn_prompt_unit(lds, bk >> 2, bk & 3, qt, z, mixin, p.sinks + l * NHEADS, tid, wid, lane); continue; } r -= NU_ATT;
        if (r < NU_SATT) { attn_sample_wave(lds, l, r >> 1, (r & 1) * 8 + wid, p, z, mixin, wid, lane); continue; } r -= NU_SATT;
        if (r < NU_CONV) { for (int i = 0; i < 8; ++i) { const int m = r * 64 + wid * 8 + i; if (m < MREAL) conv_row(l, m, p, z, mixin, lane); } continue; } r -= NU_CONV;
        if (r < NU_KVP) { for (int i = 0; i < 8; ++i) kv_prompt_row(l, r * 64 + wid * 8 + i, p, z, lane); continue; } r -= NU_KVP;
        for (int i = 0; i < 8; ++i) kv_sample_row(l, r * 64 + wid * 8 + i, p, z, lane);
    }
}

__global__ void __launch_bounds__(512, 2) hymba_fwd(Params p) {
    extern __shared__ __attribute__((aligned(16))) unsigned char lds_raw[];
    LAS unsigned char* lds = (LAS unsigned char*)lds_raw;
    cg::grid_group grid = cg::this_grid();
    const int tid = threadIdx.x, lane = tid & 63, wid = __builtin_amdgcn_readfirstlane(tid >> 6);

    unsigned* barw = (unsigned*)(p.ws + WS_BAR);
    volatile LAS unsigned* xst = (volatile LAS unsigned*)(lds + MISC_OFF);
    if (blockIdx.x == 0) for (int i = tid; i < XCD_BAR_WORDS; i += 512) __hip_atomic_store(barw + i, 0u, __ATOMIC_RELAXED, __HIP_MEMORY_SCOPE_AGENT);
    if (tid < 2) xst[tid] = 0u;
    {
        LAS float* biasL = (LAS float*)(lds + BIAS_OFF);
        for (int i = tid; i < NHEADS * 129; i += 512) {
            const int h = i / 129, d = i % 129;
            int bkt;
            if (d < 16) bkt = d;
            else { const float df = (float)d; bkt = 16 + (int)(logf(df / 16.f) / logf(8.f) * 16.f); bkt = bkt > 31 ? 31 : bkt; }
            biasL[h * BIAS_STRIDE + d] = p.rel_bias[bkt * NHEADS + h];
        }
    }
    for (int rep = 0; rep < REP_PRO; ++rep) prologue(p, lds, wid, lane);
    grid.sync();
    const XcdBarrier xb = xcd_barrier_post(barw, xst);

    bf16_t* ZACT = (bf16_t*)(p.ws + WS_ZACT); bf16_t* MIXIN = (bf16_t*)(p.ws + WS_MIXIN); bf16_t* MIXB = (bf16_t*)(p.ws + WS_MIXB); bf16_t* MIXB1 = (bf16_t*)(p.ws + WS_MIXB1);
    const int vcu = (gridDim.x % 8 == 0) ? (int)((blockIdx.x % 8) * (gridDim.x / 8) + blockIdx.x / 8) : (int)blockIdx.x;
    const bf16_t* HB = (const bf16_t*)(p.ws + WS_HB); const float* RS = (const float*)(p.ws + WS_RS);
#pragma unroll 1
    for (int l = 0; l < DEPTH; ++l) {
        {
            pg8::Gemm g{HB, (const bf16_t*)(p.ws + WS_WIN + l * SZ_WIN), MP, INDIM, D}; pg8::Epi<0> E{ZACT, INDIM, RS, ZACT};
            pg8::StaticOrder S; S.init(MP, INDIM, D, (int)gridDim.x, (int)blockIdx.x);
            for (int rep = 0; rep < REP_GIN; ++rep) pg8::gemm_phase<D, pg8::Epi<0>, pg8::StaticOrder>(lds, g, S, E);
        }
        GSYNC();
#ifndef NO_MIX
        for (int rep = 0; rep < REP_MIX; ++rep) { int t2 = threadIdx.x; asm volatile("" : "+v"(t2)); mixer_phase(p, l, lds, t2, __builtin_amdgcn_readfirstlane(t2 >> 6), t2 & 63); }
#endif
        GSYNC();
        {
            pg8::Gemm g{MIXIN, (const bf16_t*)(p.ws + WS_WOUT + l * SZ_WOUT), MP, D, D}; pg8::Epi<0> E{MIXB, D, nullptr, MIXB1};
            pg8::StreamKOrder<D / 128> S; S.init((int)gridDim.x, vcu);
            for (int rep = 0; rep < REP_GOUT; ++rep) pg8::gemm_phase<D, pg8::Epi<0>, pg8::StreamKOrder<D / 128>>(lds, g, S, E);
        }
        GSYNC();
        { int t2 = threadIdx.x; asm volatile("" : "+v"(t2)); postnorm<D / 128>(p, p.n_post_mix + l * D, false, __builtin_amdgcn_readfirstlane(t2 >> 6), t2 & 63); }
        GSYNC();
        {
            pg8::Gemm g{HB, (const bf16_t*)(p.ws + WS_WGU + l * SZ_WGU), MP, NGU, D}; pg8::Epi<1> E{ZACT, DFF, RS, ZACT};
            pg8::StaticOrder S; S.init(MP, NGU, D, (int)gridDim.x, (int)blockIdx.x);
            for (int rep = 0; rep < REP_GGU; ++rep) pg8::gemm_phase<D, pg8::Epi<1>, pg8::StaticOrder>(lds, g, S, E);
        }
        GSYNC();
        {
            pg8::Gemm g{ZACT, (const bf16_t*)(p.ws + WS_WDN + l * SZ_WDN), MP, D, DFF}; pg8::Epi<0> E{MIXB, D, nullptr, MIXB1};
            pg8::StreamKOrder<DFF / 128> S; S.init((int)gridDim.x, vcu);
            for (int rep = 0; rep < REP_GDN; ++rep) pg8::gemm_phase<DFF, pg8::Epi<0>, pg8::StreamKOrder<DFF / 128>>(lds, g, S, E);
        }
        GSYNC();
        { int t2 = threadIdx.x; asm volatile("" : "+v"(t2)); postnorm<DFF / 128>(p, p.n_post_ffn + l * D, l == DEPTH - 1, __builtin_amdgcn_readfirstlane(t2 >> 6), t2 & 63); }
        if (l != DEPTH - 1) GSYNC();
    }
}

extern "C" void kernel_launch(void* const* d_in, const int* in_sizes, int n_in, void* d_out, int out_size, void* d_ws, size_t ws_size, hipStream_t stream) {
    static int grid_blocks = 0;
    if (grid_blocks == 0) {
        if (n_in != 18 || ws_size < WS_END) { fprintf(stderr, "kernel_launch: unexpected inputs (n_in %d, ws %zu, need %zu)\n", n_in, ws_size, (size_t)WS_END); grid_blocks = -1; return; }
        int dev = 0, cus = 0, per_cu = 0;
        hipGetDevice(&dev);
        hipDeviceGetAttribute(&cus, hipDeviceAttributeMultiprocessorCount, dev);
        hipFuncSetAttribute((const void*)hymba_fwd, hipFuncAttributeMaxDynamicSharedMemorySize, LDS_BYTES);
        hipOccupancyMaxActiveBlocksPerMultiprocessor(&per_cu, (const void*)hymba_fwd, 512, LDS_BYTES);
        if (per_cu < 1) per_cu = 1;
        grid_blocks = cus * per_cu;
    }
    if (grid_blocks < 0) return;
    Params p{};
    const float** pp = (const float**)&p;
    for (int i = 0; i < 18; ++i) pp[i] = (const float*)d_in[i];
    p.out = (float*)d_out; p.ws = (unsigned char*)d_ws;
    void* args[] = {&p};
    hipError_t e = hipLaunchCooperativeKernel((const void*)hymba_fwd, dim3(grid_blocks), dim3(512), args, LDS_BYTES, stream);
    if (e != hipSuccess) fprintf(stderr, "cooperative launch failed: %s (grid %d)\n", hipGetErrorString(e), grid_blocks);
}
```

```cpp
#include <hip/hip_runtime.h>
#include <hip/hip_cooperative_groups.h>
#include <cstdio>
#include <cstdint>
namespace cg = cooperative_groups;
#define REP_PRO 1
#define REP_MIX 1
#define REP_GIN 1
#define REP_GOUT 1
#define REP_GGU 1
#define REP_GDN 1
#define EXTRA_SYNC 0
#define GSYNC() do { xcd_barrier(xb); for (int e_ = 0; e_ < EXTRA_SYNC; ++e_) xcd_barrier(xb); } while (0)

#define LAS __attribute__((address_space(3)))
typedef unsigned short bf16_t;
typedef short bf16x8 __attribute__((ext_vector_type(8)));
typedef float f32x4 __attribute__((ext_vector_type(4)));
typedef float f32x2 __attribute__((ext_vector_type(2)));
typedef unsigned u32x4 __attribute__((ext_vector_type(4)));
typedef unsigned u32x2 __attribute__((ext_vector_type(2)));

constexpr int D = 2048, NBATCH = 4, SEQ = 2048, NMETA = 16, LSEQ = SEQ + NMETA, DEPTH = 4, DB = 32, WIN = 128;
constexpr int MPROMPT = NBATCH * LSEQ;
constexpr int MREAL = MPROMPT + DB;
constexpr int MP = 8448;
constexpr int INDIM = 4608, DFF = 5632, NGU = 2 * DFF, CDIM = 1024;
constexpr int ZQ = 0, ZK = 1024, ZV = 1280, ZGB = 1536, ZGC = 2560, ZHC = 3584;
constexpr float RMS_EPS = 1e-6f;
constexpr int NHEADS = 16;

constexpr size_t O_YP = 0, O_YS = 16777216, O_KP = 16842752, O_VP = 17367040, O_CP = 17891328, O_KS = 17924096, O_VS = 22118400, O_CS = 26312704;

constexpr size_t SZ_WIN = (size_t)INDIM * D * 2, SZ_WOUT = (size_t)D * D * 2, SZ_WGU = (size_t)NGU * D * 2, SZ_WDN = (size_t)D * DFF * 2;
constexpr size_t WS_WIN = 0;
constexpr size_t WS_WOUT = WS_WIN + DEPTH * SZ_WIN;
constexpr size_t WS_WGU = WS_WOUT + DEPTH * SZ_WOUT;
constexpr size_t WS_WDN = WS_WGU + DEPTH * SZ_WGU;
constexpr size_t WS_ZACT = WS_WDN + DEPTH * SZ_WDN;
constexpr size_t WS_MIXIN = WS_ZACT + (size_t)MP * DFF * 2;
constexpr size_t WS_MIXB = WS_MIXIN + (size_t)MP * D * 2;
constexpr size_t WS_MIXB1 = WS_MIXB + (size_t)MP * D * 2;
constexpr size_t WS_HB = WS_MIXB1 + (size_t)MP * D * 2;
constexpr size_t WS_RS = WS_HB + (size_t)MP * D * 2;
constexpr size_t WS_BAR = WS_RS + (size_t)MP * 4;
constexpr size_t WS_END = WS_BAR + 16384;

constexpr int RING_BYTES = 131072, BIAS_OFF = RING_BYTES, LDS_BYTES = 147456;
constexpr int BIAS_STRIDE = 132;
constexpr int MISC_OFF = BIAS_OFF + NHEADS * BIAS_STRIDE * 4;

__device__ __forceinline__ unsigned cvt_pk_bf16(float lo, float hi) { unsigned r; asm volatile("v_cvt_pk_bf16_f32 %0, %1, %2" : "=v"(r) : "v"(lo), "v"(hi)); return r; }
__device__ __forceinline__ float bf_lo(unsigned u) { return __uint_as_float(u << 16); }
__device__ __forceinline__ float bf_hi(unsigned u) { return __uint_as_float(u & 0xffff0000u); }
__device__ __forceinline__ float wave_sum(float v) {
#pragma unroll
    for (int o = 1; o < 64; o <<= 1) v += __shfl_xor(v, o);
    return v;
}
__device__ __forceinline__ float wave_max(float v) {
#pragma unroll
    for (int o = 1; o < 64; o <<= 1) v = fmaxf(v, __shfl_xor(v, o));
    return v;
}
#define LDS_WAIT() asm volatile("s_waitcnt lgkmcnt(0)" ::: "memory")


#define XB_TMO      128
#define XB_XCNT(j)  (256  + 64 * (j))
#define XB_XSUB(j)  (1280 + 64 * (j))
#define XB_XGEN(j)  (2304 + 64 * (j))
#define XB_TOP      3328
#define XB_TOPGEN   3392
#define XCD_BAR_WORDS 3456
#define XB_SPIN_CAP (1u << 18)
__device__ __forceinline__ unsigned xb_ld(unsigned* p)              { return __hip_atomic_load(p, __ATOMIC_RELAXED, __HIP_MEMORY_SCOPE_AGENT); }
__device__ __forceinline__ unsigned xb_add(unsigned* p, unsigned v) { return __hip_atomic_fetch_add(p, v, __ATOMIC_RELAXED, __HIP_MEMORY_SCOPE_AGENT); }
__device__ __forceinline__ unsigned xb_xcc_id() { return (unsigned)__builtin_amdgcn_s_getreg((3 << 11) | 20) & 0xFu; }
#define XB_SPIN(cond, bar) do { unsigned _sp = 0; while (cond) { __builtin_amdgcn_s_sleep(1); \
    if ((++_sp & 255u) == 0u) { if (xb_ld(&(bar)[XB_TMO])) break; if (_sp > XB_SPIN_CAP) { atomicAdd(&(bar)[XB_TMO], 1u); break; } } } } while (0)
struct XcdBarrier { unsigned* bar; unsigned x; volatile LAS unsigned* st; };
__device__ __forceinline__ XcdBarrier xcd_barrier_post(unsigned* bar, volatile LAS unsigned* st) {
    XcdBarrier b; b.bar = bar; b.x = xb_xcc_id(); b.st = st;
    if (threadIdx.x == 0) (void)xb_add(&bar[XB_XCNT(b.x)], 1u);
    return b;
}
__device__ __forceinline__ void xcd_barrier_complete(unsigned* bar, unsigned x, unsigned& nloc, unsigned& nx) {
    const unsigned G = gridDim.x * gridDim.y * gridDim.z;
    unsigned sum, cnt, mine, sp = 0u;
    for (;;) {
        sum = 0u; cnt = 0u; mine = 0u;
#pragma unroll
        for (unsigned j = 0; j < 16; ++j) { const unsigned c = xb_ld(&bar[XB_XCNT(j)]); sum += c; cnt += (c > 0u) ? 1u : 0u; mine = (j == x) ? c : mine; }
        if (sum == G) break;
        __builtin_amdgcn_s_sleep(1);
        if ((++sp & 255u) == 0u) { if (xb_ld(&bar[XB_TMO])) break; if (sp > XB_SPIN_CAP) { atomicAdd(&bar[XB_TMO], 1u); break; } }
    }
    nloc = mine > 0u ? mine : 1u; nx = cnt > 0u ? cnt : 1u;
}
__device__ __forceinline__ void xcd_barrier(const XcdBarrier& b) {
    asm volatile("s_waitcnt vmcnt(0)" ::: "memory");
    __syncthreads();
    if (threadIdx.x == 0) {
        unsigned* bar = b.bar;
        __builtin_amdgcn_s_waitcnt(0);
        unsigned nloc = b.st[0], nx = b.st[1];
        if (nloc == 0u) { xcd_barrier_complete(bar, b.x, nloc, nx); b.st[0] = nloc; b.st[1] = nx; }
        const unsigned old = xb_add(&bar[XB_XSUB(b.x)], 1u);
        const unsigned gen = old / nloc;
        if (old + 1u == (gen + 1u) * nloc) {
            __builtin_amdgcn_fence(__ATOMIC_RELEASE, "agent");
            asm volatile("s_waitcnt vmcnt(0)" ::: "memory");
            const unsigned og = xb_add(&bar[XB_TOP], 1u);
            const unsigned tg = og / nx;
            if (og + 1u == (tg + 1u) * nx) xb_add(&bar[XB_TOPGEN], 1u);
            else XB_SPIN(xb_ld(&bar[XB_TOPGEN]) == tg, bar);
            __builtin_amdgcn_fence(__ATOMIC_ACQUIRE, "agent");
            xb_add(&bar[XB_XGEN(b.x)], 1u);
            asm volatile("s_waitcnt vmcnt(0)" ::: "memory");
        } else {
            XB_SPIN(xb_ld(&bar[XB_XGEN(b.x)]) == gen, bar);
            __builtin_amdgcn_fence(__ATOMIC_ACQUIRE, "agent");
            asm volatile("s_waitcnt vmcnt(0)" ::: "memory");
        }
    }
    __syncthreads();
}

namespace pg8 {
constexpr int BM = 256, BK = 64, HALF = 128, HTB = HALF * BK * 2, STAGE_BYTES = 8 * HTB, NXCD = 8, WGM = 8;
__host__ __device__ __forceinline__ int lds_byte(int r, int c) { const int st = (r >> 4) * 2 + (c >> 5), rr = r & 15, cc = c & 31, ob = rr * 64 + cc * 2; return st * 1024 + (ob ^ (((ob >> 9) & 1) << 5)); }
__host__ __device__ __forceinline__ void stage_rc(int b, int& R, int& C) { const int st = b / 1024, sb = b % 1024, swz = sb ^ (((sb >> 9) & 1) << 5); R = (st >> 1) * 16 + swz / 64; C = (st & 1) * 32 + (swz % 64) / 2; }
__host__ __device__ __forceinline__ int perm32(int rho) { const int n = rho >> 4, i = rho & 15; return 8 * (i >> 2) + 4 * n + (i & 3); }

struct Unit { int pm, pn, kt0, len, part; };
struct Gemm { const bf16_t* A; const bf16_t* Bt; int M, N, K; };

struct StaticOrder {
    int nM, nN, nwg, G, c, nt;
    __host__ __device__ void init(int M, int N, int K, int G_, int c_) { nM = M / BM; nN = N / BM; nwg = nM * nN; G = G_; c = c_; nt = K / BK; }
    __host__ __device__ bool next(int i, Unit& u) const {
        const long L = (long)i * G + c; if (L >= nwg) return false;
        int wgid = (int)L; { const int q = nwg / NXCD, r = nwg % NXCD, xcd = wgid % NXCD, off = wgid / NXCD; wgid = (xcd < r ? xcd * (q + 1) : r * (q + 1) + (xcd - r) * q) + off; }
        const int nig = WGM * nN, gid = wgid / nig, fm = gid * WGM, gsz = (nM - fm) < WGM ? (nM - fm) : WGM;
        u.pm = fm + ((wgid % nig) % gsz); u.pn = (wgid % nig) / gsz; u.kt0 = 0; u.len = nt; u.part = 0; return true;
    }
};
template <int PP> struct StreamKOrder {
    static constexpr int NTILE = (MP / BM) * 8, TP = NTILE * PP;
    int q0, q1;
    __device__ void init(int G, int v) { q0 = (int)((long)v * TP / G); q1 = (int)((long)(v + 1) * TP / G); }
    __device__ bool next(int i, Unit& u) const {
        const int t = q0 / PP + i, s = t * PP; const int a = q0 > s ? q0 : s, b = q1 < s + PP ? q1 : s + PP;
        if (a >= b) return false;
        u.pm = t >> 3; u.pn = t & 7; u.kt0 = 2 * (a - s); u.len = 2 * (b - a); u.part = a > s ? 1 : 0; return true;
    }
    static __device__ __forceinline__ bool is_split(int t, int G) { const int s = t * PP; return (int)(((long)(s + 1) * G - 1) / TP) != (int)(((long)(s + PP) * G - 1) / TP); }
};

template <int MODE> struct Epi {
    static constexpr bool PERM = true;
    bf16_t* O; int ldc; const float* rs; bf16_t* O1;
    __device__ __forceinline__ void operator()(const f32x4 (&acc)[2][2][4][2], const Unit& u, int wr, int wc, int fr, int fq) const {
        const int row0 = u.pm * BM + wr * 64 + fr;
        if constexpr (MODE == 0) {
            const int col0 = u.pn * BM + wc * 32 + 8 * fq;
#pragma unroll
            for (int ai = 0; ai < 2; ++ai)
#pragma unroll
                for (int m = 0; m < 4; ++m) {
                    const int row = row0 + ai * HALF + m * 16;
                    const float s = rs ? rs[row] : 1.f;
                    bf16_t* rowp = (u.part ? O1 : O) + (size_t)row * ldc + col0;
#pragma unroll
                    for (int bj = 0; bj < 2; ++bj) {
                        const f32x4 v0 = acc[ai][bj][m][0] * s, v1 = acc[ai][bj][m][1] * s;
                        u32x4 w; w.x = cvt_pk_bf16(v0[0], v0[1]); w.y = cvt_pk_bf16(v0[2], v0[3]); w.z = cvt_pk_bf16(v1[0], v1[1]); w.w = cvt_pk_bf16(v1[2], v1[3]);
                        *(u32x4*)(rowp + bj * HALF) = w;
                    }
                }
        } else {
            const int col0 = u.pn * HALF + wc * 32 + 8 * fq;
#pragma unroll
            for (int ai = 0; ai < 2; ++ai)
#pragma unroll
                for (int m = 0; m < 4; ++m) {
                    const int row = row0 + ai * HALF + m * 16;
                    const float s = rs[row];
                    float o[8];
#pragma unroll
                    for (int n = 0; n < 2; ++n)
#pragma unroll
                        for (int j = 0; j < 4; ++j) {
                            const float g = acc[ai][0][m][n][j] * s, up = acc[ai][1][m][n][j] * s;
                            o[n * 4 + j] = g * __builtin_amdgcn_rcpf(1.f + __expf(-g)) * up;
                        }
                    u32x4 w; w.x = cvt_pk_bf16(o[0], o[1]); w.y = cvt_pk_bf16(o[2], o[3]); w.z = cvt_pk_bf16(o[4], o[5]); w.w = cvt_pk_bf16(o[6], o[7]);
                    *(u32x4*)(O + (size_t)row * ldc + col0) = w;
                }
        }
    }
};

template <int K, class EpiT, class Sched>
__device__ __forceinline__ void gemm_phase(LAS unsigned char* lds, const Gemm g, const Sched& S, const EpiT& E) {
    int tid_ = threadIdx.x; asm volatile("" : "+v"(tid_));
    const int tid = tid_, wid = __builtin_amdgcn_readfirstlane(tid >> 6), lane = tid & 63, wr = wid >> 2, wc = wid & 3, fr = lane & 15, fq = lane >> 4;
    unsigned voffA[2], voffB[2];
#pragma unroll
    for (int i = 0; i < 2; ++i) { int R, C; stage_rc(tid * 16 + i * 8192, R, C); const int Rb = EpiT::PERM ? ((R & ~31) + perm32(R & 31)) : R;
        voffA[i] = (unsigned)(R * K + C) * 2u; voffB[i] = (unsigned)(Rb * K + C) * 2u; }
    const size_t kstep = (size_t)(BK * 2);
    const size_t hstep = (size_t)HALF * K * 2;
    const size_t tstep = 2 * hstep;
    const unsigned ldsw = (unsigned)wid * 1024u;
    const int aoff = lds_byte(wr * 64 + fr, fq * 8), boff = lds_byte(wc * 32 + fr, fq * 8);
#define PG8_SA(b, h) (((b) * 2 + (h)) * HTB)
#define PG8_SB(b, h) ((4 + (b) * 2 + (h)) * HTB)
#define PG8_STAGE(bufoff, gbase, voff) do { _Pragma("unroll") for (int _i = 0; _i < 2; ++_i) \
        __builtin_amdgcn_global_load_lds((const unsigned*)((const char*)(gbase) + (voff)[_i]), (LAS unsigned*)(lds + (bufoff) + ldsw + _i * 8192), 16, 0, 0); } while (0)
#define PG8_LDA(dst, b, h) do { _Pragma("unroll") for (int m = 0; m < 4; ++m) _Pragma("unroll") for (int k = 0; k < 2; ++k) dst[m][k] = *(const LAS bf16x8*)(lds + PG8_SA(b, h) + aoff + m * 2048 + k * 1024); } while (0)
#define PG8_LDB(dst, b, h) do { _Pragma("unroll") for (int n = 0; n < 2; ++n) _Pragma("unroll") for (int k = 0; k < 2; ++k) dst[n][k] = *(const LAS bf16x8*)(lds + PG8_SB(b, h) + boff + n * 2048 + k * 1024); } while (0)
#define PG8_MMA(ai, bj, At, Bt) do { __builtin_amdgcn_s_setprio(1); _Pragma("unroll") for (int m = 0; m < 4; ++m) _Pragma("unroll") for (int n = 0; n < 2; ++n) _Pragma("unroll") for (int k = 0; k < 2; ++k) \
        acc[ai][bj][m][n] = __builtin_amdgcn_mfma_f32_16x16x32_bf16(Bt[n][k], At[m][k], acc[ai][bj][m][n], 0, 0, 0); __builtin_amdgcn_s_setprio(0); } while (0)
#define PG8_WAIT_V(n) asm volatile("s_waitcnt vmcnt(" #n ")" ::: "memory")
#define PG8_WAIT_L(n) asm volatile("s_waitcnt lgkmcnt(" #n ")" ::: "memory")
#define PG8_BAR __builtin_amdgcn_s_barrier()
#define PG8_SCHED __builtin_amdgcn_sched_barrier(0)
    Unit cur, nxt; int ui = 0;
    if (!S.next(0, cur)) return;
    f32x4 acc[2][2][4][2];
#pragma unroll
    for (int a = 0; a < 2; ++a)
#pragma unroll
        for (int b = 0; b < 2; ++b)
#pragma unroll
            for (int m = 0; m < 4; ++m)
#pragma unroll
                for (int n = 0; n < 2; ++n) acc[a][b][m][n] = (f32x4){0.f, 0.f, 0.f, 0.f};
    bf16x8 At[4][2], B0[2][2], B1[2][2];
    const char* cA = (const char*)g.A + (size_t)cur.pm * tstep + (size_t)cur.kt0 * kstep; const char* cB = (const char*)g.Bt + (size_t)cur.pn * tstep + (size_t)cur.kt0 * kstep;
    PG8_STAGE(PG8_SB(0, 0), cB, voffB); PG8_STAGE(PG8_SB(0, 1), cB + hstep, voffB); PG8_STAGE(PG8_SA(0, 0), cA, voffA); PG8_STAGE(PG8_SA(0, 1), cA + hstep, voffA);
    if (wr == 1) PG8_BAR;
    PG8_WAIT_V(2); PG8_BAR;
    PG8_STAGE(PG8_SB(1, 0), cB + kstep, voffB); PG8_STAGE(PG8_SA(1, 0), cA + kstep, voffA); PG8_STAGE(PG8_SB(1, 1), cB + hstep + kstep, voffB);
    PG8_WAIT_V(6); PG8_BAR;
    for (;;) {
        const bool has_next = S.next(ui + 1, nxt);
        const char* nA = has_next ? (const char*)g.A + (size_t)nxt.pm * tstep + (size_t)nxt.kt0 * kstep : cA; const char* nB = has_next ? (const char*)g.Bt + (size_t)nxt.pn * tstep + (size_t)nxt.kt0 * kstep : cB;
        const int nt = cur.len;
        for (int t = 0; t < nt; t += 2) {
            const bool last = (t == nt - 2);
            const char* a1 = cA + (size_t)(t + 1) * kstep;
            const char* a2 = last ? nA : cA + (size_t)(t + 2) * kstep; const char* b2 = last ? nB : cB + (size_t)(t + 2) * kstep;
            const char* a3 = a2 + kstep; const char* b3 = b2 + kstep;
            PG8_LDB(B0, 0, 0); PG8_LDB(B1, 0, 1); PG8_SCHED; PG8_LDA(At, 0, 0); PG8_STAGE(PG8_SA(1, 1), a1 + hstep, voffA);
            PG8_WAIT_V(8); PG8_WAIT_L(0); PG8_BAR; PG8_MMA(0, 0, At, B0); PG8_MMA(0, 1, At, B1); PG8_BAR; PG8_SCHED;
            PG8_LDA(At, 0, 1); PG8_STAGE(PG8_SB(0, 0), b2, voffB); PG8_STAGE(PG8_SB(0, 1), b2 + hstep, voffB); PG8_STAGE(PG8_SA(0, 0), a2, voffA);
            PG8_WAIT_V(8); PG8_WAIT_L(0); PG8_BAR; PG8_MMA(1, 0, At, B0); PG8_MMA(1, 1, At, B1); PG8_BAR; PG8_SCHED;
            PG8_LDB(B0, 1, 0); PG8_LDB(B1, 1, 1); PG8_SCHED; PG8_LDA(At, 1, 0); PG8_STAGE(PG8_SA(0, 1), a2 + hstep, voffA);
            PG8_WAIT_V(8); PG8_WAIT_L(0); PG8_BAR; PG8_MMA(0, 0, At, B0); PG8_MMA(0, 1, At, B1); PG8_BAR; PG8_SCHED;
            PG8_LDA(At, 1, 1); PG8_STAGE(PG8_SB(1, 0), b3, voffB); PG8_STAGE(PG8_SB(1, 1), b3 + hstep, voffB); PG8_STAGE(PG8_SA(1, 0), a3, voffA);
            PG8_WAIT_V(8); PG8_WAIT_L(0); PG8_BAR; PG8_MMA(1, 0, At, B0); PG8_MMA(1, 1, At, B1); PG8_BAR; PG8_SCHED;
        }
        if (wr == 0) PG8_BAR;
        E(acc, cur, wr, wc, fr, fq);
        if (!has_next) break;
#pragma unroll
        for (int a = 0; a < 2; ++a)
#pragma unroll
            for (int b = 0; b < 2; ++b)
#pragma unroll
                for (int m = 0; m < 4; ++m)
#pragma unroll
                    for (int n = 0; n < 2; ++n) acc[a][b][m][n] = (f32x4){0.f, 0.f, 0.f, 0.f};
        cur = nxt; cA = nA; cB = nB; ++ui;
        if (wr == 1) PG8_BAR;
    }
    PG8_WAIT_V(0);
    PG8_BAR;
#undef PG8_SA
#undef PG8_SB
#undef PG8_STAGE
#undef PG8_LDA
#undef PG8_LDB
#undef PG8_MMA
#undef PG8_WAIT_V
#undef PG8_WAIT_L
#undef PG8_BAR
#undef PG8_SCHED
}
}

struct Params {
    const float *x_prompt, *x_sample, *cache_k, *cache_v, *state_conv, *meta, *rel_bias, *w_in, *conv_w, *sinks, *w_out,
        *n_pre_mix, *n_post_mix, *n_pre_ffn, *n_post_ffn, *w_gate, *w_up, *w_down;
    float* out; unsigned char* ws;
};

__device__ __forceinline__ void transpose_item(const float* __restrict__ W, int K, int N, bf16_t* WT, const float* __restrict__ gain, int mode, LAS unsigned* scr, int item, int lane) {
    const int nblk = N / 64, kb = item / nblk, nb = item % nblk, k0 = 64 * kb, n0 = 64 * nb;
    const int c4 = lane & 15, kq = lane >> 4;
    f32x4 v0[8], v1[8];
#pragma unroll
    for (int i = 0; i < 8; ++i) { const int kp = kq + 4 * i; const float* s = W + (size_t)(k0 + 2 * kp) * N + n0 + 4 * c4; v0[i] = *(const f32x4*)s; v1[i] = *(const f32x4*)(s + N); }
#pragma unroll
    for (int i = 0; i < 8; ++i) { const int kp = kq + 4 * i;
        float g0 = 1.f, g1 = 1.f; if (gain) { g0 = gain[k0 + 2 * kp]; g1 = gain[k0 + 2 * kp + 1]; }
        LAS unsigned* d = scr + (4 * c4) * 33 + kp;
        d[0] = cvt_pk_bf16(v0[i].x * g0, v1[i].x * g1); d[33] = cvt_pk_bf16(v0[i].y * g0, v1[i].y * g1); d[66] = cvt_pk_bf16(v0[i].z * g0, v1[i].z * g1); d[99] = cvt_pk_bf16(v0[i].w * g0, v1[i].w * g1); }
    LDS_WAIT(); __builtin_amdgcn_wave_barrier(); asm volatile("" ::: "memory");
    int rbase = n0;
    if (mode) rbase = ((n0 >> 7) << 8) + (n0 & 127) + (mode == 2 ? 128 : 0);
    const int kc = lane & 7;
#pragma unroll
    for (int j = 0; j < 8; ++j) { const int n = (lane >> 3) + 8 * j; const LAS unsigned* s = scr + n * 33 + 4 * kc;
        u32x4 o; o.x = s[0]; o.y = s[1]; o.z = s[2]; o.w = s[3];
        *(u32x4*)(WT + (size_t)(rbase + n) * K + k0 + 8 * kc) = o; }
    LDS_WAIT(); __builtin_amdgcn_wave_barrier(); asm volatile("" ::: "memory");
}

constexpr int I_IN = (D / 64) * (INDIM / 64), I_OUT = (D / 64) * (D / 64), I_G = (D / 64) * (DFF / 64), I_DN = (DFF / 64) * (D / 64);
constexpr int I_LAYER = I_IN + I_OUT + 2 * I_G + I_DN;
constexpr int I_SPLIT = (I_LAYER * 5 / 8) & ~7;
__device__ __forceinline__ void convert_items(const Params& p, int l, int it0, int it1, int worker, int nw, LAS unsigned char* lds, int wid, int lane) {
    LAS unsigned* scr = (LAS unsigned*)(lds + wid * 16384);
    bf16_t* win = (bf16_t*)(p.ws + WS_WIN) + (size_t)l * INDIM * D; bf16_t* wout = (bf16_t*)(p.ws + WS_WOUT) + (size_t)l * D * D;
    bf16_t* wgu = (bf16_t*)(p.ws + WS_WGU) + (size_t)l * NGU * D; bf16_t* wdn = (bf16_t*)(p.ws + WS_WDN) + (size_t)l * D * DFF;
    for (int it = it0 + worker; it < it1; it += nw) {
        int r = it;
        if (r < I_IN) { transpose_item(p.w_in + (size_t)l * D * INDIM, D, INDIM, win, p.n_pre_mix + l * D, 0, scr, r, lane); continue; } r -= I_IN;
        if (r < I_OUT) { transpose_item(p.w_out + (size_t)l * D * D, D, D, wout, nullptr, 0, scr, r, lane); continue; } r -= I_OUT;
        if (r < I_G) { transpose_item(p.w_gate + (size_t)l * D * DFF, D, DFF, wgu, p.n_pre_ffn + l * D, 1, scr, r, lane); continue; } r -= I_G;
        if (r < I_G) { transpose_item(p.w_up + (size_t)l * D * DFF, D, DFF, wgu, p.n_pre_ffn + l * D, 2, scr, r, lane); continue; } r -= I_G;
        transpose_item(p.w_down + (size_t)l * DFF * D, DFF, D, wdn, nullptr, 0, scr, r, lane);
    }
}
__device__ __forceinline__ void filler(const Params& p, int l, int it0, int it1, int nwg, LAS unsigned char* lds, int wid, int lane) {
    const int G = gridDim.x, r = nwg % G, c = blockIdx.x;
    if (r == 0) convert_items(p, l, it0, it1, c * 8 + wid, G * 8, lds, wid, lane);
    else if (c >= r) convert_items(p, l, it0, it1, (c - r) * 8 + wid, (G - r) * 8, lds, wid, lane);
}

__device__ __forceinline__ void prologue(const Params& p, LAS unsigned char* lds, int wid, int lane) {
    const int gw = blockIdx.x * 8 + wid, NGW = gridDim.x * 8;
    convert_items(p, 0, 0, I_LAYER, gw, NGW, lds, wid, lane);
    bf16_t* HB = (bf16_t*)(p.ws + WS_HB); float* RS = (float*)(p.ws + WS_RS);
    for (int m = gw; m < MREAL; m += NGW) {
        const float* src;
        if (m < MPROMPT) { const int b = m / LSEQ, t = m % LSEQ; src = t < NMETA ? p.meta + (size_t)t * D : p.x_prompt + ((size_t)b * SEQ + (t - NMETA)) * D; }
        else src = p.x_sample + (size_t)(m - MPROMPT) * D;
        const f32x4* xr = (const f32x4*)src + lane; u32x2* hb = (u32x2*)(HB + (size_t)m * D) + lane;
        float ss = 0.f;
#pragma unroll
        for (int j = 0; j < 8; ++j) { const f32x4 v = xr[64 * j]; ss += (v.x * v.x + v.y * v.y) + (v.z * v.z + v.w * v.w); u32x2 w; w.x = cvt_pk_bf16(v.x, v.y); w.y = cvt_pk_bf16(v.z, v.w); hb[64 * j] = w; }
        ss = wave_sum(ss);
        if (lane == 0) RS[m] = 1.f / sqrtf(ss * (1.f / D) + RMS_EPS);
    }
}

template <int PP> __device__ __forceinline__ void postnorm(const Params& p, const float* __restrict__ g, bool last, int wid, int lane) {
    const int gw = blockIdx.x * 8 + wid, NGW = gridDim.x * 8;
    bf16_t* HB = (bf16_t*)(p.ws + WS_HB); float* RS = (float*)(p.ws + WS_RS); const bf16_t* MIXB = (const bf16_t*)(p.ws + WS_MIXB); const bf16_t* MIXB1 = (const bf16_t*)(p.ws + WS_MIXB1);
    for (int m = gw; m < MREAL; m += NGW) {
        const u32x2* mr = (const u32x2*)(MIXB + (size_t)m * D) + lane; const u32x2* mr1 = (const u32x2*)(MIXB1 + (size_t)m * D) + lane;
        u32x2* hb = (u32x2*)(HB + (size_t)m * D) + lane; const f32x4* gr = (const f32x4*)g + lane;
        const int tile0 = (m >> 8) * 8;
        u32x2 w0[8], w1[8], hw[8]; f32x4 gv[8];
#pragma unroll
        for (int j = 0; j < 8; ++j) { w0[j] = mr[64 * j]; w1[j] = mr1[64 * j]; hw[j] = hb[64 * j]; }
#pragma unroll
        for (int j = 0; j < 8; ++j) gv[j] = gr[64 * j];
        f32x4 mv[8]; float ss = 0.f;
#pragma unroll
        for (int j = 0; j < 8; ++j) { mv[j] = (f32x4){bf_lo(w0[j].x), bf_hi(w0[j].x), bf_lo(w0[j].y), bf_hi(w0[j].y)};
            if (pg8::StreamKOrder<PP>::is_split(tile0 + j, (int)gridDim.x)) mv[j] += (f32x4){bf_lo(w1[j].x), bf_hi(w1[j].x), bf_lo(w1[j].y), bf_hi(w1[j].y)};
            ss += (mv[j].x * mv[j].x + mv[j].y * mv[j].y) + (mv[j].z * mv[j].z + mv[j].w * mv[j].w); }
        ss = wave_sum(ss);
        const float r = 1.f / sqrtf(ss * (1.f / D) + RMS_EPS);
        float* yrow = nullptr;
        if (last) { if (m < MPROMPT) { const int b = m / LSEQ, t = m % LSEQ; if (t >= NMETA) yrow = p.out + O_YP + ((size_t)b * SEQ + (t - NMETA)) * D; } else yrow = p.out + O_YS + (size_t)(m - MPROMPT) * D; }
        float s2 = 0.f;
#pragma unroll
        for (int j = 0; j < 8; ++j) {
            const f32x4 hv = (f32x4){bf_lo(hw[j].x), bf_hi(hw[j].x), bf_lo(hw[j].y), bf_hi(hw[j].y)};
            const f32x4 hn = hv + mv[j] * r * gv[j];
            s2 += (hn.x * hn.x + hn.y * hn.y) + (hn.z * hn.z + hn.w * hn.w);
            u32x2 w; w.x = cvt_pk_bf16(hn.x, hn.y); w.y = cvt_pk_bf16(hn.z, hn.w); hb[64 * j] = w;
            if (yrow) ((f32x4*)yrow)[lane + 64 * j] = hn;
        }
        s2 = wave_sum(s2);
        if (lane == 0) RS[m] = 1.f / sqrtf(s2 * (1.f / D) + RMS_EPS);
    }
}

constexpr int AT_KR = 208, AT_KS = 72, AT_VS = 216, AT_PS = 168;
constexpr int AT_K_OFF = 0, AT_V_OFF = AT_KR * AT_KS * 2  , AT_P_OFF = AT_V_OFF + 64 * AT_VS * 2  , AT_P_WAVE = 16 * AT_PS * 2  ;

__device__ __forceinline__ void attn_prompt_unit(LAS unsigned char* lds, int b, int kvh, int qt, const bf16_t* __restrict__ z, bf16_t* mixin, const float* __restrict__ sinks, int tid, int wid, int lane) {
    LAS bf16_t* Ks = (LAS bf16_t*)(lds + AT_K_OFF);
    LAS bf16_t* Vt = (LAS bf16_t*)(lds + AT_V_OFF);
    LAS bf16_t* Pw = (LAS bf16_t*)(lds + AT_P_OFF + wid * AT_P_WAVE);
    const LAS float* biasL = (const LAS float*)(lds + BIAS_OFF);
    const int q0 = qt * 64, rowb = b * LSEQ;
    for (int c = tid; c < AT_KR * 8; c += 512) {
        const int kr = c >> 3, ch = c & 7; int t = q0 - 144 + kr; t = t < 0 ? 0 : (t > LSEQ - 1 ? LSEQ - 1 : t);
        const bf16_t* src = z + (size_t)(rowb + t) * INDIM + kvh * 64 + ch * 8;
        const u32x4 kv = *(const u32x4*)(src + ZK);
        const u32x4 vv = *(const u32x4*)(src + ZV);
        *(LAS u32x4*)(Ks + kr * AT_KS + ch * 8) = kv;
        LAS bf16_t* vd = Vt + (ch * 8) * AT_VS + kr;
        vd[0 * AT_VS] = (bf16_t)(vv.x & 0xffffu); vd[1 * AT_VS] = (bf16_t)(vv.x >> 16);
        vd[2 * AT_VS] = (bf16_t)(vv.y & 0xffffu); vd[3 * AT_VS] = (bf16_t)(vv.y >> 16);
        vd[4 * AT_VS] = (bf16_t)(vv.z & 0xffffu); vd[5 * AT_VS] = (bf16_t)(vv.z >> 16);
        vd[6 * AT_VS] = (bf16_t)(vv.w & 0xffffu); vd[7 * AT_VS] = (bf16_t)(vv.w >> 16);
    }
    __syncthreads();
    const int h = kvh * 4 + (wid & 3), i16 = lane & 15, g = lane >> 4;
    const float sink = sinks[h];
#pragma unroll 1
    for (int tile = 0; tile < 2; ++tile) {
        const int tq0 = q0 + (wid >> 2) * 32 + tile * 16;
        if (tq0 >= LSEQ) continue;
        const int koff = tq0 - q0;
        const int t = tq0 + i16; const int tq = t > LSEQ - 1 ? LSEQ - 1 : t;
        const bf16_t* qp = z + (size_t)(rowb + tq) * INDIM + ZQ + h * 64 + 8 * g;
        const bf16x8 qf0 = *(const bf16x8*)qp, qf1 = *(const bf16x8*)(qp + 32);
        f32x4 s[10];
#pragma unroll
        for (int nt = 0; nt < 10; ++nt) {
            const LAS bf16_t* kp = Ks + (koff + nt * 16 + i16) * AT_KS + 8 * g;
            const bf16x8 k0 = *(const LAS bf16x8*)kp, k1 = *(const LAS bf16x8*)(kp + 32);
            f32x4 a = (f32x4){0.f, 0.f, 0.f, 0.f};
            a = __builtin_amdgcn_mfma_f32_16x16x32_bf16(k0, qf0, a, 0, 0, 0);
            a = __builtin_amdgcn_mfma_f32_16x16x32_bf16(k1, qf1, a, 0, 0, 0);
            s[nt] = a;
        }
        float mx = sink;
#pragma unroll
        for (int nt = 0; nt < 10; ++nt)
#pragma unroll
            for (int r = 0; r < 4; ++r) {
                const int kk = nt * 16 + 4 * g + r; const int dist = 144 + i16 - kk; const int tk = tq0 - 144 + kk;
                const bool ok = dist >= 0 && dist <= WIN && tk >= 0;
                const int dc = dist < 0 ? 0 : (dist > WIN ? WIN : dist);
                const float v = ok ? s[nt][r] * 0.125f + biasL[h * BIAS_STRIDE + dc] : -INFINITY;
                s[nt][r] = v; mx = fmaxf(mx, v);
            }
        mx = fmaxf(mx, __shfl_xor(mx, 16)); mx = fmaxf(mx, __shfl_xor(mx, 32));
        float sum = 0.f;
#pragma unroll
        for (int nt = 0; nt < 10; ++nt) {
            const float e0 = __expf(s[nt][0] - mx), e1 = __expf(s[nt][1] - mx), e2 = __expf(s[nt][2] - mx), e3 = __expf(s[nt][3] - mx);
            sum += (e0 + e1) + (e2 + e3);
            u32x2 w; w.x = cvt_pk_bf16(e0, e1); w.y = cvt_pk_bf16(e2, e3);
            *(LAS u32x2*)(Pw + i16 * AT_PS + nt * 16 + 4 * g) = w;
        }
        sum += __shfl_xor(sum, 16); sum += __shfl_xor(sum, 32);
        const float inv = 1.f / (sum + __expf(sink - mx));
        LDS_WAIT(); __builtin_amdgcn_wave_barrier();
        f32x4 o[4];
#pragma unroll
        for (int dn = 0; dn < 4; ++dn) o[dn] = (f32x4){0.f, 0.f, 0.f, 0.f};
#pragma unroll
        for (int ks = 0; ks < 5; ++ks) {
            const bf16x8 pf = *(const LAS bf16x8*)(Pw + i16 * AT_PS + ks * 32 + 8 * g);
#pragma unroll
            for (int dn = 0; dn < 4; ++dn) {
                const bf16x8 vf = *(const LAS bf16x8*)(Vt + (dn * 16 + i16) * AT_VS + koff + ks * 32 + 8 * g);
                o[dn] = __builtin_amdgcn_mfma_f32_16x16x32_bf16(vf, pf, o[dn], 0, 0, 0);
            }
        }
        if (t < LSEQ) {
            bf16_t* op = mixin + (size_t)(rowb + t) * D + h * 64 + 4 * g;
#pragma unroll
            for (int dn = 0; dn < 4; ++dn) { u32x2 w; w.x = cvt_pk_bf16(o[dn][0] * inv, o[dn][1] * inv); w.y = cvt_pk_bf16(o[dn][2] * inv, o[dn][3] * inv); *(u32x2*)(op + dn * 16) = w; }
        }
        LDS_WAIT(); __builtin_amdgcn_wave_barrier();
    }
    __syncthreads();
}

__device__ __forceinline__ void attn_sample_wave(LAS unsigned char* lds, int l, int b, int h, const Params& p, const bf16_t* __restrict__ z, bf16_t* mixin, int wid, int lane) {
    LAS float* qs = (LAS float*)(lds + wid * 1024);
    LAS float* ps = qs + 64;
    const LAS float* biasL = (const LAS float*)(lds + BIAS_OFF);
    const int kvh = h >> 2;
    const bf16_t* zr = z + (size_t)(MPROMPT + b) * INDIM;
    const float qv = __uint_as_float((unsigned)zr[ZQ + h * 64 + lane] << 16) * 0.125f;
    qs[lane] = qv;
    LDS_WAIT(); __builtin_amdgcn_wave_barrier();
    const float* ck = p.cache_k + (((size_t)l * DB + b) * WIN) * 256 + kvh * 64;
    const float* cv = p.cache_v + (((size_t)l * DB + b) * WIN) * 256 + kvh * 64;
    float sc0 = 0.f, sc1 = 0.f;
    {
        const f32x4* k0 = (const f32x4*)(ck + (size_t)lane * 256); const f32x4* k1 = (const f32x4*)(ck + (size_t)(lane + 64) * 256);
#pragma unroll
        for (int d4 = 0; d4 < 16; ++d4) { const f32x4 q4 = *(const LAS f32x4*)(qs + 4 * d4); const f32x4 a = k0[d4], c = k1[d4];
            sc0 += (a.x * q4.x + a.y * q4.y) + (a.z * q4.z + a.w * q4.w); sc1 += (c.x * q4.x + c.y * q4.y) + (c.z * q4.z + c.w * q4.w); }
    }
    const float knew = __uint_as_float((unsigned)zr[ZK + kvh * 64 + lane] << 16);
    const float sc2 = wave_sum(qv * knew);
    const float sink = p.sinks[l * NHEADS + h];
    const float v0 = sc0 + biasL[h * BIAS_STRIDE + (WIN - lane)], v1 = sc1 + biasL[h * BIAS_STRIDE + (64 - lane)], v2 = sc2 + biasL[h * BIAS_STRIDE];
    float mx = wave_max(fmaxf(v0, v1)); mx = fmaxf(mx, fmaxf(v2, sink));
    const float e0 = __expf(v0 - mx), e1 = __expf(v1 - mx), e2 = __expf(v2 - mx);
    const float sum = wave_sum(e0 + e1) + e2 + __expf(sink - mx);
    ps[lane] = e0; ps[lane + 64] = e1;
    LDS_WAIT(); __builtin_amdgcn_wave_barrier();
    float o = 0.f;
#pragma unroll 8
    for (int s = 0; s < WIN; ++s) o += ps[s] * cv[(size_t)s * 256 + lane];
    o += e2 * __uint_as_float((unsigned)zr[ZV + kvh * 64 + lane] << 16);
    o /= sum;
    const unsigned ob = cvt_pk_bf16(o, o);
    mixin[(size_t)(MPROMPT + b) * D + h * 64 + lane] = (bf16_t)(ob & 0xffffu);
    LDS_WAIT(); __builtin_amdgcn_wave_barrier();
}

__device__ __forceinline__ void conv_row(int l, int m, const Params& p, const bf16_t* __restrict__ z, bf16_t* mixin, int lane) {
    const float* cw = p.conv_w + (size_t)l * 3 * CDIM;
#pragma unroll
    for (int j = 0; j < 2; ++j) {
        const int c0 = lane * 8 + 512 * j;
        const bf16_t* zr = z + (size_t)m * INDIM;
        const u32x4 gbv = *(const u32x4*)(zr + ZGB + c0), gcv = *(const u32x4*)(zr + ZGC + c0), hcv = *(const u32x4*)(zr + ZHC + c0);
        float u0[8], u1[8], u2[8], gb[8];
        const unsigned gbw[4] = {gbv.x, gbv.y, gbv.z, gbv.w}, gcw[4] = {gcv.x, gcv.y, gcv.z, gcv.w}, hcw[4] = {hcv.x, hcv.y, hcv.z, hcv.w};
#pragma unroll
        for (int i = 0; i < 4; ++i) { gb[2 * i] = bf_lo(gbw[i]); gb[2 * i + 1] = bf_hi(gbw[i]); u0[2 * i] = bf_lo(gcw[i]) * bf_lo(hcw[i]); u0[2 * i + 1] = bf_hi(gcw[i]) * bf_hi(hcw[i]); }
        if (m < MPROMPT) {
            const int b = m / LSEQ, t = m % LSEQ;
#pragma unroll
            for (int i = 0; i < 8; ++i) { u1[i] = 0.f; u2[i] = 0.f; }
            if (t >= 1) { const bf16_t* z1 = zr - INDIM; const u32x4 a = *(const u32x4*)(z1 + ZGC + c0), c = *(const u32x4*)(z1 + ZHC + c0);
                const unsigned aw[4] = {a.x, a.y, a.z, a.w}, cw4[4] = {c.x, c.y, c.z, c.w};
#pragma unroll
                for (int i = 0; i < 4; ++i) { u1[2 * i] = bf_lo(aw[i]) * bf_lo(cw4[i]); u1[2 * i + 1] = bf_hi(aw[i]) * bf_hi(cw4[i]); } }
            if (t >= 2) { const bf16_t* z2 = zr - 2 * INDIM; const u32x4 a = *(const u32x4*)(z2 + ZGC + c0), c = *(const u32x4*)(z2 + ZHC + c0);
                const unsigned aw[4] = {a.x, a.y, a.z, a.w}, cw4[4] = {c.x, c.y, c.z, c.w};
#pragma unroll
                for (int i = 0; i < 4; ++i) { u2[2 * i] = bf_lo(aw[i]) * bf_lo(cw4[i]); u2[2 * i + 1] = bf_hi(aw[i]) * bf_hi(cw4[i]); } }
            if (t >= LSEQ - 2) { float* co = p.out + O_CP + (((size_t)l * NBATCH + b) * 2 + (t - (LSEQ - 2))) * CDIM + c0;
                *(f32x4*)co = (f32x4){u0[0], u0[1], u0[2], u0[3]}; *(f32x4*)(co + 4) = (f32x4){u0[4], u0[5], u0[6], u0[7]}; }
        } else {
            const int b = m - MPROMPT;
            const float* st = p.state_conv + (((size_t)l * DB + b) * 2) * CDIM + c0;
            const f32x4 s0a = *(const f32x4*)st, s0b = *(const f32x4*)(st + 4), s1a = *(const f32x4*)(st + CDIM), s1b = *(const f32x4*)(st + CDIM + 4);
            u2[0] = s0a.x; u2[1] = s0a.y; u2[2] = s0a.z; u2[3] = s0a.w; u2[4] = s0b.x; u2[5] = s0b.y; u2[6] = s0b.z; u2[7] = s0b.w;
            u1[0] = s1a.x; u1[1] = s1a.y; u1[2] = s1a.z; u1[3] = s1a.w; u1[4] = s1b.x; u1[5] = s1b.y; u1[6] = s1b.z; u1[7] = s1b.w;
            float* co = p.out + O_CS + (((size_t)l * DB + b) * 2) * CDIM + c0;
            *(f32x4*)co = s1a; *(f32x4*)(co + 4) = s1b;
            *(f32x4*)(co + CDIM) = (f32x4){u0[0], u0[1], u0[2], u0[3]}; *(f32x4*)(co + CDIM + 4) = (f32x4){u0[4], u0[5], u0[6], u0[7]};
        }
        const f32x4 w0a = *(const f32x4*)(cw + c0), w0b = *(const f32x4*)(cw + c0 + 4), w1a = *(const f32x4*)(cw + CDIM + c0), w1b = *(const f32x4*)(cw + CDIM + c0 + 4),
                    w2a = *(const f32x4*)(cw + 2 * CDIM + c0), w2b = *(const f32x4*)(cw + 2 * CDIM + c0 + 4);
        const float w0[8] = {w0a.x, w0a.y, w0a.z, w0a.w, w0b.x, w0b.y, w0b.z, w0b.w}, w1[8] = {w1a.x, w1a.y, w1a.z, w1a.w, w1b.x, w1b.y, w1b.z, w1b.w},
                    w2[8] = {w2a.x, w2a.y, w2a.z, w2a.w, w2b.x, w2b.y, w2b.z, w2b.w};
        float r[8];
#pragma unroll
        for (int i = 0; i < 8; ++i) r[i] = gb[i] * (w0[i] * u2[i] + w1[i] * u1[i] + w2[i] * u0[i]);
        u32x4 w; w.x = cvt_pk_bf16(r[0], r[1]); w.y = cvt_pk_bf16(r[2], r[3]); w.z = cvt_pk_bf16(r[4], r[5]); w.w = cvt_pk_bf16(r[6], r[7]);
        *(u32x4*)(mixin + (size_t)m * D + 1024 + c0) = w;
    }
}

__device__ __forceinline__ void kv_prompt_row(int l, int idx, const Params& p, const bf16_t* __restrict__ z, int lane) {
    const int b = idx >> 7, w = idx & 127;
    const bf16_t* zr = z + (size_t)(b * LSEQ + (LSEQ - WIN) + w) * INDIM;
    const u32x2 kv = *(const u32x2*)(zr + ZK + 4 * lane), vv = *(const u32x2*)(zr + ZV + 4 * lane);
    const size_t o = (((size_t)l * NBATCH + b) * WIN + w) * 256 + 4 * lane;
    *(f32x4*)(p.out + O_KP + o) = (f32x4){bf_lo(kv.x), bf_hi(kv.x), bf_lo(kv.y), bf_hi(kv.y)};
    *(f32x4*)(p.out + O_VP + o) = (f32x4){bf_lo(vv.x), bf_hi(vv.x), bf_lo(vv.y), bf_hi(vv.y)};
}
__device__ __forceinline__ void kv_sample_row(int l, int idx, const Params& p, const bf16_t* __restrict__ z, int lane) {
    const int b = idx >> 7, w = idx & 127;
    const size_t o = (((size_t)l * DB + b) * WIN + w) * 256 + 4 * lane;
    f32x4 kq, vq;
    if (w < WIN - 1) { kq = *(const f32x4*)(p.cache_k + o + 256); vq = *(const f32x4*)(p.cache_v + o + 256); }
    else { const bf16_t* zr = z + (size_t)(MPROMPT + b) * INDIM; const u32x2 kv = *(const u32x2*)(zr + ZK + 4 * lane), vv = *(const u32x2*)(zr + ZV + 4 * lane);
        kq = (f32x4){bf_lo(kv.x), bf_hi(kv.x), bf_lo(kv.y), bf_hi(kv.y)}; vq = (f32x4){bf_lo(vv.x), bf_hi(vv.x), bf_lo(vv.y), bf_hi(vv.y)}; }
    *(f32x4*)(p.out + O_KS + o) = kq; *(f32x4*)(p.out + O_VS + o) = vq;
}

constexpr int NU_ATT = NBATCH * 4 * 33;
constexpr int NU_SATT = DB * 2;
constexpr int NU_CONV = (MREAL + 63) / 64;
constexpr int NU_KVP = NBATCH * WIN / 64;
constexpr int NU_KVS = DB * WIN / 64;
constexpr int NU_B = NU_ATT + NU_SATT + NU_CONV + NU_KVP + NU_KVS;

__device__ __forceinline__ void mixer_phase(const Params& p, int l, LAS unsigned char* lds, int tid, int wid, int lane) {
    const bf16_t* z = (const bf16_t*)(p.ws + WS_ZACT); bf16_t* mixin = (bf16_t*)(p.ws + WS_MIXIN);
    for (int u = blockIdx.x; u < NU_B; u += gridDim.x) {
        int r = u;
        if (r < NU_ATT) { const int qt = r % 33, bk = r / 33; attn_prompt_unit(lds, bk >> 2, bk & 3, qt, z, mixin, p.sinks + l * NHEADS, tid, wid, lane); continue; } r -= NU_ATT;
        if (r < NU_SATT) { attn_sample_wave(lds, l, r >> 1, (r & 1) * 8 + wid, p, z, mixin, wid, lane); continue; } r -= NU_SATT;
        if (r < NU_CONV) { for (int i = 0; i < 8; ++i) { const int m = r * 64 + wid * 8 + i; if (m < MREAL) conv_row(l, m, p, z, mixin, lane); } continue; } r -= NU_CONV;
        if (r < NU_KVP) { for (int i = 0; i < 8; ++i) kv_prompt_row(l, r * 64 + wid * 8 + i, p, z, lane); continue; } r -= NU_KVP;
        for (int i = 0; i < 8; ++i) kv_sample_row(l, r * 64 + wid * 8 + i, p, z, lane);
    }
}

__global__ void __launch_bounds__(512, 2) hymba_fwd(Params p) {
    extern __shared__ __attribute__((aligned(16))) unsigned char lds_raw[];
    LAS unsigned char* lds = (LAS unsigned char*)lds_raw;
    cg::grid_group grid = cg::this_grid();
    const int tid = threadIdx.x, lane = tid & 63, wid = __builtin_amdgcn_readfirstlane(tid >> 6);

    unsigned* barw = (unsigned*)(p.ws + WS_BAR);
    volatile LAS unsigned* xst = (volatile LAS unsigned*)(lds + MISC_OFF);
    if (blockIdx.x == 0) for (int i = tid; i < XCD_BAR_WORDS; i += 512) __hip_atomic_store(barw + i, 0u, __ATOMIC_RELAXED, __HIP_MEMORY_SCOPE_AGENT);
    if (tid < 2) xst[tid] = 0u;
    {
        LAS float* biasL = (LAS float*)(lds + BIAS_OFF);
        for (int i = tid; i < NHEADS * 129; i += 512) {
            const int h = i / 129, d = i % 129;
            int bkt;
            if (d < 16) bkt = d;
            else { const float df = (float)d; bkt = 16 + (int)(logf(df / 16.f) / logf(8.f) * 16.f); bkt = bkt > 31 ? 31 : bkt; }
            biasL[h * BIAS_STRIDE + d] = p.rel_bias[bkt * NHEADS + h];
        }
    }
    for (int rep = 0; rep < REP_PRO; ++rep) prologue(p, lds, wid, lane);
    grid.sync();
    const XcdBarrier xb = xcd_barrier_post(barw, xst);

    bf16_t* ZACT = (bf16_t*)(p.ws + WS_ZACT); bf16_t* MIXIN = (bf16_t*)(p.ws + WS_MIXIN); bf16_t* MIXB = (bf16_t*)(p.ws + WS_MIXB); bf16_t* MIXB1 = (bf16_t*)(p.ws + WS_MIXB1);
    const int vcu = (gridDim.x % 8 == 0) ? (int)((blockIdx.x % 8) * (gridDim.x / 8) + blockIdx.x / 8) : (int)blockIdx.x;
    const bf16_t* HB = (const bf16_t*)(p.ws + WS_HB); const float* RS = (const float*)(p.ws + WS_RS);
#pragma unroll 1
    for (int l = 0; l < DEPTH; ++l) {
        {
            pg8::Gemm g{HB, (const bf16_t*)(p.ws + WS_WIN + l * SZ_WIN), MP, INDIM, D}; pg8::Epi<0> E{ZACT, INDIM, RS, ZACT};
            pg8::StaticOrder S; S.init(MP, INDIM, D, (int)gridDim.x, (int)blockIdx.x);
            for (int rep = 0; rep < REP_GIN; ++rep) pg8::gemm_phase<D, pg8::Epi<0>, pg8::StaticOrder>(lds, g, S, E);
            if (l + 1 < DEPTH) { int t2 = threadIdx.x; asm volatile("" : "+v"(t2)); filler(p, l + 1, 0, I_SPLIT, (MP / 256) * (INDIM / 256), lds, __builtin_amdgcn_readfirstlane(t2 >> 6), t2 & 63); }
        }
        GSYNC();
#ifndef NO_MIX
        for (int rep = 0; rep < REP_MIX; ++rep) { int t2 = threadIdx.x; asm volatile("" : "+v"(t2)); mixer_phase(p, l, lds, t2, __builtin_amdgcn_readfirstlane(t2 >> 6), t2 & 63); }
#endif
        GSYNC();
        {
            pg8::Gemm g{MIXIN, (const bf16_t*)(p.ws + WS_WOUT + l * SZ_WOUT), MP, D, D}; pg8::Epi<0> E{MIXB, D, nullptr, MIXB1};
            pg8::StreamKOrder<D / 128> S; S.init((int)gridDim.x, vcu);
            for (int rep = 0; rep < REP_GOUT; ++rep) pg8::gemm_phase<D, pg8::Epi<0>, pg8::StreamKOrder<D / 128>>(lds, g, S, E);
        }
        GSYNC();
        { int t2 = threadIdx.x; asm volatile("" : "+v"(t2)); postnorm<D / 128>(p, p.n_post_mix + l * D, false, __builtin_amdgcn_readfirstlane(t2 >> 6), t2 & 63); }
        GSYNC();
        {
            pg8::Gemm g{HB, (const bf16_t*)(p.ws + WS_WGU + l * SZ_WGU), MP, NGU, D}; pg8::Epi<1> E{ZACT, DFF, RS, ZACT};
            pg8::StaticOrder S; S.init(MP, NGU, D, (int)gridDim.x, (int)blockIdx.x);
            for (int rep = 0; rep < REP_GGU; ++rep) pg8::gemm_phase<D, pg8::Epi<1>, pg8::StaticOrder>(lds, g, S, E);
            if (l + 1 < DEPTH) { int t2 = threadIdx.x; asm volatile("" : "+v"(t2)); filler(p, l + 1, I_SPLIT, I_LAYER, (MP / 256) * (NGU / 256), lds, __builtin_amdgcn_readfirstlane(t2 >> 6), t2 & 63); }
        }
        GSYNC();
        {
            pg8::Gemm g{ZACT, (const bf16_t*)(p.ws + WS_WDN + l * SZ_WDN), MP, D, DFF}; pg8::Epi<0> E{MIXB, D, nullptr, MIXB1};
            pg8::StreamKOrder<DFF / 128> S; S.init((int)gridDim.x, vcu);
            for (int rep = 0; rep < REP_GDN; ++rep) pg8::gemm_phase<DFF, pg8::Epi<0>, pg8::StreamKOrder<DFF / 128>>(lds, g, S, E);
        }
        GSYNC();
        { int t2 = threadIdx.x; asm volatile("" : "+v"(t2)); postnorm<DFF / 128>(p, p.n_post_ffn + l * D, l == DEPTH - 1, __builtin_amdgcn_readfirstlane(t2 >> 6), t2 & 63); }
        if (l != DEPTH - 1) GSYNC();
    }
}

extern "C" void kernel_launch(void* const* d_in, const int* in_sizes, int n_in, void* d_out, int out_size, void* d_ws, size_t ws_size, hipStream_t stream) {
    static int grid_blocks = 0;
    if (grid_blocks == 0) {
        if (n_in != 18 || ws_size < WS_END) { fprintf(stderr, "kernel_launch: unexpected inputs (n_in %d, ws %zu, need %zu)\n", n_in, ws_size, (size_t)WS_END); grid_blocks = -1; return; }
        int dev = 0, cus = 0, per_cu = 0;
        hipGetDevice(&dev);
        hipDeviceGetAttribute(&cus, hipDeviceAttributeMultiprocessorCount, dev);
        hipFuncSetAttribute((const void*)hymba_fwd, hipFuncAttributeMaxDynamicSharedMemorySize, LDS_BYTES);
        hipOccupancyMaxActiveBlocksPerMultiprocessor(&per_cu, (const void*)hymba_fwd, 512, LDS_BYTES);
        if (per_cu < 1) per_cu = 1;
        grid_blocks = cus * per_cu;
    }
    if (grid_blocks < 0) return;
    Params p{};
    const float** pp = (const float**)&p;
    for (int i = 0; i < 18; ++i) pp[i] = (const float*)d_in[i];
    p.out = (float*)d_out; p.ws = (unsigned char*)d_ws;
    void* args[] = {&p};
    hipError_t e = hipLaunchCooperativeKernel((const void*)hymba_fwd, dim3(grid_blocks), dim3(512), args, LDS_BYTES, stream);
    if (e != hipSuccess) fprintf(stderr, "cooperative launch failed: %s (grid %d)\n", hipGetErrorString(e), grid_blocks);
}
```

```cpp
#include <hip/hip_runtime.h>
#include <hip/hip_cooperative_groups.h>
#include <cstdio>
#include <cstdint>
namespace cg = cooperative_groups;
#define REP_PRO 1
#define REP_MIX 1
#define REP_GIN 1
#define REP_GOUT 1
#define REP_GGU 1
#define REP_GDN 1
#define EXTRA_SYNC 0
#define REP_PN 0
#define REP_FILL 1
#define WGM_SET 5
#define TMASK 0
#define TMULT 4
#define TBLK 0
#define TB(k) do { if (TMASK & (1 << (k))) t0_ = __builtin_amdgcn_s_memrealtime(); } while (0)
#define TE(k) do { if (TMASK & (1 << (k))) tacc_ += __builtin_amdgcn_s_memrealtime() - t0_; } while (0)
#define GSYNC() do { TB(8); xcd_barrier(xb); for (int e_ = 0; e_ < EXTRA_SYNC; ++e_) xcd_barrier(xb); TE(8); } while (0)

#define LAS __attribute__((address_space(3)))
typedef unsigned short bf16_t;
typedef short bf16x8 __attribute__((ext_vector_type(8)));
typedef float f32x4 __attribute__((ext_vector_type(4)));
typedef float f32x2 __attribute__((ext_vector_type(2)));
typedef unsigned u32x4 __attribute__((ext_vector_type(4)));
typedef unsigned u32x2 __attribute__((ext_vector_type(2)));

constexpr int D = 2048, NBATCH = 4, SEQ = 2048, NMETA = 16, LSEQ = SEQ + NMETA, DEPTH = 4, DB = 32, WIN = 128;
constexpr int MPROMPT = NBATCH * LSEQ;
constexpr int MREAL = MPROMPT + DB;
constexpr int MP = 8448;
constexpr int INDIM = 4608, DFF = 5632, NGU = 2 * DFF, CDIM = 1024;
constexpr int ZQ = 0, ZK = 1024, ZV = 1280, ZGB = 1536, ZGC = 2560, ZHC = 3584;
constexpr float RMS_EPS = 1e-6f;
constexpr int NHEADS = 16;

constexpr size_t O_YP = 0, O_YS = 16777216, O_KP = 16842752, O_VP = 17367040, O_CP = 17891328, O_KS = 17924096, O_VS = 22118400, O_CS = 26312704;

constexpr size_t SZ_WIN = (size_t)INDIM * D * 2, SZ_WOUT = (size_t)D * D * 2, SZ_WGU = (size_t)NGU * D * 2, SZ_WDN = (size_t)D * DFF * 2;
constexpr size_t WS_WIN = 0;
constexpr size_t WS_WOUT = WS_WIN + DEPTH * SZ_WIN;
constexpr size_t WS_WGU = WS_WOUT + DEPTH * SZ_WOUT;
constexpr size_t WS_WDN = WS_WGU + DEPTH * SZ_WGU;
constexpr size_t WS_ZACT = WS_WDN + DEPTH * SZ_WDN;
constexpr size_t WS_MIXIN = WS_ZACT + (size_t)MP * DFF * 2;
constexpr size_t WS_MIXB = WS_MIXIN + (size_t)MP * D * 2;
constexpr size_t WS_MIXB1 = WS_MIXB + (size_t)MP * D * 2;
constexpr size_t WS_HB = WS_MIXB1 + (size_t)MP * D * 2;
constexpr size_t WS_RS = WS_HB + (size_t)MP * D * 2;
constexpr size_t WS_BAR = WS_RS + (size_t)MP * 4;
constexpr size_t WS_CNT = WS_BAR + 16384;
constexpr size_t WS_END = WS_CNT + (size_t)DEPTH * 2 * 33 * 64;

constexpr int RING_BYTES = 131072, BIAS_OFF = RING_BYTES, LDS_BYTES = 147456;
constexpr int BIAS_STRIDE = 176, BIAS_PAD = 16;
constexpr int MISC_OFF = BIAS_OFF + NHEADS * BIAS_STRIDE * 4;

__device__ __forceinline__ unsigned cvt_pk_bf16(float lo, float hi) { unsigned r; asm volatile("v_cvt_pk_bf16_f32 %0, %1, %2" : "=v"(r) : "v"(lo), "v"(hi)); return r; }
__device__ __forceinline__ float bf_lo(unsigned u) { return __uint_as_float(u << 16); }
__device__ __forceinline__ float bf_hi(unsigned u) { return __uint_as_float(u & 0xffff0000u); }
__device__ __forceinline__ float wave_sum(float v) {
#pragma unroll
    for (int o = 1; o < 64; o <<= 1) v += __shfl_xor(v, o);
    return v;
}
__device__ __forceinline__ float wave_max(float v) {
#pragma unroll
    for (int o = 1; o < 64; o <<= 1) v = fmaxf(v, __shfl_xor(v, o));
    return v;
}
#define LDS_WAIT() asm volatile("s_waitcnt lgkmcnt(0)" ::: "memory")
#define WT_STORES 0
#define WT_SK 1
#define WT_LAST 0
__device__ __forceinline__ void store16_wt(void* p, u32x4 v, bool wt) {
    if (wt) asm volatile("global_store_dwordx4 %0, %1, off sc1\n\ts_nop 1" :: "v"(p), "v"(v) : "memory");
    else *(u32x4*)p = v;
}
__device__ __forceinline__ void store8_wt(void* p, u32x2 v) {
#if WT_STORES
    asm volatile("global_store_dwordx2 %0, %1, off sc1\n\ts_nop 1" :: "v"(p), "v"(v) : "memory");
#else
    *(u32x2*)p = v;
#endif
}


#define XB_TMO      128
#define XB_XCNT(j)  (256  + 64 * (j))
#define XB_XSUB(j)  (1280 + 64 * (j))
#define XB_XGEN(j)  (2304 + 64 * (j))
#define XB_TOP      3328
#define XB_TOPGEN   3392
#define XCD_BAR_WORDS 3456
#define XB_SPIN_CAP (1u << 18)
__device__ __forceinline__ unsigned xb_ld(unsigned* p)              { return __hip_atomic_load(p, __ATOMIC_RELAXED, __HIP_MEMORY_SCOPE_AGENT); }
__device__ __forceinline__ unsigned xb_add(unsigned* p, unsigned v) { return __hip_atomic_fetch_add(p, v, __ATOMIC_RELAXED, __HIP_MEMORY_SCOPE_AGENT); }
__device__ __forceinline__ unsigned xb_xcc_id() { return (unsigned)__builtin_amdgcn_s_getreg((3 << 11) | 20) & 0xFu; }
#define XB_SPIN(cond, bar) do { unsigned _sp = 0; while (cond) { __builtin_amdgcn_s_sleep(1); \
    if ((++_sp & 255u) == 0u) { if (xb_ld(&(bar)[XB_TMO])) break; if (_sp > XB_SPIN_CAP) { atomicAdd(&(bar)[XB_TMO], 1u); break; } } } } while (0)
struct XcdBarrier { unsigned* bar; unsigned x; volatile LAS unsigned* st; };
__device__ __forceinline__ XcdBarrier xcd_barrier_post(unsigned* bar, volatile LAS unsigned* st) {
    XcdBarrier b; b.bar = bar; b.x = xb_xcc_id(); b.st = st;
    if (threadIdx.x == 0) (void)xb_add(&bar[XB_XCNT(b.x)], 1u);
    return b;
}
__device__ __forceinline__ void xcd_barrier_complete(unsigned* bar, unsigned x, unsigned& nloc, unsigned& nx) {
    const unsigned G = gridDim.x * gridDim.y * gridDim.z;
    unsigned sum, cnt, mine, sp = 0u;
    for (;;) {
        sum = 0u; cnt = 0u; mine = 0u;
#pragma unroll
        for (unsigned j = 0; j < 16; ++j) { const unsigned c = xb_ld(&bar[XB_XCNT(j)]); sum += c; cnt += (c > 0u) ? 1u : 0u; mine = (j == x) ? c : mine; }
        if (sum == G) break;
        __builtin_amdgcn_s_sleep(1);
        if ((++sp & 255u) == 0u) { if (xb_ld(&bar[XB_TMO])) break; if (sp > XB_SPIN_CAP) { atomicAdd(&bar[XB_TMO], 1u); break; } }
    }
    nloc = mine > 0u ? mine : 1u; nx = cnt > 0u ? cnt : 1u;
}
__device__ __forceinline__ void xcd_barrier(const XcdBarrier& b) {
    asm volatile("s_waitcnt vmcnt(0)" ::: "memory");
    __syncthreads();
    if (threadIdx.x == 0) {
        unsigned* bar = b.bar;
        __builtin_amdgcn_s_waitcnt(0);
        unsigned nloc = b.st[0], nx = b.st[1];
        if (nloc == 0u) { xcd_barrier_complete(bar, b.x, nloc, nx); b.st[0] = nloc; b.st[1] = nx; }
        const unsigned old = xb_add(&bar[XB_XSUB(b.x)], 1u);
        const unsigned gen = old / nloc;
        if (old + 1u == (gen + 1u) * nloc) {
            __builtin_amdgcn_fence(__ATOMIC_RELEASE, "agent");
            asm volatile("s_waitcnt vmcnt(0)" ::: "memory");
            const unsigned og = xb_add(&bar[XB_TOP], 1u);
            const unsigned tg = og / nx;
            if (og + 1u == (tg + 1u) * nx) xb_add(&bar[XB_TOPGEN], 1u);
            else XB_SPIN(xb_ld(&bar[XB_TOPGEN]) == tg, bar);
            __builtin_amdgcn_fence(__ATOMIC_ACQUIRE, "agent");
            xb_add(&bar[XB_XGEN(b.x)], 1u);
            asm volatile("s_waitcnt vmcnt(0)" ::: "memory");
        } else {
            XB_SPIN(xb_ld(&bar[XB_XGEN(b.x)]) == gen, bar);
            __builtin_amdgcn_fence(__ATOMIC_ACQUIRE, "agent");
            asm volatile("s_waitcnt vmcnt(0)" ::: "memory");
        }
    }
    __syncthreads();
}

namespace pg8 {
constexpr int BM = 256, BK = 64, HALF = 128, HTB = HALF * BK * 2, STAGE_BYTES = 8 * HTB, NXCD = 8, WGM = WGM_SET;
__host__ __device__ __forceinline__ int lds_byte(int r, int c) { const int st = (r >> 4) * 2 + (c >> 5), rr = r & 15, cc = c & 31, ob = rr * 64 + cc * 2; return st * 1024 + (ob ^ (((ob >> 9) & 1) << 5)); }
__host__ __device__ __forceinline__ void stage_rc(int b, int& R, int& C) { const int st = b / 1024, sb = b % 1024, swz = sb ^ (((sb >> 9) & 1) << 5); R = (st >> 1) * 16 + swz / 64; C = (st & 1) * 32 + (swz % 64) / 2; }
__host__ __device__ __forceinline__ int perm32(int rho) { const int n = rho >> 4, i = rho & 15; return 8 * (i >> 2) + 4 * n + (i & 3); }

struct Unit { int pm, pn, kt0, len, part; };
struct Gemm { const bf16_t* A; const bf16_t* Bt; int M, N, K; };

struct StaticOrder {
    static constexpr bool WT_ALL = false;
    int nM, nN, nwg, G, c, nt;
    __host__ __device__ void init(int M, int N, int K, int G_, int c_) { nM = M / BM; nN = N / BM; nwg = nM * nN; G = G_; c = c_; nt = K / BK; }
    __host__ __device__ bool next(int i, Unit& u) const {
        const long L = (long)i * G + c; if (L >= nwg) return false;
        int wgid = (int)L; { const int q = nwg / NXCD, r = nwg % NXCD, xcd = wgid % NXCD, off = wgid / NXCD; wgid = (xcd < r ? xcd * (q + 1) : r * (q + 1) + (xcd - r) * q) + off; }
        const int nig = WGM * nN, gid = wgid / nig, fm = gid * WGM, gsz = (nM - fm) < WGM ? (nM - fm) : WGM;
        u.pm = fm + ((wgid % nig) % gsz); u.pn = (wgid % nig) / gsz; u.kt0 = 0; u.len = nt; u.part = 0; return true;
    }
};
template <int PP> struct StreamKOrder {
    static constexpr bool WT_ALL = (WT_SK != 0);
    static constexpr int NTILE = (MP / BM) * 8, TP = NTILE * PP;
    int q0, q1;
    __device__ void init(int G, int v) { q0 = (int)((long)v * TP / G); q1 = (int)((long)(v + 1) * TP / G); }
    __device__ bool next(int i, Unit& u) const {
        const int t = q0 / PP + i, s = t * PP; const int a = q0 > s ? q0 : s, b = q1 < s + PP ? q1 : s + PP;
        if (a >= b) return false;
        u.pm = t >> 3; u.pn = t & 7; u.kt0 = 2 * (a - s); u.len = 2 * (b - a); u.part = a > s ? 1 : 0; return true;
    }
    static __device__ __forceinline__ bool is_split(int t, int G) { const int s = t * PP; return (int)(((long)(s + 1) * G - 1) / TP) != (int)(((long)(s + PP) * G - 1) / TP); }
};

template <int MODE> struct Epi {
    static constexpr bool PERM = true;
    bf16_t* O; int ldc; const float* rs; bf16_t* O1;
    __device__ __forceinline__ void operator()(const f32x4 (&acc)[2][2][4][2], const Unit& u, int wr, int wc, int fr, int fq, bool wt) const {
        const int row0 = u.pm * BM + wr * 64 + fr;
        if constexpr (MODE == 0) {
            const int col0 = u.pn * BM + wc * 32 + 8 * fq;
#pragma unroll
            for (int ai = 0; ai < 2; ++ai)
#pragma unroll
                for (int m = 0; m < 4; ++m) {
                    const int row = row0 + ai * HALF + m * 16;
                    bf16_t* rowp = (u.part ? O1 : O) + (size_t)row * ldc + col0;
#pragma unroll
                    for (int bj = 0; bj < 2; ++bj) {
                        const f32x4 v0 = acc[ai][bj][m][0], v1 = acc[ai][bj][m][1];
                        u32x4 w; w.x = cvt_pk_bf16(v0[0], v0[1]); w.y = cvt_pk_bf16(v0[2], v0[3]); w.z = cvt_pk_bf16(v1[0], v1[1]); w.w = cvt_pk_bf16(v1[2], v1[3]);
                        store16_wt(rowp + bj * HALF, w, wt);
                    }
                }
        } else {
            const int col0 = u.pn * HALF + wc * 32 + 8 * fq;
#pragma unroll
            for (int ai = 0; ai < 2; ++ai)
#pragma unroll
                for (int m = 0; m < 4; ++m) {
                    const int row = row0 + ai * HALF + m * 16;
                    float o[8];
#pragma unroll
                    for (int n = 0; n < 2; ++n)
#pragma unroll
                        for (int j = 0; j < 4; ++j) {
                            const float g = acc[ai][0][m][n][j], up = acc[ai][1][m][n][j];
                            o[n * 4 + j] = (g * up) * __builtin_amdgcn_rcpf(1.f + __builtin_amdgcn_exp2f(g * -1.4426950408889634f));
                        }
                    u32x4 w; w.x = cvt_pk_bf16(o[0], o[1]); w.y = cvt_pk_bf16(o[2], o[3]); w.z = cvt_pk_bf16(o[4], o[5]); w.w = cvt_pk_bf16(o[6], o[7]);
                    store16_wt(O + (size_t)row * ldc + col0, w, wt);
                }
        }
    }
};

template <int K, class EpiT, class Sched>
__device__ __forceinline__ void gemm_phase(LAS unsigned char* lds, const Gemm g, const Sched& S, const EpiT& E) {
    int tid_ = threadIdx.x; asm volatile("" : "+v"(tid_));
    const int tid = tid_, wid = __builtin_amdgcn_readfirstlane(tid >> 6), lane = tid & 63, wr = wid >> 2, wc = wid & 3, fr = lane & 15, fq = lane >> 4;
    unsigned voffA[2], voffB[2];
#pragma unroll
    for (int i = 0; i < 2; ++i) { int R, C; stage_rc(tid * 16 + i * 8192, R, C); const int Rb = EpiT::PERM ? ((R & ~31) + perm32(R & 31)) : R;
        voffA[i] = (unsigned)(R * K + C) * 2u; voffB[i] = (unsigned)(Rb * K + C) * 2u; }
    const size_t kstep = (size_t)(BK * 2);
    const size_t hstep = (size_t)HALF * K * 2;
    const size_t tstep = 2 * hstep;
    const unsigned ldsw = (unsigned)wid * 1024u;
    const int aoff = lds_byte(wr * 64 + fr, fq * 8), boff = lds_byte(wc * 32 + fr, fq * 8);
#define PG8_SA(b, h) (((b) * 2 + (h)) * HTB)
#define PG8_SB(b, h) ((4 + (b) * 2 + (h)) * HTB)
#define PG8_STAGE(bufoff, gbase, voff) do { _Pragma("unroll") for (int _i = 0; _i < 2; ++_i) \
        __builtin_amdgcn_global_load_lds((const unsigned*)((const char*)(gbase) + (voff)[_i]), (LAS unsigned*)(lds + (bufoff) + ldsw + _i * 8192), 16, 0, 0); } while (0)
#define PG8_LDA(dst, b, h) do { _Pragma("unroll") for (int m = 0; m < 4; ++m) _Pragma("unroll") for (int k = 0; k < 2; ++k) dst[m][k] = *(const LAS bf16x8*)(lds + PG8_SA(b, h) + aoff + m * 2048 + k * 1024); } while (0)
#define PG8_LDB(dst, b, h) do { _Pragma("unroll") for (int n = 0; n < 2; ++n) _Pragma("unroll") for (int k = 0; k < 2; ++k) dst[n][k] = *(const LAS bf16x8*)(lds + PG8_SB(b, h) + boff + n * 2048 + k * 1024); } while (0)
#define PG8_MMA(ai, bj, At, Bt) do { __builtin_amdgcn_s_setprio(1); _Pragma("unroll") for (int m = 0; m < 4; ++m) _Pragma("unroll") for (int n = 0; n < 2; ++n) _Pragma("unroll") for (int k = 0; k < 2; ++k) \
        acc[ai][bj][m][n] = __builtin_amdgcn_mfma_f32_16x16x32_bf16(Bt[n][k], At[m][k], acc[ai][bj][m][n], 0, 0, 0); __builtin_amdgcn_s_setprio(0); } while (0)
#define PG8_WAIT_V(n) asm volatile("s_waitcnt vmcnt(" #n ")" ::: "memory")
#define PG8_WAIT_L(n) asm volatile("s_waitcnt lgkmcnt(" #n ")" ::: "memory")
#define PG8_BAR __builtin_amdgcn_s_barrier()
#define PG8_SCHED __builtin_amdgcn_sched_barrier(0)
    Unit cur, nxt; int ui = 0;
    if (!S.next(0, cur)) return;
    f32x4 acc[2][2][4][2];
#pragma unroll
    for (int a = 0; a < 2; ++a)
#pragma unroll
        for (int b = 0; b < 2; ++b)
#pragma unroll
            for (int m = 0; m < 4; ++m)
#pragma unroll
                for (int n = 0; n < 2; ++n) acc[a][b][m][n] = (f32x4){0.f, 0.f, 0.f, 0.f};
    bf16x8 At[4][2], B0[2][2], B1[2][2];
    const char* cA = (const char*)g.A + (size_t)cur.pm * tstep + (size_t)cur.kt0 * kstep; const char* cB = (const char*)g.Bt + (size_t)cur.pn * tstep + (size_t)cur.kt0 * kstep;
    PG8_STAGE(PG8_SB(0, 0), cB, voffB); PG8_STAGE(PG8_SB(0, 1), cB + hstep, voffB); PG8_STAGE(PG8_SA(0, 0), cA, voffA); PG8_STAGE(PG8_SA(0, 1), cA + hstep, voffA);
    if (wr == 1) PG8_BAR;
    PG8_WAIT_V(2); PG8_BAR;
    PG8_STAGE(PG8_SB(1, 0), cB + kstep, voffB); PG8_STAGE(PG8_SA(1, 0), cA + kstep, voffA); PG8_STAGE(PG8_SB(1, 1), cB + hstep + kstep, voffB);
    PG8_WAIT_V(6); PG8_BAR;
    for (;;) {
        const bool has_next = S.next(ui + 1, nxt);
        const char* nA = has_next ? (const char*)g.A + (size_t)nxt.pm * tstep + (size_t)nxt.kt0 * kstep : cA; const char* nB = has_next ? (const char*)g.Bt + (size_t)nxt.pn * tstep + (size_t)nxt.kt0 * kstep : cB;
        const int nt = cur.len;
        for (int t = 0; t < nt; t += 2) {
            const bool last = (t == nt - 2);
            const char* a1 = cA + (size_t)(t + 1) * kstep;
            const char* a2 = last ? nA : cA + (size_t)(t + 2) * kstep; const char* b2 = last ? nB : cB + (size_t)(t + 2) * kstep;
            const char* a3 = a2 + kstep; const char* b3 = b2 + kstep;
            PG8_LDB(B0, 0, 0); PG8_LDB(B1, 0, 1); PG8_SCHED; PG8_LDA(At, 0, 0); PG8_STAGE(PG8_SA(1, 1), a1 + hstep, voffA);
            PG8_WAIT_V(8); PG8_WAIT_L(0); PG8_BAR; PG8_MMA(0, 0, At, B0); PG8_MMA(0, 1, At, B1); PG8_BAR; PG8_SCHED;
            PG8_LDA(At, 0, 1); PG8_STAGE(PG8_SB(0, 0), b2, voffB); PG8_STAGE(PG8_SB(0, 1), b2 + hstep, voffB); PG8_STAGE(PG8_SA(0, 0), a2, voffA);
            PG8_WAIT_V(8); PG8_WAIT_L(0); PG8_BAR; PG8_MMA(1, 0, At, B0); PG8_MMA(1, 1, At, B1); PG8_BAR; PG8_SCHED;
            PG8_LDB(B0, 1, 0); PG8_LDB(B1, 1, 1); PG8_SCHED; PG8_LDA(At, 1, 0); PG8_STAGE(PG8_SA(0, 1), a2 + hstep, voffA);
            PG8_WAIT_V(8); PG8_WAIT_L(0); PG8_BAR; PG8_MMA(0, 0, At, B0); PG8_MMA(0, 1, At, B1); PG8_BAR; PG8_SCHED;
            PG8_LDA(At, 1, 1); PG8_STAGE(PG8_SB(1, 0), b3, voffB); PG8_STAGE(PG8_SB(1, 1), b3 + hstep, voffB); PG8_STAGE(PG8_SA(1, 0), a3, voffA);
            PG8_WAIT_V(8); PG8_WAIT_L(0); PG8_BAR; PG8_MMA(1, 0, At, B0); PG8_MMA(1, 1, At, B1); PG8_BAR; PG8_SCHED;
        }
        if (wr == 0) PG8_BAR;
        E(acc, cur, wr, wc, fr, fq, Sched::WT_ALL ? true : (WT_LAST != 0 && !has_next));
        if (!has_next) break;
#pragma unroll
        for (int a = 0; a < 2; ++a)
#pragma unroll
            for (int b = 0; b < 2; ++b)
#pragma unroll
                for (int m = 0; m < 4; ++m)
#pragma unroll
                    for (int n = 0; n < 2; ++n) acc[a][b][m][n] = (f32x4){0.f, 0.f, 0.f, 0.f};
        cur = nxt; cA = nA; cB = nB; ++ui;
        if (wr == 1) PG8_BAR;
    }
    PG8_WAIT_V(0);
    PG8_BAR;
#undef PG8_SA
#undef PG8_SB
#undef PG8_STAGE
#undef PG8_LDA
#undef PG8_LDB
#undef PG8_MMA
#undef PG8_WAIT_V
#undef PG8_WAIT_L
#undef PG8_BAR
#undef PG8_SCHED
}
}

struct Params {
    const float *x_prompt, *x_sample, *cache_k, *cache_v, *state_conv, *meta, *rel_bias, *w_in, *conv_w, *sinks, *w_out,
        *n_pre_mix, *n_post_mix, *n_pre_ffn, *n_post_ffn, *w_gate, *w_up, *w_down;
    float* out; unsigned char* ws;
};

constexpr int I_IN = (D / 64) * (INDIM / 64), I_OUT = (D / 64) * (D / 64), I_G = (D / 64) * (DFF / 64), I_DN = (DFF / 64) * (D / 64);
constexpr int I_LAYER = I_IN + I_OUT + 2 * I_G + I_DN;
struct ItemDesc { const float* W; const float* gain; bf16_t* WT; int K, N, mode, k0, n0; };
struct ItemRegs { f32x4 v0[8], v1[8]; f32x2 gg[8]; };
__device__ __forceinline__ void item_decode(const Params& p, int l, int it, ItemDesc& d) {
    int r = it;
    if (r < I_IN) { d.W = p.w_in + (size_t)l * D * INDIM; d.K = D; d.N = INDIM; d.WT = (bf16_t*)(p.ws + WS_WIN) + (size_t)l * INDIM * D; d.gain = p.n_pre_mix + l * D; d.mode = 0; }
    else if ((r -= I_IN) < I_OUT) { d.W = p.w_out + (size_t)l * D * D; d.K = D; d.N = D; d.WT = (bf16_t*)(p.ws + WS_WOUT) + (size_t)l * D * D; d.gain = nullptr; d.mode = 0; }
    else if ((r -= I_OUT) < I_G) { d.W = p.w_gate + (size_t)l * D * DFF; d.K = D; d.N = DFF; d.WT = (bf16_t*)(p.ws + WS_WGU) + (size_t)l * NGU * D; d.gain = p.n_pre_ffn + l * D; d.mode = 1; }
    else if ((r -= I_G) < I_G) { d.W = p.w_up + (size_t)l * D * DFF; d.K = D; d.N = DFF; d.WT = (bf16_t*)(p.ws + WS_WGU) + (size_t)l * NGU * D; d.gain = p.n_pre_ffn + l * D; d.mode = 2; }
    else { r -= I_G; d.W = p.w_down + (size_t)l * DFF * D; d.K = DFF; d.N = D; d.WT = (bf16_t*)(p.ws + WS_WDN) + (size_t)l * D * DFF; d.gain = nullptr; d.mode = 0; }
    const int nblk = d.N / 64; d.k0 = 64 * (r / nblk); d.n0 = 64 * (r % nblk);
}
__device__ __forceinline__ void item_load(const ItemDesc& d, int lane, ItemRegs& R) {
    const int c4 = lane & 15, kq = lane >> 4;
#pragma unroll
    for (int i = 0; i < 8; ++i) { const int kp = kq + 4 * i; const float* s = d.W + (size_t)(d.k0 + 2 * kp) * d.N + d.n0 + 4 * c4; R.v0[i] = *(const f32x4*)s; R.v1[i] = *(const f32x4*)(s + d.N); }
#pragma unroll
    for (int i = 0; i < 8; ++i) { const int kp = kq + 4 * i; R.gg[i] = d.gain ? *(const f32x2*)(d.gain + d.k0 + 2 * kp) : (f32x2){1.f, 1.f}; }
}
__device__ __forceinline__ void item_finish(const ItemDesc& d, LAS unsigned* scr, int lane, const ItemRegs& R) {
    const int c4 = lane & 15, kq = lane >> 4;
#pragma unroll
    for (int i = 0; i < 8; ++i) { const int kp = kq + 4 * i; const float g0 = R.gg[i].x, g1 = R.gg[i].y;
        LAS unsigned* q = scr + (4 * c4) * 33 + kp;
        q[0] = cvt_pk_bf16(R.v0[i].x * g0, R.v1[i].x * g1); q[33] = cvt_pk_bf16(R.v0[i].y * g0, R.v1[i].y * g1); q[66] = cvt_pk_bf16(R.v0[i].z * g0, R.v1[i].z * g1); q[99] = cvt_pk_bf16(R.v0[i].w * g0, R.v1[i].w * g1); }
    LDS_WAIT(); __builtin_amdgcn_wave_barrier(); asm volatile("" ::: "memory");
    int rbase = d.n0;
    if (d.mode) rbase = ((d.n0 >> 7) << 8) + (d.n0 & 127) + (d.mode == 2 ? 128 : 0);
    const int kc = lane & 7;
#pragma unroll
    for (int j = 0; j < 8; ++j) { const int n = (lane >> 3) + 8 * j; const LAS unsigned* s = scr + n * 33 + 4 * kc;
        u32x4 o; o.x = s[0]; o.y = s[1]; o.z = s[2]; o.w = s[3];
        *(u32x4*)(d.WT + (size_t)(rbase + n) * d.K + d.k0 + 8 * kc) = o; }
    LDS_WAIT(); __builtin_amdgcn_wave_barrier(); asm volatile("" ::: "memory");
}
__device__ __forceinline__ void convert_items(const Params& p, int l, int it0, int it1, int worker, int nw, LAS unsigned char* lds, int wid, int lane) {
    LAS unsigned* scr = (LAS unsigned*)(lds + wid * 16384);
    int it = it0 + worker;
    if (it >= it1) return;
    ItemDesc dA, dB; ItemRegs A, B;
    item_decode(p, l, it, dA); item_load(dA, lane, A);
    for (;;) {
        const int itB = it + nw; const bool hB = itB < it1;
        if (hB) { item_decode(p, l, itB, dB); item_load(dB, lane, B); }
        item_finish(dA, scr, lane, A);
        if (!hB) break;
        const int itA = itB + nw; const bool hA = itA < it1;
        if (hA) { item_decode(p, l, itA, dA); item_load(dA, lane, A); }
        item_finish(dB, scr, lane, B);
        if (!hA) break;
        it = itA;
    }
}
__device__ __forceinline__ void filler(const Params& p, int l, int it0, int it1, int nwg, LAS unsigned char* lds, int wid, int lane) {
    const int G = gridDim.x, r = nwg % G, c = blockIdx.x;
    if (r == 0) convert_items(p, l, it0, it1, c * 8 + wid, G * 8, lds, wid, lane);
    else if (c >= r) convert_items(p, l, it0, it1, (c - r) * 8 + wid, (G - r) * 8, lds, wid, lane);
}

__device__ __forceinline__ void prologue(const Params& p, LAS unsigned char* lds, int wid, int lane) {
    const int gw = blockIdx.x * 8 + wid, NGW = gridDim.x * 8;
    convert_items(p, 0, 0, I_IN, gw, NGW, lds, wid, lane);
    bf16_t* HB = (bf16_t*)(p.ws + WS_HB); float* RS = (float*)(p.ws + WS_RS);
    for (int m = gw; m < MREAL; m += NGW) {
        const float* src;
        if (m < MPROMPT) { const int b = m / LSEQ, t = m % LSEQ; src = t < NMETA ? p.meta + (size_t)t * D : p.x_prompt + ((size_t)b * SEQ + (t - NMETA)) * D; }
        else src = p.x_sample + (size_t)(m - MPROMPT) * D;
        const f32x4* xr = (const f32x4*)src + lane; u32x2* hb = (u32x2*)(HB + (size_t)m * D) + lane;
        float ss = 0.f; f32x4 v[8];
#pragma unroll
        for (int j = 0; j < 8; ++j) { v[j] = xr[64 * j]; ss += (v[j].x * v[j].x + v[j].y * v[j].y) + (v[j].z * v[j].z + v[j].w * v[j].w); }
        ss = wave_sum(ss);
        const float r = 1.f / sqrtf(ss * (1.f / D) + RMS_EPS);
#pragma unroll
        for (int j = 0; j < 8; ++j) { u32x2 w; w.x = cvt_pk_bf16(v[j].x * r, v[j].y * r); w.y = cvt_pk_bf16(v[j].z * r, v[j].w * r); hb[64 * j] = w; }
        if (lane == 0) RS[m] = r;
    }
}

template <int PP> __device__ __forceinline__ void postnorm_row(const Params& p, const float* __restrict__ g, bool last, int m, int lane, bool dry) {
    bf16_t* HB = (bf16_t*)(p.ws + WS_HB); float* RS = (float*)(p.ws + WS_RS); const bf16_t* MIXB = (const bf16_t*)(p.ws + WS_MIXB); const bf16_t* MIXB1 = (const bf16_t*)(p.ws + WS_MIXB1);
    const u32x2* mr = (const u32x2*)(MIXB + (size_t)m * D) + lane; const u32x2* mr1 = (const u32x2*)(MIXB1 + (size_t)m * D) + lane;
    u32x2* hb = (u32x2*)(HB + (size_t)m * D) + lane; const f32x4* gr = (const f32x4*)g + lane;
    const int tile0 = (m >> 8) * 8;
    u32x2 w0[8], w1[8], hw[8]; f32x4 gv[8];
#pragma unroll
    for (int j = 0; j < 8; ++j) { w0[j] = mr[64 * j]; w1[j] = mr1[64 * j]; hw[j] = hb[64 * j]; }
#pragma unroll
    for (int j = 0; j < 8; ++j) gv[j] = gr[64 * j];
    f32x4 mv[8]; float ss = 0.f;
#pragma unroll
    for (int j = 0; j < 8; ++j) { mv[j] = (f32x4){bf_lo(w0[j].x), bf_hi(w0[j].x), bf_lo(w0[j].y), bf_hi(w0[j].y)};
        if (pg8::StreamKOrder<PP>::is_split(tile0 + j, (int)gridDim.x)) mv[j] += (f32x4){bf_lo(w1[j].x), bf_hi(w1[j].x), bf_lo(w1[j].y), bf_hi(w1[j].y)};
        ss += (mv[j].x * mv[j].x + mv[j].y * mv[j].y) + (mv[j].z * mv[j].z + mv[j].w * mv[j].w); }
    ss = wave_sum(ss);
    const float r = 1.f / sqrtf(ss * (1.f / D) + RMS_EPS);
    float* yrow = nullptr;
    if (last) { if (m < MPROMPT) { const int b = m / LSEQ, t = m % LSEQ; if (t >= NMETA) yrow = p.out + O_YP + ((size_t)b * SEQ + (t - NMETA)) * D; } else yrow = p.out + O_YS + (size_t)(m - MPROMPT) * D; }
    const float rinv = 1.f / RS[m];
    float s2 = 0.f; f32x4 hn[8];
#pragma unroll
    for (int j = 0; j < 8; ++j) {
        const f32x4 hv = (f32x4){bf_lo(hw[j].x), bf_hi(hw[j].x), bf_lo(hw[j].y), bf_hi(hw[j].y)};
        hn[j] = hv * rinv + mv[j] * r * gv[j];
        s2 += (hn[j].x * hn[j].x + hn[j].y * hn[j].y) + (hn[j].z * hn[j].z + hn[j].w * hn[j].w);
        if (yrow) ((f32x4*)yrow)[lane + 64 * j] = hn[j];
    }
    s2 = wave_sum(s2);
    const float rn = 1.f / sqrtf(s2 * (1.f / D) + RMS_EPS);
#pragma unroll
    for (int j = 0; j < 8; ++j) { u32x2 w; w.x = cvt_pk_bf16(hn[j].x * rn, hn[j].y * rn); w.y = cvt_pk_bf16(hn[j].z * rn, hn[j].w * rn); (dry ? (u32x2*)(p.ws + WS_ZACT) + (size_t)m * (D / 4) + lane : hb)[64 * j] = w; }
    if (lane == 0 && !dry) RS[m] = rn;
}
template <int PP> __device__ __forceinline__ void postnorm_row2(const Params& p, const float* __restrict__ g, bool last, int m0, int lane) {
    bf16_t* HB = (bf16_t*)(p.ws + WS_HB); float* RS = (float*)(p.ws + WS_RS); const bf16_t* MIXB = (const bf16_t*)(p.ws + WS_MIXB); const bf16_t* MIXB1 = (const bf16_t*)(p.ws + WS_MIXB1);
    const int tile0 = (m0 >> 8) * 8;
    const f32x4* gr = (const f32x4*)g + lane;
    u32x2 w0[2][8], w1[2][8], hw[2][8]; f32x4 gv[8];
#pragma unroll
    for (int e = 0; e < 2; ++e) {
        const u32x2* mr = (const u32x2*)(MIXB + (size_t)(m0 + e) * D) + lane; const u32x2* mr1 = (const u32x2*)(MIXB1 + (size_t)(m0 + e) * D) + lane; const u32x2* hb = (const u32x2*)(HB + (size_t)(m0 + e) * D) + lane;
#pragma unroll
        for (int j = 0; j < 8; ++j) { w0[e][j] = mr[64 * j]; w1[e][j] = mr1[64 * j]; hw[e][j] = hb[64 * j]; }
    }
#pragma unroll
    for (int j = 0; j < 8; ++j) gv[j] = gr[64 * j];
#pragma unroll
    for (int e = 0; e < 2; ++e) {
        const int m = m0 + e;
        f32x4 mv[8]; float ss = 0.f;
#pragma unroll
        for (int j = 0; j < 8; ++j) { mv[j] = (f32x4){bf_lo(w0[e][j].x), bf_hi(w0[e][j].x), bf_lo(w0[e][j].y), bf_hi(w0[e][j].y)};
            if (pg8::StreamKOrder<PP>::is_split(tile0 + j, (int)gridDim.x)) mv[j] += (f32x4){bf_lo(w1[e][j].x), bf_hi(w1[e][j].x), bf_lo(w1[e][j].y), bf_hi(w1[e][j].y)};
            ss += (mv[j].x * mv[j].x + mv[j].y * mv[j].y) + (mv[j].z * mv[j].z + mv[j].w * mv[j].w); }
        ss = wave_sum(ss);
        const float r = 1.f / sqrtf(ss * (1.f / D) + RMS_EPS);
        float* yrow = nullptr;
        if (last) { if (m < MPROMPT) { const int b = m / LSEQ, t = m % LSEQ; if (t >= NMETA) yrow = p.out + O_YP + ((size_t)b * SEQ + (t - NMETA)) * D; } else yrow = p.out + O_YS + (size_t)(m - MPROMPT) * D; }
        u32x2* hbw = (u32x2*)(HB + (size_t)m * D) + lane;
        const float rinv = 1.f / RS[m];
        float s2 = 0.f; f32x4 hn[8];
#pragma unroll
        for (int j = 0; j < 8; ++j) {
            const f32x4 hv = (f32x4){bf_lo(hw[e][j].x), bf_hi(hw[e][j].x), bf_lo(hw[e][j].y), bf_hi(hw[e][j].y)};
            hn[j] = hv * rinv + mv[j] * r * gv[j];
            s2 += (hn[j].x * hn[j].x + hn[j].y * hn[j].y) + (hn[j].z * hn[j].z + hn[j].w * hn[j].w);
            if (yrow) ((f32x4*)yrow)[lane + 64 * j] = hn[j];
        }
        s2 = wave_sum(s2);
        const float rn = 1.f / sqrtf(s2 * (1.f / D) + RMS_EPS);
#pragma unroll
        for (int j = 0; j < 8; ++j) { u32x2 w; w.x = cvt_pk_bf16(hn[j].x * rn, hn[j].y * rn); w.y = cvt_pk_bf16(hn[j].z * rn, hn[j].w * rn); hbw[64 * j] = w; }
        if (lane == 0) RS[m] = rn;
    }
}
template <int PP> __device__ __forceinline__ void postnorm(const Params& p, const float* __restrict__ g, bool last, int wid, int lane, bool dry = false) {
    const int gw = blockIdx.x * 8 + wid, NGW = gridDim.x * 8;
    for (int m = gw; m < MREAL; m += NGW) postnorm_row<PP>(p, g, last, m, lane, dry);
}
template <int PP> __device__ __forceinline__ void sk_postnorm(const Params& p, const pg8::StreamKOrder<PP>& S, unsigned* cnt, const float* __restrict__ g, bool last, int vcu, int tid, int wid, int lane, unsigned long long& tacc_, unsigned long long& t0_) {
    const int G = gridDim.x, gwv = vcu * 8 + wid, NGW = G * 8;
    constexpr int NMAIN = 8192 / 32;
    TB(11);
    asm volatile("s_waitcnt vmcnt(0)" ::: "memory");
    __syncthreads();
    TE(11);
    TB(12);
    if (tid == 0) {
#if !WT_SK
        __builtin_amdgcn_fence(__ATOMIC_RELEASE, "agent");
        asm volatile("s_waitcnt vmcnt(0)" ::: "memory");
#endif
        pg8::Unit u; for (int i = 0; S.next(i, u); ++i) (void)xb_add(cnt + 16 * u.pm, 1u);
        for (int c = vcu; c < NMAIN + 1; c += G) {
            int pm = c >> 3;
            if (c >= NMAIN) break;
            unsigned want = 0; for (int j = 0; j < 8; ++j) want += 1u + (pg8::StreamKOrder<PP>::is_split(8 * pm + j, G) ? 1u : 0u);
            unsigned sp = 0; while (xb_ld(cnt + 16 * pm) < want) { __builtin_amdgcn_s_sleep(1); if (++sp > (1u << 22)) break; }
        }
        if (vcu * 8 < MREAL - 8192) {
            unsigned want = 0; for (int j = 0; j < 8; ++j) want += 1u + (pg8::StreamKOrder<PP>::is_split(8 * 32 + j, G) ? 1u : 0u);
            unsigned sp = 0; while (xb_ld(cnt + 16 * 32) < want) { __builtin_amdgcn_s_sleep(1); if (++sp > (1u << 22)) break; }
        }
        __builtin_amdgcn_fence(__ATOMIC_ACQUIRE, "agent");
        asm volatile("s_waitcnt vmcnt(0)" ::: "memory");
    }
    __syncthreads();
    TE(12);
    TB(13);
    for (int c = vcu; c < NMAIN; c += G)
        for (int i = 0; i < 4; i += 2) postnorm_row2<PP>(p, g, last, 32 * c + 4 * wid + i, lane);
    for (int i = gwv; i < MREAL - 8192; i += NGW) postnorm_row<PP>(p, g, last, 8192 + i, lane, false);
    TE(13);
}

constexpr int AT_QT = 128, AT_NT = 4, AT_KR = 304, AT_KS = 72, AT_VS = 312, AT_PS = 168;
constexpr int AT_K_OFF = 0, AT_V_OFF = AT_KR * AT_KS * 2  , AT_P_OFF = AT_V_OFF + 64 * AT_VS * 2  , AT_P_WAVE = 16 * AT_PS * 2  ;
static_assert(AT_P_OFF + 8 * AT_P_WAVE <= RING_BYTES && (AT_V_OFF % 16) == 0 && (AT_P_OFF % 16) == 0, "attention LDS map");

__device__ __forceinline__ void attn_prompt_unit(LAS unsigned char* lds, int b, int kvh, int qt, const bf16_t* __restrict__ z, bf16_t* mixin, const float* __restrict__ sinks, int tid, int wid, int lane) {
    LAS bf16_t* Ks = (LAS bf16_t*)(lds + AT_K_OFF);
    LAS bf16_t* Vt = (LAS bf16_t*)(lds + AT_V_OFF);
    LAS bf16_t* Pw = (LAS bf16_t*)(lds + AT_P_OFF + wid * AT_P_WAVE);
    const LAS float* biasL = (const LAS float*)(lds + BIAS_OFF);
    const int q0 = qt * AT_QT, rowb = b * LSEQ;
    const int h = kvh * 4 + (wid & 3), i16 = lane & 15, g = lane >> 4;
    const int ntile = AT_NT + ((qt == 15 && (wid >> 2) == 0) ? 1 : 0);
    bf16x8 qf[AT_NT + 1][2];
#pragma unroll
    for (int tile = 0; tile < AT_NT + 1; ++tile) {
        const int tq0 = tile < AT_NT ? q0 + (wid >> 2) * (AT_QT / 2) + tile * 16 : 2048;
        int tq = tq0 + i16; tq = tq > LSEQ - 1 ? LSEQ - 1 : tq;
        const bf16_t* qp = z + (size_t)(rowb + tq) * INDIM + ZQ + h * 64 + 8 * g;
        if (tile < ntile) { qf[tile][0] = *(const bf16x8*)qp; qf[tile][1] = *(const bf16x8*)(qp + 32); }
        else { qf[tile][0] = (bf16x8){0, 0, 0, 0, 0, 0, 0, 0}; qf[tile][1] = qf[tile][0]; }
    }
    const float sink = sinks[h];
    {
        constexpr int NIT = (AT_KR * 8 + 511) / 512;
        u32x4 kv[NIT], vv[NIT];
#pragma unroll
        for (int it = 0; it < NIT; ++it) {
            const int c = tid + it * 512;
            if (it < NIT - 1 || c < AT_KR * 8) {
                const int kr = c >> 3, ch = c & 7; int t = q0 - 144 + kr; t = t < 0 ? 0 : (t > LSEQ - 1 ? LSEQ - 1 : t);
                const bf16_t* src = z + (size_t)(rowb + t) * INDIM + kvh * 64 + ch * 8;
                kv[it] = *(const u32x4*)(src + ZK); vv[it] = *(const u32x4*)(src + ZV);
            }
        }
#pragma unroll
        for (int it = 0; it < NIT; ++it) {
            const int c = tid + it * 512;
            if (it < NIT - 1 || c < AT_KR * 8) {
                const int kr = c >> 3, ch = c & 7;
                *(LAS u32x4*)(Ks + kr * AT_KS + ch * 8) = kv[it];
                LAS bf16_t* vd = Vt + (ch * 8) * AT_VS + kr;
                vd[0 * AT_VS] = (bf16_t)(vv[it].x & 0xffffu); vd[1 * AT_VS] = (bf16_t)(vv[it].x >> 16);
                vd[2 * AT_VS] = (bf16_t)(vv[it].y & 0xffffu); vd[3 * AT_VS] = (bf16_t)(vv[it].y >> 16);
                vd[4 * AT_VS] = (bf16_t)(vv[it].z & 0xffffu); vd[5 * AT_VS] = (bf16_t)(vv[it].z >> 16);
                vd[6 * AT_VS] = (bf16_t)(vv[it].w & 0xffffu); vd[7 * AT_VS] = (bf16_t)(vv[it].w >> 16);
            }
        }
    }
    __syncthreads();
#pragma unroll
    for (int tile = 0; tile < AT_NT + 1; ++tile) {
        if (tile >= ntile) break;
        const int tq0 = tile < AT_NT ? q0 + (wid >> 2) * (AT_QT / 2) + tile * 16 : 2048;
        const int koff = tq0 - q0;
        const int t = tq0 + i16;
        f32x4 s[10];
#pragma unroll
        for (int nt = 1; nt < 10; ++nt) {
            const LAS bf16_t* kp = Ks + (koff + nt * 16 + i16) * AT_KS + 8 * g;
            const bf16x8 k0 = *(const LAS bf16x8*)kp, k1 = *(const LAS bf16x8*)(kp + 32);
            f32x4 a = (f32x4){0.f, 0.f, 0.f, 0.f};
            a = __builtin_amdgcn_mfma_f32_16x16x32_bf16(k0, qf[tile][0], a, 0, 0, 0);
            a = __builtin_amdgcn_mfma_f32_16x16x32_bf16(k1, qf[tile][1], a, 0, 0, 0);
            s[nt] = a;
        }
        const LAS float* bp = biasL + h * BIAS_STRIDE + BIAS_PAD + 144 + i16 - 4 * g;
        float mx = sink;
        if (tq0 >= 144) {
#pragma unroll
            for (int nt = 1; nt < 10; ++nt)
#pragma unroll
                for (int r = 0; r < 4; ++r) { const float v = s[nt][r] * 0.125f + bp[-(nt * 16 + r)]; s[nt][r] = v; mx = fmaxf(mx, v); }
        } else {
#pragma unroll
            for (int nt = 1; nt < 10; ++nt)
#pragma unroll
                for (int r = 0; r < 4; ++r) { const int tk = tq0 - 144 + nt * 16 + 4 * g + r; const float v = tk >= 0 ? s[nt][r] * 0.125f + bp[-(nt * 16 + r)] : -INFINITY; s[nt][r] = v; mx = fmaxf(mx, v); }
        }
        mx = fmaxf(mx, __shfl_xor(mx, 16)); mx = fmaxf(mx, __shfl_xor(mx, 32));
        float sum = 0.f;
        *(LAS u32x2*)(Pw + i16 * AT_PS + 4 * g) = (u32x2){0u, 0u};
#pragma unroll
        for (int nt = 1; nt < 10; ++nt) {
            const float e0 = __expf(s[nt][0] - mx), e1 = __expf(s[nt][1] - mx), e2 = __expf(s[nt][2] - mx), e3 = __expf(s[nt][3] - mx);
            sum += (e0 + e1) + (e2 + e3);
            u32x2 w; w.x = cvt_pk_bf16(e0, e1); w.y = cvt_pk_bf16(e2, e3);
            *(LAS u32x2*)(Pw + i16 * AT_PS + nt * 16 + 4 * g) = w;
        }
        sum += __shfl_xor(sum, 16); sum += __shfl_xor(sum, 32);
        const float inv = 1.f / (sum + __expf(sink - mx));
        LDS_WAIT(); __builtin_amdgcn_wave_barrier();
        f32x4 o[4];
#pragma unroll
        for (int dn = 0; dn < 4; ++dn) o[dn] = (f32x4){0.f, 0.f, 0.f, 0.f};
#pragma unroll
        for (int ks = 0; ks < 5; ++ks) {
            const bf16x8 pf = *(const LAS bf16x8*)(Pw + i16 * AT_PS + ks * 32 + 8 * g);
#pragma unroll
            for (int dn = 0; dn < 4; ++dn) {
                const bf16x8 vf = *(const LAS bf16x8*)(Vt + (dn * 16 + i16) * AT_VS + koff + ks * 32 + 8 * g);
                o[dn] = __builtin_amdgcn_mfma_f32_16x16x32_bf16(vf, pf, o[dn], 0, 0, 0);
            }
        }
        if (t < LSEQ) {
            bf16_t* op = mixin + (size_t)(rowb + t) * D + h * 64 + 4 * g;
#pragma unroll
            for (int dn = 0; dn < 4; ++dn) { u32x2 w; w.x = cvt_pk_bf16(o[dn][0] * inv, o[dn][1] * inv); w.y = cvt_pk_bf16(o[dn][2] * inv, o[dn][3] * inv); *(u32x2*)(op + dn * 16) = w; }
        }
        LDS_WAIT(); __builtin_amdgcn_wave_barrier();
    }
    __syncthreads();
}

__device__ __forceinline__ void attn_sample_wave(LAS unsigned char* lds, int l, int b, int h, const Params& p, const bf16_t* __restrict__ z, bf16_t* mixin, int wid, int lane) {
    LAS float* qs = (LAS float*)(lds + wid * 1024);
    LAS float* ps = qs + 64;
    const LAS float* biasL = (const LAS float*)(lds + BIAS_OFF);
    const int kvh = h >> 2;
    const bf16_t* zr = z + (size_t)(MPROMPT + b) * INDIM;
    const float qv = __uint_as_float((unsigned)zr[ZQ + h * 64 + lane] << 16) * 0.125f;
    qs[lane] = qv;
    LDS_WAIT(); __builtin_amdgcn_wave_barrier();
    const float* ck = p.cache_k + (((size_t)l * DB + b) * WIN) * 256 + kvh * 64;
    const float* cv = p.cache_v + (((size_t)l * DB + b) * WIN) * 256 + kvh * 64;
    float sc0 = 0.f, sc1 = 0.f;
    {
        const f32x4* k0 = (const f32x4*)(ck + (size_t)lane * 256); const f32x4* k1 = (const f32x4*)(ck + (size_t)(lane + 64) * 256);
#pragma unroll
        for (int d4 = 0; d4 < 16; ++d4) { const f32x4 q4 = *(const LAS f32x4*)(qs + 4 * d4); const f32x4 a = k0[d4], c = k1[d4];
            sc0 += (a.x * q4.x + a.y * q4.y) + (a.z * q4.z + a.w * q4.w); sc1 += (c.x * q4.x + c.y * q4.y) + (c.z * q4.z + c.w * q4.w); }
    }
    const float knew = __uint_as_float((unsigned)zr[ZK + kvh * 64 + lane] << 16);
    const float sc2 = wave_sum(qv * knew);
    const float sink = p.sinks[l * NHEADS + h];
    const float v0 = sc0 + biasL[h * BIAS_STRIDE + BIAS_PAD + (WIN - lane)], v1 = sc1 + biasL[h * BIAS_STRIDE + BIAS_PAD + (64 - lane)], v2 = sc2 + biasL[h * BIAS_STRIDE + BIAS_PAD];
    float mx = wave_max(fmaxf(v0, v1)); mx = fmaxf(mx, fmaxf(v2, sink));
    const float e0 = __expf(v0 - mx), e1 = __expf(v1 - mx), e2 = __expf(v2 - mx);
    const float sum = wave_sum(e0 + e1) + e2 + __expf(sink - mx);
    ps[lane] = e0; ps[lane + 64] = e1;
    LDS_WAIT(); __builtin_amdgcn_wave_barrier();
    const int sg = lane >> 4, dq = lane & 15;
    f32x4 oa = (f32x4){0.f, 0.f, 0.f, 0.f}, ob4 = (f32x4){0.f, 0.f, 0.f, 0.f};
#pragma unroll
    for (int it = 0; it < 2; ++it) {
        f32x4 vr[16];
#pragma unroll
        for (int i = 0; i < 16; ++i) vr[i] = *(const f32x4*)(cv + (size_t)(sg + 4 * (i + 16 * it)) * 256 + 4 * dq);
#pragma unroll
        for (int i = 0; i < 16; i += 2) { oa += vr[i] * ps[sg + 4 * (i + 16 * it)]; ob4 += vr[i + 1] * ps[sg + 4 * (i + 1 + 16 * it)]; }
    }
    oa += ob4;
#pragma unroll
    for (int c = 0; c < 4; ++c) { oa[c] += __shfl_xor(oa[c], 16); oa[c] += __shfl_xor(oa[c], 32); }
    if (sg == 0) {
        const u32x2 vn = *(const u32x2*)(zr + ZV + kvh * 64 + 4 * dq);
        const float rs_ = 1.f / sum;
        const float o0 = (oa[0] + e2 * bf_lo(vn.x)) * rs_, o1 = (oa[1] + e2 * bf_hi(vn.x)) * rs_, o2 = (oa[2] + e2 * bf_lo(vn.y)) * rs_, o3 = (oa[3] + e2 * bf_hi(vn.y)) * rs_;
        u32x2 w; w.x = cvt_pk_bf16(o0, o1); w.y = cvt_pk_bf16(o2, o3);
        *(u32x2*)(mixin + (size_t)(MPROMPT + b) * D + h * 64 + 4 * dq) = w;
    }
    LDS_WAIT(); __builtin_amdgcn_wave_barrier();
}

__device__ __forceinline__ void unpack8(const u32x4 a, float (&o)[8]) { o[0] = bf_lo(a.x); o[1] = bf_hi(a.x); o[2] = bf_lo(a.y); o[3] = bf_hi(a.y); o[4] = bf_lo(a.z); o[5] = bf_hi(a.z); o[6] = bf_lo(a.w); o[7] = bf_hi(a.w); }
__device__ __forceinline__ void conv_row(int l, int m, const Params& p, const bf16_t* __restrict__ z, bf16_t* mixin, int lane) {
    const float* cw = p.conv_w + (size_t)l * 3 * CDIM;
    const bool prompt = m < MPROMPT;
    const int b = prompt ? m / LSEQ : m - MPROMPT, t = prompt ? m % LSEQ : 0;
    const bf16_t* zr = z + (size_t)m * INDIM;
    const bf16_t* z1 = (prompt && t >= 1) ? zr - INDIM : zr;
    const bf16_t* z2 = (prompt && t >= 2) ? zr - 2 * INDIM : zr;
    const float k1 = (prompt && t >= 1) ? 1.f : 0.f, k2 = (prompt && t >= 2) ? 1.f : 0.f;
    const float* st = p.state_conv + (((size_t)l * DB + (prompt ? 0 : b)) * 2) * CDIM;
    u32x4 gbv[2], gcv[2], hcv[2], a1[2], c1[2], a2[2], c2[2]; f32x4 sv[2][4], wv[2][6];
#pragma unroll
    for (int j = 0; j < 2; ++j) {
        const int c0 = lane * 8 + 512 * j;
        gbv[j] = *(const u32x4*)(zr + ZGB + c0); gcv[j] = *(const u32x4*)(zr + ZGC + c0); hcv[j] = *(const u32x4*)(zr + ZHC + c0);
        a1[j] = *(const u32x4*)(z1 + ZGC + c0); c1[j] = *(const u32x4*)(z1 + ZHC + c0); a2[j] = *(const u32x4*)(z2 + ZGC + c0); c2[j] = *(const u32x4*)(z2 + ZHC + c0);
        if (!prompt) { sv[j][0] = *(const f32x4*)(st + c0); sv[j][1] = *(const f32x4*)(st + c0 + 4); sv[j][2] = *(const f32x4*)(st + CDIM + c0); sv[j][3] = *(const f32x4*)(st + CDIM + c0 + 4); }
#pragma unroll
        for (int i = 0; i < 3; ++i) { wv[j][2 * i] = *(const f32x4*)(cw + i * CDIM + c0); wv[j][2 * i + 1] = *(const f32x4*)(cw + i * CDIM + c0 + 4); }
    }
#pragma unroll
    for (int j = 0; j < 2; ++j) {
        const int c0 = lane * 8 + 512 * j;
        float gb[8], gc[8], hc[8], u0[8], u1[8], u2[8], x[8], y[8];
        unpack8(gbv[j], gb); unpack8(gcv[j], gc); unpack8(hcv[j], hc);
#pragma unroll
        for (int i = 0; i < 8; ++i) u0[i] = gc[i] * hc[i];
        if (prompt) {
            unpack8(a1[j], x); unpack8(c1[j], y);
#pragma unroll
            for (int i = 0; i < 8; ++i) u1[i] = x[i] * y[i] * k1;
            unpack8(a2[j], x); unpack8(c2[j], y);
#pragma unroll
            for (int i = 0; i < 8; ++i) u2[i] = x[i] * y[i] * k2;
            if (t >= LSEQ - 2) { float* co = p.out + O_CP + (((size_t)l * NBATCH + b) * 2 + (t - (LSEQ - 2))) * CDIM + c0;
                *(f32x4*)co = (f32x4){u0[0], u0[1], u0[2], u0[3]}; *(f32x4*)(co + 4) = (f32x4){u0[4], u0[5], u0[6], u0[7]}; }
        } else {
#pragma unroll
            for (int i = 0; i < 4; ++i) { u2[i] = sv[j][0][i]; u2[4 + i] = sv[j][1][i]; u1[i] = sv[j][2][i]; u1[4 + i] = sv[j][3][i]; }
            float* co = p.out + O_CS + (((size_t)l * DB + b) * 2) * CDIM + c0;
            *(f32x4*)co = sv[j][2]; *(f32x4*)(co + 4) = sv[j][3];
            *(f32x4*)(co + CDIM) = (f32x4){u0[0], u0[1], u0[2], u0[3]}; *(f32x4*)(co + CDIM + 4) = (f32x4){u0[4], u0[5], u0[6], u0[7]};
        }
        float r[8];
#pragma unroll
        for (int i = 0; i < 8; ++i) { const float w0 = wv[j][i >> 2][i & 3], w1 = wv[j][2 + (i >> 2)][i & 3], w2 = wv[j][4 + (i >> 2)][i & 3]; r[i] = gb[i] * (w0 * u2[i] + w1 * u1[i] + w2 * u0[i]); }
        u32x4 w; w.x = cvt_pk_bf16(r[0], r[1]); w.y = cvt_pk_bf16(r[2], r[3]); w.z = cvt_pk_bf16(r[4], r[5]); w.w = cvt_pk_bf16(r[6], r[7]);
        *(u32x4*)(mixin + (size_t)m * D + 1024 + c0) = w;
    }
}

__device__ __forceinline__ void conv_job4(int l, int m0, const Params& p, const bf16_t* __restrict__ z, bf16_t* mixin, int lane) {
    const float* cw = p.conv_w + (size_t)l * 3 * CDIM;
    const int b = m0 / LSEQ, t0 = m0 % LSEQ;
    const float kprev = t0 > 0 ? 1.f : 0.f;
    const bf16_t* zr = z + (size_t)m0 * INDIM;
    const bf16_t* zp = t0 > 0 ? zr - 2 * INDIM : zr;
#pragma unroll
    for (int j = 0; j < 2; ++j) {
        const int c0 = lane * 8 + 512 * j;
        u32x4 gcv[6], hcv[6], gbv[4]; f32x4 wv[6];
        gcv[0] = *(const u32x4*)(zp + ZGC + c0); hcv[0] = *(const u32x4*)(zp + ZHC + c0);
        gcv[1] = *(const u32x4*)(zp + INDIM + ZGC + c0); hcv[1] = *(const u32x4*)(zp + INDIM + ZHC + c0);
#pragma unroll
        for (int r = 0; r < 4; ++r) { gcv[2 + r] = *(const u32x4*)(zr + (size_t)r * INDIM + ZGC + c0); hcv[2 + r] = *(const u32x4*)(zr + (size_t)r * INDIM + ZHC + c0); gbv[r] = *(const u32x4*)(zr + (size_t)r * INDIM + ZGB + c0); }
#pragma unroll
        for (int i = 0; i < 3; ++i) { wv[2 * i] = *(const f32x4*)(cw + i * CDIM + c0); wv[2 * i + 1] = *(const f32x4*)(cw + i * CDIM + c0 + 4); }
        float u[6][8];
#pragma unroll
        for (int r = 0; r < 6; ++r) { float x[8], y[8]; unpack8(gcv[r], x); unpack8(hcv[r], y); const float k = r < 2 ? kprev : 1.f;
#pragma unroll
            for (int i = 0; i < 8; ++i) u[r][i] = x[i] * y[i] * k; }
#pragma unroll
        for (int r = 0; r < 4; ++r) {
            float gb[8], o[8]; unpack8(gbv[r], gb);
#pragma unroll
            for (int i = 0; i < 8; ++i) { const float w0 = wv[i >> 2][i & 3], w1 = wv[2 + (i >> 2)][i & 3], w2 = wv[4 + (i >> 2)][i & 3]; o[i] = gb[i] * (w0 * u[r][i] + w1 * u[r + 1][i] + w2 * u[r + 2][i]); }
            u32x4 w; w.x = cvt_pk_bf16(o[0], o[1]); w.y = cvt_pk_bf16(o[2], o[3]); w.z = cvt_pk_bf16(o[4], o[5]); w.w = cvt_pk_bf16(o[6], o[7]);
            *(u32x4*)(mixin + (size_t)(m0 + r) * D + 1024 + c0) = w;
        }
        if (t0 == LSEQ - 4) {
#pragma unroll
            for (int r = 0; r < 2; ++r) { float* co = p.out + O_CP + (((size_t)l * NBATCH + b) * 2 + r) * CDIM + c0;
                *(f32x4*)co = (f32x4){u[4 + r][0], u[4 + r][1], u[4 + r][2], u[4 + r][3]}; *(f32x4*)(co + 4) = (f32x4){u[4 + r][4], u[4 + r][5], u[4 + r][6], u[4 + r][7]}; }
        }
    }
}

__device__ __forceinline__ void kv_prompt_row(int l, int idx, const Params& p, const bf16_t* __restrict__ z, int lane) {
    const int b = idx >> 7, w = idx & 127;
    const bf16_t* zr = z + (size_t)(b * LSEQ + (LSEQ - WIN) + w) * INDIM;
    const u32x2 kv = *(const u32x2*)(zr + ZK + 4 * lane), vv = *(const u32x2*)(zr + ZV + 4 * lane);
    const size_t o = (((size_t)l * NBATCH + b) * WIN + w) * 256 + 4 * lane;
    *(f32x4*)(p.out + O_KP + o) = (f32x4){bf_lo(kv.x), bf_hi(kv.x), bf_lo(kv.y), bf_hi(kv.y)};
    *(f32x4*)(p.out + O_VP + o) = (f32x4){bf_lo(vv.x), bf_hi(vv.x), bf_lo(vv.y), bf_hi(vv.y)};
}
__device__ __forceinline__ void kv_sample_row(int l, int idx, const Params& p, const bf16_t* __restrict__ z, int lane) {
    const int b = idx >> 7, w = idx & 127;
    const size_t o = (((size_t)l * DB + b) * WIN + w) * 256 + 4 * lane;
    f32x4 kq, vq;
    if (w < WIN - 1) { kq = *(const f32x4*)(p.cache_k + o + 256); vq = *(const f32x4*)(p.cache_v + o + 256); }
    else { const bf16_t* zr = z + (size_t)(MPROMPT + b) * INDIM; const u32x2 kv = *(const u32x2*)(zr + ZK + 4 * lane), vv = *(const u32x2*)(zr + ZV + 4 * lane);
        kq = (f32x4){bf_lo(kv.x), bf_hi(kv.x), bf_lo(kv.y), bf_hi(kv.y)}; vq = (f32x4){bf_lo(vv.x), bf_hi(vv.x), bf_lo(vv.y), bf_hi(vv.y)}; }
    *(f32x4*)(p.out + O_KS + o) = kq; *(f32x4*)(p.out + O_VS + o) = vq;
}

__device__ __forceinline__ void kv_sample_row2(int l, int i0, int i1, const Params& p, const bf16_t* __restrict__ z, int lane) {
    f32x4 kq[2], vq[2]; size_t o[2]; const int idx[2] = {i0, i1};
#pragma unroll
    for (int e = 0; e < 2; ++e) {
        const int b = idx[e] >> 7, w = idx[e] & 127;
        o[e] = (((size_t)l * DB + b) * WIN + w) * 256 + 4 * lane;
        if (w < WIN - 1) { kq[e] = *(const f32x4*)(p.cache_k + o[e] + 256); vq[e] = *(const f32x4*)(p.cache_v + o[e] + 256); }
        else { const bf16_t* zr = z + (size_t)(MPROMPT + b) * INDIM; const u32x2 kv = *(const u32x2*)(zr + ZK + 4 * lane), vv = *(const u32x2*)(zr + ZV + 4 * lane);
            kq[e] = (f32x4){bf_lo(kv.x), bf_hi(kv.x), bf_lo(kv.y), bf_hi(kv.y)}; vq[e] = (f32x4){bf_lo(vv.x), bf_hi(vv.x), bf_lo(vv.y), bf_hi(vv.y)}; }
    }
#pragma unroll
    for (int e = 0; e < 2; ++e) { *(f32x4*)(p.out + O_KS + o[e]) = kq[e]; *(f32x4*)(p.out + O_VS + o[e]) = vq[e]; }
}

__device__ __forceinline__ void filler_cache_copy(const Params& p, int l, int nwg, int wid, int lane) {
    const int G = gridDim.x, r = nwg % G, c = blockIdx.x;
    int worker, nw;
    if (r == 0) { worker = c * 8 + wid; nw = G * 8; } else if (c >= r) { worker = (c - r) * 8 + wid; nw = (G - r) * 8; } else return;
    for (int i = worker; i < DB * WIN / 2; i += nw) {
        const int i1 = i + DB * WIN / 2;
        if ((i & 127) != 127) kv_sample_row2(l, i, i1, p, (const bf16_t*)(p.ws + WS_ZACT), lane);
    }
}

constexpr int NU_ATT = NBATCH * 4 * 16;

__device__ __forceinline__ void mixer_phase(const Params& p, int l, LAS unsigned char* lds, int tid, int wid, int lane, unsigned long long& tacc_, unsigned long long& t0_) {
    const bf16_t* z = (const bf16_t*)(p.ws + WS_ZACT); bf16_t* mixin = (bf16_t*)(p.ws + WS_MIXIN);
    TB(9);
    for (int u = blockIdx.x; u < NU_ATT; u += gridDim.x) { const int qt = u & 15, bk = u >> 4; attn_prompt_unit(lds, bk >> 2, bk & 3, qt, z, mixin, p.sinks + l * NHEADS, tid, wid, lane); }
    TE(9);
    TB(10);
    const int gw = blockIdx.x * 8 + wid, NGW = gridDim.x * 8;
    if (gw < MPROMPT / 4) conv_job4(l, 4 * gw, p, z, mixin, lane);
    for (int j = NGW + (gw >> 7); j < MPROMPT / 4 && (gw & 127) == 5; j += NGW >> 7) conv_job4(l, 4 * j, p, z, mixin, lane);
    if ((gw & 63) == 33 && (gw >> 6) < DB) conv_row(l, MPROMPT + (gw >> 6), p, z, mixin, lane);
    if ((gw & 3) == 0 && (gw >> 2) < DB * NHEADS) { const int job = gw >> 2; attn_sample_wave(lds, l, job >> 4, job & 15, p, z, mixin, wid, lane); }
    for (int i = (int)NGW - 1 - gw; i < NBATCH * WIN; i += NGW) kv_prompt_row(l, i, p, z, lane);
    if ((gw & 63) == 34 && (gw >> 6) < DB) kv_sample_row(l, (gw >> 6) * WIN + (WIN - 1), p, z, lane);
    TE(10);
}

__global__ void __launch_bounds__(512, 2) hymba_fwd(Params p) {
    extern __shared__ __attribute__((aligned(16))) unsigned char lds_raw[];
    LAS unsigned char* lds = (LAS unsigned char*)lds_raw;
    cg::grid_group grid = cg::this_grid();
    const int tid = threadIdx.x, lane = tid & 63, wid = __builtin_amdgcn_readfirstlane(tid >> 6);

    unsigned* barw = (unsigned*)(p.ws + WS_BAR);
    unsigned* cntw = (unsigned*)(p.ws + WS_CNT);
    volatile LAS unsigned* xst = (volatile LAS unsigned*)(lds + MISC_OFF);
    if (tid < 2) xst[tid] = 0u;
    __syncthreads();
    const XcdBarrier xb = xcd_barrier_post(barw, xst);
    {
        LAS float* biasL = (LAS float*)(lds + BIAS_OFF);
        for (int i = tid; i < NHEADS * BIAS_STRIDE; i += 512) {
            const int h = i / BIAS_STRIDE, d = i % BIAS_STRIDE - BIAS_PAD;
            float v = -INFINITY;
            if (d >= 0 && d <= WIN) {
                int bkt;
                if (d < 16) bkt = d;
                else { const float df = (float)d; bkt = 16 + (int)(logf(df / 16.f) / logf(8.f) * 16.f); bkt = bkt > 31 ? 31 : bkt; }
                v = p.rel_bias[bkt * NHEADS + h];
            }
            biasL[i] = v;
        }
    }
    unsigned long long tacc_ = 0, t0_ = 0;
    TB(0);
    for (int rep = 0; rep < REP_PRO; ++rep) prologue(p, lds, wid, lane);
    TE(0);
    if (p.ws == nullptr) grid.sync();
    GSYNC();

    bf16_t* ZACT = (bf16_t*)(p.ws + WS_ZACT); bf16_t* MIXIN = (bf16_t*)(p.ws + WS_MIXIN); bf16_t* MIXB = (bf16_t*)(p.ws + WS_MIXB); bf16_t* MIXB1 = (bf16_t*)(p.ws + WS_MIXB1);
    const int vcu = (gridDim.x % 8 == 0) ? (int)((blockIdx.x % 8) * (gridDim.x / 8) + blockIdx.x / 8) : (int)blockIdx.x;
    const bf16_t* HB = (const bf16_t*)(p.ws + WS_HB); const float* RS = (const float*)(p.ws + WS_RS);
#pragma unroll 1
    for (int l = 0; l < DEPTH; ++l) {
        TB(1);
        {
            pg8::Gemm g{HB, (const bf16_t*)(p.ws + WS_WIN + l * SZ_WIN), MP, INDIM, D}; pg8::Epi<0> E{ZACT, INDIM, RS, ZACT};
            pg8::StaticOrder S; S.init(MP, INDIM, D, (int)gridDim.x, (int)blockIdx.x);
            for (int rep = 0; rep < REP_GIN; ++rep) pg8::gemm_phase<D, pg8::Epi<0>, pg8::StaticOrder>(lds, g, S, E);
            for (int rep = 0; rep < REP_FILL; ++rep) { int t2 = threadIdx.x; asm volatile("" : "+v"(t2)); const int w2 = __builtin_amdgcn_readfirstlane(t2 >> 6), l2 = t2 & 63;
                filler(p, l, I_IN, I_LAYER - I_DN, (MP / 256) * (INDIM / 256), lds, w2, l2);
                if (l + 1 < DEPTH) filler(p, l + 1, 0, I_IN / 2, (MP / 256) * (INDIM / 256), lds, w2, l2);
                filler_cache_copy(p, l, (MP / 256) * (INDIM / 256), w2, l2); }
        }
        TE(1);
        GSYNC();
        TB(2);
#ifndef NO_MIX
        for (int rep = 0; rep < REP_MIX; ++rep) { int t2 = threadIdx.x; asm volatile("" : "+v"(t2)); mixer_phase(p, l, lds, t2, __builtin_amdgcn_readfirstlane(t2 >> 6), t2 & 63, tacc_, t0_); }
#endif
        TE(2);
        GSYNC();
        TB(3);
        {
            pg8::Gemm g{MIXIN, (const bf16_t*)(p.ws + WS_WOUT + l * SZ_WOUT), MP, D, D}; pg8::Epi<0> E{MIXB, D, nullptr, MIXB1};
            pg8::StreamKOrder<D / 128> S; S.init((int)gridDim.x, vcu);
            for (int rep = 0; rep < REP_GOUT; ++rep) pg8::gemm_phase<D, pg8::Epi<0>, pg8::StreamKOrder<D / 128>>(lds, g, S, E);
            TE(3);
            TB(4);
            { int t2 = threadIdx.x; asm volatile("" : "+v"(t2)); sk_postnorm<D / 128>(p, S, cntw + (size_t)((l * 2 + 0) * 33) * 16, p.n_post_mix + l * D, false, vcu, t2, __builtin_amdgcn_readfirstlane(t2 >> 6), t2 & 63, tacc_, t0_); }
        }
        TE(4);
        GSYNC();
        TB(5);
        {
            pg8::Gemm g{HB, (const bf16_t*)(p.ws + WS_WGU + l * SZ_WGU), MP, NGU, D}; pg8::Epi<1> E{ZACT, DFF, RS, ZACT};
            pg8::StaticOrder S; S.init(MP, NGU, D, (int)gridDim.x, (int)blockIdx.x);
            for (int rep = 0; rep < REP_GGU; ++rep) pg8::gemm_phase<D, pg8::Epi<1>, pg8::StaticOrder>(lds, g, S, E);
            for (int rep = 0; rep < REP_FILL; ++rep) { int t2 = threadIdx.x; asm volatile("" : "+v"(t2)); const int w2 = __builtin_amdgcn_readfirstlane(t2 >> 6), l2 = t2 & 63;
                filler(p, l, I_LAYER - I_DN, I_LAYER, (MP / 256) * (NGU / 256), lds, w2, l2);
                if (l + 1 < DEPTH) filler(p, l + 1, I_IN / 2, I_IN, (MP / 256) * (NGU / 256), lds, w2, l2); }
        }
        TE(5);
        GSYNC();
        TB(6);
        {
            pg8::Gemm g{ZACT, (const bf16_t*)(p.ws + WS_WDN + l * SZ_WDN), MP, D, DFF}; pg8::Epi<0> E{MIXB, D, nullptr, MIXB1};
            pg8::StreamKOrder<DFF / 128> S; S.init((int)gridDim.x, vcu);
            for (int rep = 0; rep < REP_GDN; ++rep) pg8::gemm_phase<DFF, pg8::Epi<0>, pg8::StreamKOrder<DFF / 128>>(lds, g, S, E);
            TE(6);
            TB(7);
            { int t2 = threadIdx.x; asm volatile("" : "+v"(t2)); sk_postnorm<DFF / 128>(p, S, cntw + (size_t)((l * 2 + 1) * 33) * 16, p.n_post_ffn + l * D, l == DEPTH - 1, vcu, t2, __builtin_amdgcn_readfirstlane(t2 >> 6), t2 & 63, tacc_, t0_); }
        }
        TE(7);
        if (l != DEPTH - 1) GSYNC();
    }
    if (TMASK != 0 && blockIdx.x == TBLK) { const unsigned long long tend = __builtin_amdgcn_s_memrealtime() + (unsigned long long)TMULT * tacc_; while (__builtin_amdgcn_s_memrealtime() < tend) __builtin_amdgcn_s_sleep(8); }
}

extern "C" void kernel_launch(void* const* d_in, const int* in_sizes, int n_in, void* d_out, int out_size, void* d_ws, size_t ws_size, hipStream_t stream) {
    static int grid_blocks = 0;
    if (grid_blocks == 0) {
        if (n_in != 18 || ws_size < WS_END) { fprintf(stderr, "kernel_launch: unexpected inputs (n_in %d, ws %zu, need %zu)\n", n_in, ws_size, (size_t)WS_END); grid_blocks = -1; return; }
        int dev = 0, cus = 0, per_cu = 0;
        hipGetDevice(&dev);
        hipDeviceGetAttribute(&cus, hipDeviceAttributeMultiprocessorCount, dev);
        hipFuncSetAttribute((const void*)hymba_fwd, hipFuncAttributeMaxDynamicSharedMemorySize, LDS_BYTES);
        hipOccupancyMaxActiveBlocksPerMultiprocessor(&per_cu, (const void*)hymba_fwd, 512, LDS_BYTES);
        if (per_cu < 1) per_cu = 1;
        grid_blocks = cus * per_cu;
    }
    if (grid_blocks < 0) return;
    if (hipMemsetAsync((char*)d_ws + WS_BAR, 0, WS_END - WS_BAR, stream) != hipSuccess) { fprintf(stderr, "kernel_launch: memset of the barrier words failed\n"); return; }
    Params p{};
    const float** pp = (const float**)&p;
    for (int i = 0; i < 18; ++i) pp[i] = (const float*)d_in[i];
    p.out = (float*)d_out; p.ws = (unsigned char*)d_ws;
    void* args[] = {&p};
    hipError_t e = hipLaunchCooperativeKernel((const void*)hymba_fwd, dim3(grid_blocks), dim3(512), args, LDS_BYTES, stream);
    if (e != hipSuccess) fprintf(stderr, "cooperative launch failed: %s (grid %d)\n", hipGetErrorString(e), grid_blocks);
}
```

```cpp
#include <hip/hip_runtime.h>
#include <hip/hip_cooperative_groups.h>
#include <cstdio>
#include <cstdint>
namespace cg = cooperative_groups;
#define REP_PRO 1
#define REP_MIX 1
#define REP_GIN 1
#define REP_GOUT 1
#define REP_GGU 1
#define REP_GDN 1
#define EXTRA_SYNC 0
#define REP_PN 0
#define REP_FILL 1
#define WGM_SET 5
#define TMASK 0
#define TMULT 4
#define TBLK 0
#define TB(k) do { if (TMASK & (1 << (k))) t0_ = __builtin_amdgcn_s_memrealtime(); } while (0)
#define TE(k) do { if (TMASK & (1 << (k))) tacc_ += __builtin_amdgcn_s_memrealtime() - t0_; } while (0)
#define GSYNC() do { TB(8); xcd_barrier(xb); for (int e_ = 0; e_ < EXTRA_SYNC; ++e_) xcd_barrier(xb); TE(8); } while (0)

#define LAS __attribute__((address_space(3)))
typedef unsigned short bf16_t;
typedef short bf16x8 __attribute__((ext_vector_type(8)));
typedef float f32x4 __attribute__((ext_vector_type(4)));
typedef float f32x2 __attribute__((ext_vector_type(2)));
typedef unsigned u32x4 __attribute__((ext_vector_type(4)));
typedef unsigned u32x2 __attribute__((ext_vector_type(2)));

constexpr int D = 2048, NBATCH = 4, SEQ = 2048, NMETA = 16, LSEQ = SEQ + NMETA, DEPTH = 4, DB = 32, WIN = 128;
constexpr int MPROMPT = NBATCH * LSEQ;
constexpr int MREAL = MPROMPT + DB;
constexpr int MP = 8448;
constexpr int INDIM = 4608, DFF = 5632, NGU = 2 * DFF, CDIM = 1024;
constexpr int ZQ = 0, ZK = 1024, ZV = 1280, ZGB = 1536, ZGC = 2560, ZHC = 3584;
constexpr float RMS_EPS = 1e-6f;
constexpr int NHEADS = 16;

constexpr size_t O_YP = 0, O_YS = 16777216, O_KP = 16842752, O_VP = 17367040, O_CP = 17891328, O_KS = 17924096, O_VS = 22118400, O_CS = 26312704;

constexpr size_t SZ_WIN = (size_t)INDIM * D * 2, SZ_WOUT = (size_t)D * D * 2, SZ_WGU = (size_t)NGU * D * 2, SZ_WDN = (size_t)D * DFF * 2;
constexpr size_t WS_WIN = 0;
constexpr size_t WS_WOUT = WS_WIN + DEPTH * SZ_WIN;
constexpr size_t WS_WGU = WS_WOUT + DEPTH * SZ_WOUT;
constexpr size_t WS_WDN = WS_WGU + DEPTH * SZ_WGU;
constexpr size_t WS_ZACT = WS_WDN + DEPTH * SZ_WDN;
constexpr size_t WS_MIXIN = WS_ZACT + (size_t)MP * DFF * 2;
constexpr size_t WS_MIXB = WS_MIXIN + (size_t)MP * D * 2;
constexpr size_t WS_MIXB1 = WS_MIXB + (size_t)MP * D * 2;
constexpr size_t WS_HB = WS_MIXB1 + (size_t)MP * D * 2;
constexpr size_t WS_RS = WS_HB + (size_t)MP * D * 2;
constexpr size_t WS_BAR = WS_RS + (size_t)MP * 4;
constexpr size_t WS_CNT = WS_BAR + 16384;
constexpr size_t WS_END = WS_CNT + (size_t)DEPTH * 2 * 33 * 64;

constexpr int RING_BYTES = 131072, BIAS_OFF = RING_BYTES, LDS_BYTES = 147456;
constexpr int BIAS_STRIDE = 176, BIAS_PAD = 16;
constexpr int MISC_OFF = BIAS_OFF + NHEADS * BIAS_STRIDE * 4;

__device__ __forceinline__ unsigned cvt_pk_bf16(float lo, float hi) { unsigned r; asm volatile("v_cvt_pk_bf16_f32 %0, %1, %2" : "=v"(r) : "v"(lo), "v"(hi)); return r; }
__device__ __forceinline__ float bf_lo(unsigned u) { return __uint_as_float(u << 16); }
__device__ __forceinline__ float bf_hi(unsigned u) { return __uint_as_float(u & 0xffff0000u); }
__device__ __forceinline__ float wave_sum(float v) {
#pragma unroll
    for (int o = 1; o < 64; o <<= 1) v += __shfl_xor(v, o);
    return v;
}
__device__ __forceinline__ float wave_max(float v) {
#pragma unroll
    for (int o = 1; o < 64; o <<= 1) v = fmaxf(v, __shfl_xor(v, o));
    return v;
}
#define LDS_WAIT() asm volatile("s_waitcnt lgkmcnt(0)" ::: "memory")
#define WT_STORES 0
#define WT_SK 1
#define WT_LAST 0
__device__ __forceinline__ void store16_wt(void* p, u32x4 v, bool wt) {
    if (wt) asm volatile("global_store_dwordx4 %0, %1, off sc1\n\ts_nop 1" :: "v"(p), "v"(v) : "memory");
    else *(u32x4*)p = v;
}
__device__ __forceinline__ void store8_wt(void* p, u32x2 v) {
#if WT_STORES
    asm volatile("global_store_dwordx2 %0, %1, off sc1\n\ts_nop 1" :: "v"(p), "v"(v) : "memory");
#else
    *(u32x2*)p = v;
#endif
}


#define XB_TMO      128
#define XB_XCNT(j)  (256  + 64 * (j))
#define XB_XSUB(j)  (1280 + 64 * (j))
#define XB_XGEN(j)  (2304 + 64 * (j))
#define XB_TOP      3328
#define XB_TOPGEN   3392
#define XCD_BAR_WORDS 3456
#define XB_SPIN_CAP (1u << 18)
__device__ __forceinline__ unsigned xb_ld(unsigned* p)              { return __hip_atomic_load(p, __ATOMIC_RELAXED, __HIP_MEMORY_SCOPE_AGENT); }
__device__ __forceinline__ unsigned xb_add(unsigned* p, unsigned v) { return __hip_atomic_fetch_add(p, v, __ATOMIC_RELAXED, __HIP_MEMORY_SCOPE_AGENT); }
__device__ __forceinline__ unsigned xb_xcc_id() { return (unsigned)__builtin_amdgcn_s_getreg((3 << 11) | 20) & 0xFu; }
#define XB_SPIN(cond, bar) do { unsigned _sp = 0; while (cond) { __builtin_amdgcn_s_sleep(1); \
    if ((++_sp & 255u) == 0u) { if (xb_ld(&(bar)[XB_TMO])) break; if (_sp > XB_SPIN_CAP) { atomicAdd(&(bar)[XB_TMO], 1u); break; } } } } while (0)
struct XcdBarrier { unsigned* bar; unsigned x; volatile LAS unsigned* st; };
__device__ __forceinline__ XcdBarrier xcd_barrier_post(unsigned* bar, volatile LAS unsigned* st) {
    XcdBarrier b; b.bar = bar; b.x = xb_xcc_id(); b.st = st;
    if (threadIdx.x == 0) (void)xb_add(&bar[XB_XCNT(b.x)], 1u);
    return b;
}
__device__ __forceinline__ void xcd_barrier_complete(unsigned* bar, unsigned x, unsigned& nloc, unsigned& nx) {
    const unsigned G = gridDim.x * gridDim.y * gridDim.z;
    unsigned sum, cnt, mine, sp = 0u;
    for (;;) {
        sum = 0u; cnt = 0u; mine = 0u;
#pragma unroll
        for (unsigned j = 0; j < 16; ++j) { const unsigned c = xb_ld(&bar[XB_XCNT(j)]); sum += c; cnt += (c > 0u) ? 1u : 0u; mine = (j == x) ? c : mine; }
        if (sum == G) break;
        __builtin_amdgcn_s_sleep(1);
        if ((++sp & 255u) == 0u) { if (xb_ld(&bar[XB_TMO])) break; if (sp > XB_SPIN_CAP) { atomicAdd(&bar[XB_TMO], 1u); break; } }
    }
    nloc = mine > 0u ? mine : 1u; nx = cnt > 0u ? cnt : 1u;
}
__device__ __forceinline__ void xcd_barrier(const XcdBarrier& b) {
    asm volatile("s_waitcnt vmcnt(0)" ::: "memory");
    __syncthreads();
    if (threadIdx.x == 0) {
        unsigned* bar = b.bar;
        __builtin_amdgcn_s_waitcnt(0);
        unsigned nloc = b.st[0], nx = b.st[1];
        if (nloc == 0u) { xcd_barrier_complete(bar, b.x, nloc, nx); b.st[0] = nloc; b.st[1] = nx; }
        const unsigned old = xb_add(&bar[XB_XSUB(b.x)], 1u);
        const unsigned gen = old / nloc;
        if (old + 1u == (gen + 1u) * nloc) {
            __builtin_amdgcn_fence(__ATOMIC_RELEASE, "agent");
            asm volatile("s_waitcnt vmcnt(0)" ::: "memory");
            const unsigned og = xb_add(&bar[XB_TOP], 1u);
            const unsigned tg = og / nx;
            if (og + 1u == (tg + 1u) * nx) xb_add(&bar[XB_TOPGEN], 1u);
            else XB_SPIN(xb_ld(&bar[XB_TOPGEN]) == tg, bar);
            __builtin_amdgcn_fence(__ATOMIC_ACQUIRE, "agent");
            xb_add(&bar[XB_XGEN(b.x)], 1u);
            asm volatile("s_waitcnt vmcnt(0)" ::: "memory");
        } else {
            XB_SPIN(xb_ld(&bar[XB_XGEN(b.x)]) == gen, bar);
            __builtin_amdgcn_fence(__ATOMIC_ACQUIRE, "agent");
            asm volatile("s_waitcnt vmcnt(0)" ::: "memory");
        }
    }
    __syncthreads();
}

namespace pg8 {
constexpr int BM = 256, BK = 64, HALF = 128, HTB = HALF * BK * 2, STAGE_BYTES = 8 * HTB, NXCD = 8, WGM = WGM_SET;
__host__ __device__ __forceinline__ int lds_byte(int r, int c) { const int st = (r >> 4) * 2 + (c >> 5), rr = r & 15, cc = c & 31, ob = rr * 64 + cc * 2; return st * 1024 + (ob ^ (((ob >> 9) & 1) << 5)); }
__host__ __device__ __forceinline__ void stage_rc(int b, int& R, int& C) { const int st = b / 1024, sb = b % 1024, swz = sb ^ (((sb >> 9) & 1) << 5); R = (st >> 1) * 16 + swz / 64; C = (st & 1) * 32 + (swz % 64) / 2; }
__host__ __device__ __forceinline__ int perm32(int rho) { const int n = rho >> 4, i = rho & 15; return 8 * (i >> 2) + 4 * n + (i & 3); }

struct Unit { int pm, pn, kt0, len, part; };
struct Gemm { const bf16_t* A; const bf16_t* Bt; int M, N, K; };

struct StaticOrder {
    static constexpr bool WT_ALL = false;
    int nM, nN, nwg, G, c, nt;
    __host__ __device__ void init(int M, int N, int K, int G_, int c_) { nM = M / BM; nN = N / BM; nwg = nM * nN; G = G_; c = c_; nt = K / BK; }
    __host__ __device__ bool next(int i, Unit& u) const {
        const long L = (long)i * G + c; if (L >= nwg) return false;
        int wgid = (int)L; { const int q = nwg / NXCD, r = nwg % NXCD, xcd = wgid % NXCD, off = wgid / NXCD; wgid = (xcd < r ? xcd * (q + 1) : r * (q + 1) + (xcd - r) * q) + off; }
        const int nig = WGM * nN, gid = wgid / nig, fm = gid * WGM, gsz = (nM - fm) < WGM ? (nM - fm) : WGM;
        u.pm = fm + ((wgid % nig) % gsz); u.pn = (wgid % nig) / gsz; u.kt0 = 0; u.len = nt; u.part = 0; return true;
    }
};
template <int PP> struct StreamKOrder {
    static constexpr bool WT_ALL = (WT_SK != 0);
    static constexpr int NTILE = (MP / BM) * 8, TP = NTILE * PP;
    int q0, q1;
    __device__ void init(int G, int v) { q0 = (int)((long)v * TP / G); q1 = (int)((long)(v + 1) * TP / G); }
    __device__ bool next(int i, Unit& u) const {
        const int t = q0 / PP + i, s = t * PP; const int a = q0 > s ? q0 : s, b = q1 < s + PP ? q1 : s + PP;
        if (a >= b) return false;
        u.pm = t >> 3; u.pn = t & 7; u.kt0 = 2 * (a - s); u.len = 2 * (b - a); u.part = a > s ? 1 : 0; return true;
    }
    static __device__ __forceinline__ bool is_split(int t, int G) { const int s = t * PP; return (int)(((long)(s + 1) * G - 1) / TP) != (int)(((long)(s + PP) * G - 1) / TP); }
};

template <int MODE> struct Epi {
    static constexpr bool PERM = true;
    bf16_t* O; int ldc; const float* rs; bf16_t* O1;
    __device__ __forceinline__ void operator()(const f32x4 (&acc)[2][2][4][2], const Unit& u, int wr, int wc, int fr, int fq, bool wt) const {
        const int row0 = u.pm * BM + wr * 64 + fr;
        if constexpr (MODE == 0) {
            const int col0 = u.pn * BM + wc * 32 + 8 * fq;
#pragma unroll
            for (int ai = 0; ai < 2; ++ai)
#pragma unroll
                for (int m = 0; m < 4; ++m) {
                    const int row = row0 + ai * HALF + m * 16;
                    bf16_t* rowp = (u.part ? O1 : O) + (size_t)row * ldc + col0;
#pragma unroll
                    for (int bj = 0; bj < 2; ++bj) {
                        const f32x4 v0 = acc[ai][bj][m][0], v1 = acc[ai][bj][m][1];
                        u32x4 w; w.x = cvt_pk_bf16(v0[0], v0[1]); w.y = cvt_pk_bf16(v0[2], v0[3]); w.z = cvt_pk_bf16(v1[0], v1[1]); w.w = cvt_pk_bf16(v1[2], v1[3]);
                        store16_wt(rowp + bj * HALF, w, wt);
                    }
                }
        } else {
            const int col0 = u.pn * HALF + wc * 32 + 8 * fq;
#pragma unroll
            for (int ai = 0; ai < 2; ++ai)
#pragma unroll
                for (int m = 0; m < 4; ++m) {
                    const int row = row0 + ai * HALF + m * 16;
                    float o[8];
#pragma unroll
                    for (int n = 0; n < 2; ++n)
#pragma unroll
                        for (int j = 0; j < 4; ++j) {
                            const float g = acc[ai][0][m][n][j], up = acc[ai][1][m][n][j];
                            o[n * 4 + j] = (g * up) * __builtin_amdgcn_rcpf(1.f + __builtin_amdgcn_exp2f(g * -1.4426950408889634f));
                        }
                    u32x4 w; w.x = cvt_pk_bf16(o[0], o[1]); w.y = cvt_pk_bf16(o[2], o[3]); w.z = cvt_pk_bf16(o[4], o[5]); w.w = cvt_pk_bf16(o[6], o[7]);
                    store16_wt(O + (size_t)row * ldc + col0, w, wt);
                }
        }
    }
};

template <int K, class EpiT, class Sched>
__device__ __forceinline__ void gemm_phase(LAS unsigned char* lds, const Gemm g, const Sched& S, const EpiT& E) {
    int tid_ = threadIdx.x; asm volatile("" : "+v"(tid_));
    const int tid = tid_, wid = __builtin_amdgcn_readfirstlane(tid >> 6), lane = tid & 63, wr = wid >> 2, wc = wid & 3, fr = lane & 15, fq = lane >> 4;
    unsigned voffA[2], voffB[2];
#pragma unroll
    for (int i = 0; i < 2; ++i) { int R, C; stage_rc(tid * 16 + i * 8192, R, C); const int Rb = EpiT::PERM ? ((R & ~31) + perm32(R & 31)) : R;
        voffA[i] = (unsigned)(R * K + C) * 2u; voffB[i] = (unsigned)(Rb * K + C) * 2u; }
    const size_t kstep = (size_t)(BK * 2);
    const size_t hstep = (size_t)HALF * K * 2;
    const size_t tstep = 2 * hstep;
    const unsigned ldsw = (unsigned)wid * 1024u;
    const int aoff = lds_byte(wr * 64 + fr, fq * 8), boff = lds_byte(wc * 32 + fr, fq * 8);
#define PG8_SA(b, h) (((b) * 2 + (h)) * HTB)
#define PG8_SB(b, h) ((4 + (b) * 2 + (h)) * HTB)
#define PG8_STAGE(bufoff, gbase, voff) do { _Pragma("unroll") for (int _i = 0; _i < 2; ++_i) \
        __builtin_amdgcn_global_load_lds((const unsigned*)((const char*)(gbase) + (voff)[_i]), (LAS unsigned*)(lds + (bufoff) + ldsw + _i * 8192), 16, 0, 0); } while (0)
#define PG8_LDA(dst, b, h) do { _Pragma("unroll") for (int m = 0; m < 4; ++m) _Pragma("unroll") for (int k = 0; k < 2; ++k) dst[m][k] = *(const LAS bf16x8*)(lds + PG8_SA(b, h) + aoff + m * 2048 + k * 1024); } while (0)
#define PG8_LDB(dst, b, h) do { _Pragma("unroll") for (int n = 0; n < 2; ++n) _Pragma("unroll") for (int k = 0; k < 2; ++k) dst[n][k] = *(const LAS bf16x8*)(lds + PG8_SB(b, h) + boff + n * 2048 + k * 1024); } while (0)
#define PG8_MMA(ai, bj, At, Bt) do { __builtin_amdgcn_s_setprio(1); _Pragma("unroll") for (int m = 0; m < 4; ++m) _Pragma("unroll") for (int n = 0; n < 2; ++n) _Pragma("unroll") for (int k = 0; k < 2; ++k) \
        acc[ai][bj][m][n] = __builtin_amdgcn_mfma_f32_16x16x32_bf16(Bt[n][k], At[m][k], acc[ai][bj][m][n], 0, 0, 0); __builtin_amdgcn_s_setprio(0); } while (0)
#define PG8_WAIT_V(n) asm volatile("s_waitcnt vmcnt(" #n ")" ::: "memory")
#define PG8_WAIT_L(n) asm volatile("s_waitcnt lgkmcnt(" #n ")" ::: "memory")
#define PG8_BAR __builtin_amdgcn_s_barrier()
#define PG8_SCHED __builtin_amdgcn_sched_barrier(0)
    Unit cur, nxt; int ui = 0;
    if (!S.next(0, cur)) return;
    f32x4 acc[2][2][4][2];
#pragma unroll
    for (int a = 0; a < 2; ++a)
#pragma unroll
        for (int b = 0; b < 2; ++b)
#pragma unroll
            for (int m = 0; m < 4; ++m)
#pragma unroll
                for (int n = 0; n < 2; ++n) acc[a][b][m][n] = (f32x4){0.f, 0.f, 0.f, 0.f};
    bf16x8 At[4][2], B0[2][2], B1[2][2];
    const char* cA = (const char*)g.A + (size_t)cur.pm * tstep + (size_t)cur.kt0 * kstep; const char* cB = (const char*)g.Bt + (size_t)cur.pn * tstep + (size_t)cur.kt0 * kstep;
    PG8_STAGE(PG8_SB(0, 0), cB, voffB); PG8_STAGE(PG8_SB(0, 1), cB + hstep, voffB); PG8_STAGE(PG8_SA(0, 0), cA, voffA); PG8_STAGE(PG8_SA(0, 1), cA + hstep, voffA);
    if (wr == 1) PG8_BAR;
    PG8_WAIT_V(2); PG8_BAR;
    PG8_STAGE(PG8_SB(1, 0), cB + kstep, voffB); PG8_STAGE(PG8_SA(1, 0), cA + kstep, voffA); PG8_STAGE(PG8_SB(1, 1), cB + hstep + kstep, voffB);
    PG8_WAIT_V(6); PG8_BAR;
    for (;;) {
        const bool has_next = S.next(ui + 1, nxt);
        const char* nA = has_next ? (const char*)g.A + (size_t)nxt.pm * tstep + (size_t)nxt.kt0 * kstep : cA; const char* nB = has_next ? (const char*)g.Bt + (size_t)nxt.pn * tstep + (size_t)nxt.kt0 * kstep : cB;
        const int nt = cur.len;
        for (int t = 0; t < nt; t += 2) {
            const bool last = (t == nt - 2);
            const char* a1 = cA + (size_t)(t + 1) * kstep;
            const char* a2 = last ? nA : cA + (size_t)(t + 2) * kstep; const char* b2 = last ? nB : cB + (size_t)(t + 2) * kstep;
            const char* a3 = a2 + kstep; const char* b3 = b2 + kstep;
            PG8_LDB(B0, 0, 0); PG8_LDB(B1, 0, 1); PG8_SCHED; PG8_LDA(At, 0, 0); PG8_STAGE(PG8_SA(1, 1), a1 + hstep, voffA);
            PG8_WAIT_V(8); PG8_WAIT_L(0); PG8_BAR; PG8_MMA(0, 0, At, B0); PG8_MMA(0, 1, At, B1); PG8_BAR; PG8_SCHED;
            PG8_LDA(At, 0, 1); PG8_STAGE(PG8_SB(0, 0), b2, voffB); PG8_STAGE(PG8_SB(0, 1), b2 + hstep, voffB); PG8_STAGE(PG8_SA(0, 0), a2, voffA);
            PG8_WAIT_V(8); PG8_WAIT_L(0); PG8_BAR; PG8_MMA(1, 0, At, B0); PG8_MMA(1, 1, At, B1); PG8_BAR; PG8_SCHED;
            PG8_LDB(B0, 1, 0); PG8_LDB(B1, 1, 1); PG8_SCHED; PG8_LDA(At, 1, 0); PG8_STAGE(PG8_SA(0, 1), a2 + hstep, voffA);
            PG8_WAIT_V(8); PG8_WAIT_L(0); PG8_BAR; PG8_MMA(0, 0, At, B0); PG8_MMA(0, 1, At, B1); PG8_BAR; PG8_SCHED;
            PG8_LDA(At, 1, 1); PG8_STAGE(PG8_SB(1, 0), b3, voffB); PG8_STAGE(PG8_SB(1, 1), b3 + hstep, voffB); PG8_STAGE(PG8_SA(1, 0), a3, voffA);
            PG8_WAIT_V(8); PG8_WAIT_L(0); PG8_BAR; PG8_MMA(1, 0, At, B0); PG8_MMA(1, 1, At, B1); PG8_BAR; PG8_SCHED;
        }
        if (wr == 0) PG8_BAR;
        E(acc, cur, wr, wc, fr, fq, Sched::WT_ALL ? true : (WT_LAST != 0 && !has_next));
        if (!has_next) break;
#pragma unroll
        for (int a = 0; a < 2; ++a)
#pragma unroll
            for (int b = 0; b < 2; ++b)
#pragma unroll
                for (int m = 0; m < 4; ++m)
#pragma unroll
                    for (int n = 0; n < 2; ++n) acc[a][b][m][n] = (f32x4){0.f, 0.f, 0.f, 0.f};
        cur = nxt; cA = nA; cB = nB; ++ui;
        if (wr == 1) PG8_BAR;
    }
    PG8_WAIT_V(0);
    PG8_BAR;
#undef PG8_SA
#undef PG8_SB
#undef PG8_STAGE
#undef PG8_LDA
#undef PG8_LDB
#undef PG8_MMA
#undef PG8_WAIT_V
#undef PG8_WAIT_L
#undef PG8_BAR
#undef PG8_SCHED
}
}

struct Params {
    const float *x_prompt, *x_sample, *cache_k, *cache_v, *state_conv, *meta, *rel_bias, *w_in, *conv_w, *sinks, *w_out,
        *n_pre_mix, *n_post_mix, *n_pre_ffn, *n_post_ffn, *w_gate, *w_up, *w_down;
    float* out; unsigned char* ws;
};

constexpr int I_IN = (D / 64) * (INDIM / 64), I_OUT = (D / 64) * (D / 64), I_G = (D / 64) * (DFF / 64), I_DN = (DFF / 64) * (D / 64);
constexpr int I_LAYER = I_IN + I_OUT + 2 * I_G + I_DN;
struct ItemDesc { const float* W; const float* gain; bf16_t* WT; int K, N, mode, k0, n0; };
struct ItemRegs { f32x4 v0[8], v1[8]; f32x2 gg[8]; };
__device__ __forceinline__ void item_decode(const Params& p, int l, int it, ItemDesc& d) {
    int r = it;
    if (r < I_IN) { d.W = p.w_in + (size_t)l * D * INDIM; d.K = D; d.N = INDIM; d.WT = (bf16_t*)(p.ws + WS_WIN) + (size_t)l * INDIM * D; d.gain = p.n_pre_mix + l * D; d.mode = 0; }
    else if ((r -= I_IN) < I_OUT) { d.W = p.w_out + (size_t)l * D * D; d.K = D; d.N = D; d.WT = (bf16_t*)(p.ws + WS_WOUT) + (size_t)l * D * D; d.gain = nullptr; d.mode = 0; }
    else if ((r -= I_OUT) < I_G) { d.W = p.w_gate + (size_t)l * D * DFF; d.K = D; d.N = DFF; d.WT = (bf16_t*)(p.ws + WS_WGU) + (size_t)l * NGU * D; d.gain = p.n_pre_ffn + l * D; d.mode = 1; }
    else if ((r -= I_G) < I_G) { d.W = p.w_up + (size_t)l * D * DFF; d.K = D; d.N = DFF; d.WT = (bf16_t*)(p.ws + WS_WGU) + (size_t)l * NGU * D; d.gain = p.n_pre_ffn + l * D; d.mode = 2; }
    else { r -= I_G; d.W = p.w_down + (size_t)l * DFF * D; d.K = DFF; d.N = D; d.WT = (bf16_t*)(p.ws + WS_WDN) + (size_t)l * D * DFF; d.gain = nullptr; d.mode = 0; }
    const int nblk = d.N / 64; d.k0 = 64 * (r / nblk); d.n0 = 64 * (r % nblk);
}
__device__ __forceinline__ void item_load(const ItemDesc& d, int lane, ItemRegs& R) {
    const int c4 = lane & 15, kq = lane >> 4;
#pragma unroll
    for (int i = 0; i < 8; ++i) { const int kp = kq + 4 * i; const float* s = d.W + (size_t)(d.k0 + 2 * kp) * d.N + d.n0 + 4 * c4; R.v0[i] = *(const f32x4*)s; R.v1[i] = *(const f32x4*)(s + d.N); }
#pragma unroll
    for (int i = 0; i < 8; ++i) { const int kp = kq + 4 * i; R.gg[i] = d.gain ? *(const f32x2*)(d.gain + d.k0 + 2 * kp) : (f32x2){1.f, 1.f}; }
}
__device__ __forceinline__ void item_finish(const ItemDesc& d, LAS unsigned* scr, int lane, const ItemRegs& R) {
    const int c4 = lane & 15, kq = lane >> 4;
#pragma unroll
    for (int i = 0; i < 8; ++i) { const int kp = kq + 4 * i; const float g0 = R.gg[i].x, g1 = R.gg[i].y;
        LAS unsigned* q = scr + (4 * c4) * 33 + kp;
        q[0] = cvt_pk_bf16(R.v0[i].x * g0, R.v1[i].x * g1); q[33] = cvt_pk_bf16(R.v0[i].y * g0, R.v1[i].y * g1); q[66] = cvt_pk_bf16(R.v0[i].z * g0, R.v1[i].z * g1); q[99] = cvt_pk_bf16(R.v0[i].w * g0, R.v1[i].w * g1); }
    LDS_WAIT(); __builtin_amdgcn_wave_barrier(); asm volatile("" ::: "memory");
    int rbase = d.n0;
    if (d.mode) rbase = ((d.n0 >> 7) << 8) + (d.n0 & 127) + (d.mode == 2 ? 128 : 0);
    const int kc = lane & 7;
#pragma unroll
    for (int j = 0; j < 8; ++j) { const int n = (lane >> 3) + 8 * j; const LAS unsigned* s = scr + n * 33 + 4 * kc;
        u32x4 o; o.x = s[0]; o.y = s[1]; o.z = s[2]; o.w = s[3];
        *(u32x4*)(d.WT + (size_t)(rbase + n) * d.K + d.k0 + 8 * kc) = o; }
    LDS_WAIT(); __builtin_amdgcn_wave_barrier(); asm volatile("" ::: "memory");
}
__device__ __forceinline__ void convert_items(const Params& p, int l, int it0, int it1, int worker, int nw, LAS unsigned char* lds, int wid, int lane) {
    LAS unsigned* scr = (LAS unsigned*)(lds + wid * 16384);
    int it = it0 + worker;
    if (it >= it1) return;
    ItemDesc dA, dB; ItemRegs A, B;
    item_decode(p, l, it, dA); item_load(dA, lane, A);
    for (;;) {
        const int itB = it + nw; const bool hB = itB < it1;
        if (hB) { item_decode(p, l, itB, dB); item_load(dB, lane, B); }
        item_finish(dA, scr, lane, A);
        if (!hB) break;
        const int itA = itB + nw; const bool hA = itA < it1;
        if (hA) { item_decode(p, l, itA, dA); item_load(dA, lane, A); }
        item_finish(dB, scr, lane, B);
        if (!hA) break;
        it = itA;
    }
}
__device__ __forceinline__ void filler(const Params& p, int l, int it0, int it1, int nwg, LAS unsigned char* lds, int wid, int lane) {
    const int G = gridDim.x, r = nwg % G, c = blockIdx.x;
    if (r == 0) convert_items(p, l, it0, it1, c * 8 + wid, G * 8, lds, wid, lane);
    else if (c >= r) convert_items(p, l, it0, it1, (c - r) * 8 + wid, (G - r) * 8, lds, wid, lane);
}

__device__ __forceinline__ void prologue(const Params& p, LAS unsigned char* lds, int wid, int lane) {
    const int gw = blockIdx.x * 8 + wid, NGW = gridDim.x * 8;
    convert_items(p, 0, 0, I_IN, gw, NGW, lds, wid, lane);
    bf16_t* HB = (bf16_t*)(p.ws + WS_HB); float* RS = (float*)(p.ws + WS_RS);
    for (int m = gw; m < MREAL; m += NGW) {
        const float* src;
        if (m < MPROMPT) { const int b = m / LSEQ, t = m % LSEQ; src = t < NMETA ? p.meta + (size_t)t * D : p.x_prompt + ((size_t)b * SEQ + (t - NMETA)) * D; }
        else src = p.x_sample + (size_t)(m - MPROMPT) * D;
        const f32x4* xr = (const f32x4*)src + lane; u32x2* hb = (u32x2*)(HB + (size_t)m * D) + lane;
        float ss = 0.f; f32x4 v[8];
#pragma unroll
        for (int j = 0; j < 8; ++j) { v[j] = xr[64 * j]; ss += (v[j].x * v[j].x + v[j].y * v[j].y) + (v[j].z * v[j].z + v[j].w * v[j].w); }
        ss = wave_sum(ss);
        const float r = 1.f / sqrtf(ss * (1.f / D) + RMS_EPS);
#pragma unroll
        for (int j = 0; j < 8; ++j) { u32x2 w; w.x = cvt_pk_bf16(v[j].x * r, v[j].y * r); w.y = cvt_pk_bf16(v[j].z * r, v[j].w * r); hb[64 * j] = w; }
        if (lane == 0) RS[m] = r;
    }
}

template <int PP> __device__ __forceinline__ void postnorm_row(const Params& p, const float* __restrict__ g, bool last, int m, int lane, bool dry) {
    bf16_t* HB = (bf16_t*)(p.ws + WS_HB); float* RS = (float*)(p.ws + WS_RS); const bf16_t* MIXB = (const bf16_t*)(p.ws + WS_MIXB); const bf16_t* MIXB1 = (const bf16_t*)(p.ws + WS_MIXB1);
    const u32x2* mr = (const u32x2*)(MIXB + (size_t)m * D) + lane; const u32x2* mr1 = (const u32x2*)(MIXB1 + (size_t)m * D) + lane;
    u32x2* hb = (u32x2*)(HB + (size_t)m * D) + lane; const f32x4* gr = (const f32x4*)g + lane;
    const int tile0 = (m >> 8) * 8;
    u32x2 w0[8], w1[8], hw[8]; f32x4 gv[8];
#pragma unroll
    for (int j = 0; j < 8; ++j) { w0[j] = mr[64 * j]; w1[j] = mr1[64 * j]; hw[j] = hb[64 * j]; }
#pragma unroll
    for (int j = 0; j < 8; ++j) gv[j] = gr[64 * j];
    f32x4 mv[8]; float ss = 0.f;
#pragma unroll
    for (int j = 0; j < 8; ++j) { mv[j] = (f32x4){bf_lo(w0[j].x), bf_hi(w0[j].x), bf_lo(w0[j].y), bf_hi(w0[j].y)};
        if (pg8::StreamKOrder<PP>::is_split(tile0 + j, (int)gridDim.x)) mv[j] += (f32x4){bf_lo(w1[j].x), bf_hi(w1[j].x), bf_lo(w1[j].y), bf_hi(w1[j].y)};
        ss += (mv[j].x * mv[j].x + mv[j].y * mv[j].y) + (mv[j].z * mv[j].z + mv[j].w * mv[j].w); }
    ss = wave_sum(ss);
    const float r = 1.f / sqrtf(ss * (1.f / D) + RMS_EPS);
    float* yrow = nullptr;
    if (last) { if (m < MPROMPT) { const int b = m / LSEQ, t = m % LSEQ; if (t >= NMETA) yrow = p.out + O_YP + ((size_t)b * SEQ + (t - NMETA)) * D; } else yrow = p.out + O_YS + (size_t)(m - MPROMPT) * D; }
    const float rinv = 1.f / RS[m];
    float s2 = 0.f; f32x4 hn[8];
#pragma unroll
    for (int j = 0; j < 8; ++j) {
        const f32x4 hv = (f32x4){bf_lo(hw[j].x), bf_hi(hw[j].x), bf_lo(hw[j].y), bf_hi(hw[j].y)};
        hn[j] = hv * rinv + mv[j] * r * gv[j];
        s2 += (hn[j].x * hn[j].x + hn[j].y * hn[j].y) + (hn[j].z * hn[j].z + hn[j].w * hn[j].w);
        if (yrow) ((f32x4*)yrow)[lane + 64 * j] = hn[j];
    }
    s2 = wave_sum(s2);
    const float rn = 1.f / sqrtf(s2 * (1.f / D) + RMS_EPS);
#pragma unroll
    for (int j = 0; j < 8; ++j) { u32x2 w; w.x = cvt_pk_bf16(hn[j].x * rn, hn[j].y * rn); w.y = cvt_pk_bf16(hn[j].z * rn, hn[j].w * rn); (dry ? (u32x2*)(p.ws + WS_ZACT) + (size_t)m * (D / 4) + lane : hb)[64 * j] = w; }
    if (lane == 0 && !dry) RS[m] = rn;
}
template <int PP> __device__ __forceinline__ void postnorm_row2(const Params& p, const float* __restrict__ g, bool last, int m0, int lane) {
    bf16_t* HB = (bf16_t*)(p.ws + WS_HB); float* RS = (float*)(p.ws + WS_RS); const bf16_t* MIXB = (const bf16_t*)(p.ws + WS_MIXB); const bf16_t* MIXB1 = (const bf16_t*)(p.ws + WS_MIXB1);
    const int tile0 = (m0 >> 8) * 8;
    const f32x4* gr = (const f32x4*)g + lane;
    u32x2 w0[2][8], w1[2][8], hw[2][8]; f32x4 gv[8];
#pragma unroll
    for (int e = 0; e < 2; ++e) {
        const u32x2* mr = (const u32x2*)(MIXB + (size_t)(m0 + e) * D) + lane; const u32x2* mr1 = (const u32x2*)(MIXB1 + (size_t)(m0 + e) * D) + lane; const u32x2* hb = (const u32x2*)(HB + (size_t)(m0 + e) * D) + lane;
#pragma unroll
        for (int j = 0; j < 8; ++j) { w0[e][j] = mr[64 * j]; w1[e][j] = mr1[64 * j]; hw[e][j] = hb[64 * j]; }
    }
#pragma unroll
    for (int j = 0; j < 8; ++j) gv[j] = gr[64 * j];
#pragma unroll
    for (int e = 0; e < 2; ++e) {
        const int m = m0 + e;
        f32x4 mv[8]; float ss = 0.f;
#pragma unroll
        for (int j = 0; j < 8; ++j) { mv[j] = (f32x4){bf_lo(w0[e][j].x), bf_hi(w0[e][j].x), bf_lo(w0[e][j].y), bf_hi(w0[e][j].y)};
            if (pg8::StreamKOrder<PP>::is_split(tile0 + j, (int)gridDim.x)) mv[j] += (f32x4){bf_lo(w1[e][j].x), bf_hi(w1[e][j].x), bf_lo(w1[e][j].y), bf_hi(w1[e][j].y)};
            ss += (mv[j].x * mv[j].x + mv[j].y * mv[j].y) + (mv[j].z * mv[j].z + mv[j].w * mv[j].w); }
        ss = wave_sum(ss);
        const float r = 1.f / sqrtf(ss * (1.f / D) + RMS_EPS);
        float* yrow = nullptr;
        if (last) { if (m < MPROMPT) { const int b = m / LSEQ, t = m % LSEQ; if (t >= NMETA) yrow = p.out + O_YP + ((size_t)b * SEQ + (t - NMETA)) * D; } else yrow = p.out + O_YS + (size_t)(m - MPROMPT) * D; }
        u32x2* hbw = (u32x2*)(HB + (size_t)m * D) + lane;
        const float rinv = 1.f / RS[m];
        float s2 = 0.f; f32x4 hn[8];
#pragma unroll
        for (int j = 0; j < 8; ++j) {
            const f32x4 hv = (f32x4){bf_lo(hw[e][j].x), bf_hi(hw[e][j].x), bf_lo(hw[e][j].y), bf_hi(hw[e][j].y)};
            hn[j] = hv * rinv + mv[j] * r * gv[j];
            s2 += (hn[j].x * hn[j].x + hn[j].y * hn[j].y) + (hn[j].z * hn[j].z + hn[j].w * hn[j].w);
            if (yrow) ((f32x4*)yrow)[lane + 64 * j] = hn[j];
        }
        s2 = wave_sum(s2);
        const float rn = 1.f / sqrtf(s2 * (1.f / D) + RMS_EPS);
        if (!last) {
#pragma unroll
            for (int j = 0; j < 8; ++j) { u32x2 w; w.x = cvt_pk_bf16(hn[j].x * rn, hn[j].y * rn); w.y = cvt_pk_bf16(hn[j].z * rn, hn[j].w * rn); hbw[64 * j] = w; }
            if (lane == 0) RS[m] = rn;
        }
    }
}
template <int PP> __device__ __forceinline__ void postnorm(const Params& p, const float* __restrict__ g, bool last, int wid, int lane, bool dry = false) {
    const int gw = blockIdx.x * 8 + wid, NGW = gridDim.x * 8;
    for (int m = gw; m < MREAL; m += NGW) postnorm_row<PP>(p, g, last, m, lane, dry);
}
template <int PP> __device__ __forceinline__ void sk_postnorm(const Params& p, const pg8::StreamKOrder<PP>& S, unsigned* cnt, const float* __restrict__ g, bool last, int vcu, int tid, int wid, int lane, unsigned long long& tacc_, unsigned long long& t0_) {
    const int G = gridDim.x, gwv = vcu * 8 + wid, NGW = G * 8;
    constexpr int NMAIN = 8192 / 32;
    TB(11);
    asm volatile("s_waitcnt vmcnt(0)" ::: "memory");
    __syncthreads();
    TE(11);
    TB(12);
    if (tid == 0) {
#if !WT_SK
        __builtin_amdgcn_fence(__ATOMIC_RELEASE, "agent");
        asm volatile("s_waitcnt vmcnt(0)" ::: "memory");
#endif
        pg8::Unit u; for (int i = 0; S.next(i, u); ++i) (void)xb_add(cnt + 16 * u.pm, 1u);
        for (int c = vcu; c < NMAIN + 1; c += G) {
            int pm = c >> 3;
            if (c >= NMAIN) break;
            unsigned want = 0; for (int j = 0; j < 8; ++j) want += 1u + (pg8::StreamKOrder<PP>::is_split(8 * pm + j, G) ? 1u : 0u);
            unsigned sp = 0; while (xb_ld(cnt + 16 * pm) < want) { __builtin_amdgcn_s_sleep(1); if (++sp > (1u << 22)) break; }
        }
        if (vcu * 8 < MREAL - 8192) {
            unsigned want = 0; for (int j = 0; j < 8; ++j) want += 1u + (pg8::StreamKOrder<PP>::is_split(8 * 32 + j, G) ? 1u : 0u);
            unsigned sp = 0; while (xb_ld(cnt + 16 * 32) < want) { __builtin_amdgcn_s_sleep(1); if (++sp > (1u << 22)) break; }
        }
        __builtin_amdgcn_fence(__ATOMIC_ACQUIRE, "agent");
        asm volatile("s_waitcnt vmcnt(0)" ::: "memory");
    }
    __syncthreads();
    TE(12);
    TB(13);
    for (int c = vcu; c < NMAIN; c += G)
        for (int i = 0; i < 4; i += 2) postnorm_row2<PP>(p, g, last, 32 * c + 4 * wid + i, lane);
    for (int i = gwv; i < MREAL - 8192; i += NGW) postnorm_row<PP>(p, g, last, 8192 + i, lane, false);
    TE(13);
}

constexpr int AT_QT = 128, AT_NT = 4, AT_KR = 304, AT_KS = 72, AT_VS = 312, AT_PS = 168;
constexpr int AT_K_OFF = 0, AT_V_OFF = AT_KR * AT_KS * 2  , AT_P_OFF = AT_V_OFF + 64 * AT_VS * 2  , AT_P_WAVE = 16 * AT_PS * 2  ;
static_assert(AT_P_OFF + 8 * AT_P_WAVE <= RING_BYTES && (AT_V_OFF % 16) == 0 && (AT_P_OFF % 16) == 0, "attention LDS map");

__device__ __forceinline__ void attn_prompt_unit(LAS unsigned char* lds, int b, int kvh, int qt, const bf16_t* __restrict__ z, bf16_t* mixin, const float* __restrict__ sinks, int tid, int wid, int lane) {
    LAS bf16_t* Ks = (LAS bf16_t*)(lds + AT_K_OFF);
    LAS bf16_t* Vt = (LAS bf16_t*)(lds + AT_V_OFF);
    LAS bf16_t* Pw = (LAS bf16_t*)(lds + AT_P_OFF + wid * AT_P_WAVE);
    const LAS float* biasL = (const LAS float*)(lds + BIAS_OFF);
    const int q0 = qt * AT_QT, rowb = b * LSEQ;
    const int h = kvh * 4 + (wid & 3), i16 = lane & 15, g = lane >> 4;
    const int ntile = AT_NT + ((qt == 15 && (wid >> 2) == 0) ? 1 : 0);
    bf16x8 qf[AT_NT + 1][2];
#pragma unroll
    for (int tile = 0; tile < AT_NT + 1; ++tile) {
        const int tq0 = tile < AT_NT ? q0 + (wid >> 2) * (AT_QT / 2) + tile * 16 : 2048;
        int tq = tq0 + i16; tq = tq > LSEQ - 1 ? LSEQ - 1 : tq;
        const bf16_t* qp = z + (size_t)(rowb + tq) * INDIM + ZQ + h * 64 + 8 * g;
        if (tile < ntile) { qf[tile][0] = *(const bf16x8*)qp; qf[tile][1] = *(const bf16x8*)(qp + 32); }
        else { qf[tile][0] = (bf16x8){0, 0, 0, 0, 0, 0, 0, 0}; qf[tile][1] = qf[tile][0]; }
    }
    const float sink = sinks[h];
    {
        constexpr int NIT = (AT_KR * 8 + 511) / 512;
        u32x4 kv[NIT], vv[NIT];
#pragma unroll
        for (int it = 0; it < NIT; ++it) {
            const int c = tid + it * 512;
            if (it < NIT - 1 || c < AT_KR * 8) {
                const int kr = c >> 3, ch = c & 7; int t = q0 - 144 + kr; t = t < 0 ? 0 : (t > LSEQ - 1 ? LSEQ - 1 : t);
                const bf16_t* src = z + (size_t)(rowb + t) * INDIM + kvh * 64 + ch * 8;
                kv[it] = *(const u32x4*)(src + ZK); vv[it] = *(const u32x4*)(src + ZV);
            }
        }
#pragma unroll
        for (int it = 0; it < NIT; ++it) {
            const int c = tid + it * 512;
            if (it < NIT - 1 || c < AT_KR * 8) {
                const int kr = c >> 3, ch = c & 7;
                *(LAS u32x4*)(Ks + kr * AT_KS + ch * 8) = kv[it];
                LAS bf16_t* vd = Vt + (ch * 8) * AT_VS + kr;
                vd[0 * AT_VS] = (bf16_t)(vv[it].x & 0xffffu); vd[1 * AT_VS] = (bf16_t)(vv[it].x >> 16);
                vd[2 * AT_VS] = (bf16_t)(vv[it].y & 0xffffu); vd[3 * AT_VS] = (bf16_t)(vv[it].y >> 16);
                vd[4 * AT_VS] = (bf16_t)(vv[it].z & 0xffffu); vd[5 * AT_VS] = (bf16_t)(vv[it].z >> 16);
                vd[6 * AT_VS] = (bf16_t)(vv[it].w & 0xffffu); vd[7 * AT_VS] = (bf16_t)(vv[it].w >> 16);
            }
        }
    }
    __syncthreads();
#pragma unroll
    for (int tile = 0; tile < AT_NT + 1; ++tile) {
        if (tile >= ntile) break;
        const int tq0 = tile < AT_NT ? q0 + (wid >> 2) * (AT_QT / 2) + tile * 16 : 2048;
        const int koff = tq0 - q0;
        const int t = tq0 + i16;
        f32x4 s[10];
#pragma unroll
        for (int nt = 1; nt < 10; ++nt) {
            const LAS bf16_t* kp = Ks + (koff + nt * 16 + i16) * AT_KS + 8 * g;
            const bf16x8 k0 = *(const LAS bf16x8*)kp, k1 = *(const LAS bf16x8*)(kp + 32);
            f32x4 a = (f32x4){0.f, 0.f, 0.f, 0.f};
            a = __builtin_amdgcn_mfma_f32_16x16x32_bf16(k0, qf[tile][0], a, 0, 0, 0);
            a = __builtin_amdgcn_mfma_f32_16x16x32_bf16(k1, qf[tile][1], a, 0, 0, 0);
            s[nt] = a;
        }
        const LAS float* bp = biasL + h * BIAS_STRIDE + BIAS_PAD + 144 + i16 - 4 * g;
        float mx = sink;
        if (tq0 >= 144) {
#pragma unroll
            for (int nt = 1; nt < 10; ++nt)
#pragma unroll
                for (int r = 0; r < 4; ++r) { const float v = s[nt][r] * 0.125f + bp[-(nt * 16 + r)]; s[nt][r] = v; mx = fmaxf(mx, v); }
        } else {
#pragma unroll
            for (int nt = 1; nt < 10; ++nt)
#pragma unroll
                for (int r = 0; r < 4; ++r) { const int tk = tq0 - 144 + nt * 16 + 4 * g + r; const float v = tk >= 0 ? s[nt][r] * 0.125f + bp[-(nt * 16 + r)] : -INFINITY; s[nt][r] = v; mx = fmaxf(mx, v); }
        }
        mx = fmaxf(mx, __shfl_xor(mx, 16)); mx = fmaxf(mx, __shfl_xor(mx, 32));
        float sum = 0.f;
        *(LAS u32x2*)(Pw + i16 * AT_PS + 4 * g) = (u32x2){0u, 0u};
#pragma unroll
        for (int nt = 1; nt < 10; ++nt) {
            const float e0 = __expf(s[nt][0] - mx), e1 = __expf(s[nt][1] - mx), e2 = __expf(s[nt][2] - mx), e3 = __expf(s[nt][3] - mx);
            sum += (e0 + e1) + (e2 + e3);
            u32x2 w; w.x = cvt_pk_bf16(e0, e1); w.y = cvt_pk_bf16(e2, e3);
            *(LAS u32x2*)(Pw + i16 * AT_PS + nt * 16 + 4 * g) = w;
        }
        sum += __shfl_xor(sum, 16); sum += __shfl_xor(sum, 32);
        const float inv = 1.f / (sum + __expf(sink - mx));
        LDS_WAIT(); __builtin_amdgcn_wave_barrier();
        f32x4 o[4];
#pragma unroll
        for (int dn = 0; dn < 4; ++dn) o[dn] = (f32x4){0.f, 0.f, 0.f, 0.f};
#pragma unroll
        for (int ks = 0; ks < 5; ++ks) {
            const bf16x8 pf = *(const LAS bf16x8*)(Pw + i16 * AT_PS + ks * 32 + 8 * g);
#pragma unroll
            for (int dn = 0; dn < 4; ++dn) {
                const bf16x8 vf = *(const LAS bf16x8*)(Vt + (dn * 16 + i16) * AT_VS + koff + ks * 32 + 8 * g);
                o[dn] = __builtin_amdgcn_mfma_f32_16x16x32_bf16(vf, pf, o[dn], 0, 0, 0);
            }
        }
        if (t < LSEQ) {
            bf16_t* op = mixin + (size_t)(rowb + t) * D + h * 64 + 4 * g;
#pragma unroll
            for (int dn = 0; dn < 4; ++dn) { u32x2 w; w.x = cvt_pk_bf16(o[dn][0] * inv, o[dn][1] * inv); w.y = cvt_pk_bf16(o[dn][2] * inv, o[dn][3] * inv); *(u32x2*)(op + dn * 16) = w; }
        }
        LDS_WAIT(); __builtin_amdgcn_wave_barrier();
    }
    __syncthreads();
}

__device__ __forceinline__ void attn_sample_wave(LAS unsigned char* lds, int l, int b, int h, const Params& p, const bf16_t* __restrict__ z, bf16_t* mixin, int wid, int lane) {
    LAS float* qs = (LAS float*)(lds + wid * 1024);
    LAS float* ps = qs + 64;
    const LAS float* biasL = (const LAS float*)(lds + BIAS_OFF);
    const int kvh = h >> 2;
    const bf16_t* zr = z + (size_t)(MPROMPT + b) * INDIM;
    const float qv = __uint_as_float((unsigned)zr[ZQ + h * 64 + lane] << 16) * 0.125f;
    qs[lane] = qv;
    LDS_WAIT(); __builtin_amdgcn_wave_barrier();
    const float* ck = p.cache_k + (((size_t)l * DB + b) * WIN) * 256 + kvh * 64;
    const float* cv = p.cache_v + (((size_t)l * DB + b) * WIN) * 256 + kvh * 64;
    float sc0 = 0.f, sc1 = 0.f;
    {
        const f32x4* k0 = (const f32x4*)(ck + (size_t)lane * 256); const f32x4* k1 = (const f32x4*)(ck + (size_t)(lane + 64) * 256);
#pragma unroll
        for (int d4 = 0; d4 < 16; ++d4) { const f32x4 q4 = *(const LAS f32x4*)(qs + 4 * d4); const f32x4 a = k0[d4], c = k1[d4];
            sc0 += (a.x * q4.x + a.y * q4.y) + (a.z * q4.z + a.w * q4.w); sc1 += (c.x * q4.x + c.y * q4.y) + (c.z * q4.z + c.w * q4.w); }
    }
    const float knew = __uint_as_float((unsigned)zr[ZK + kvh * 64 + lane] << 16);
    const float sc2 = wave_sum(qv * knew);
    const float sink = p.sinks[l * NHEADS + h];
    const float v0 = sc0 + biasL[h * BIAS_STRIDE + BIAS_PAD + (WIN - lane)], v1 = sc1 + biasL[h * BIAS_STRIDE + BIAS_PAD + (64 - lane)], v2 = sc2 + biasL[h * BIAS_STRIDE + BIAS_PAD];
    float mx = wave_max(fmaxf(v0, v1)); mx = fmaxf(mx, fmaxf(v2, sink));
    const float e0 = __expf(v0 - mx), e1 = __expf(v1 - mx), e2 = __expf(v2 - mx);
    const float sum = wave_sum(e0 + e1) + e2 + __expf(sink - mx);
    ps[lane] = e0; ps[lane + 64] = e1;
    LDS_WAIT(); __builtin_amdgcn_wave_barrier();
    const int sg = lane >> 4, dq = lane & 15;
    f32x4 oa = (f32x4){0.f, 0.f, 0.f, 0.f}, ob4 = (f32x4){0.f, 0.f, 0.f, 0.f};
#pragma unroll
    for (int it = 0; it < 2; ++it) {
        f32x4 vr[16];
#pragma unroll
        for (int i = 0; i < 16; ++i) vr[i] = *(const f32x4*)(cv + (size_t)(sg + 4 * (i + 16 * it)) * 256 + 4 * dq);
#pragma unroll
        for (int i = 0; i < 16; i += 2) { oa += vr[i] * ps[sg + 4 * (i + 16 * it)]; ob4 += vr[i + 1] * ps[sg + 4 * (i + 1 + 16 * it)]; }
    }
    oa += ob4;
#pragma unroll
    for (int c = 0; c < 4; ++c) { oa[c] += __shfl_xor(oa[c], 16); oa[c] += __shfl_xor(oa[c], 32); }
    if (sg == 0) {
        const u32x2 vn = *(const u32x2*)(zr + ZV + kvh * 64 + 4 * dq);
        const float rs_ = 1.f / sum;
        const float o0 = (oa[0] + e2 * bf_lo(vn.x)) * rs_, o1 = (oa[1] + e2 * bf_hi(vn.x)) * rs_, o2 = (oa[2] + e2 * bf_lo(vn.y)) * rs_, o3 = (oa[3] + e2 * bf_hi(vn.y)) * rs_;
        u32x2 w; w.x = cvt_pk_bf16(o0, o1); w.y = cvt_pk_bf16(o2, o3);
        *(u32x2*)(mixin + (size_t)(MPROMPT + b) * D + h * 64 + 4 * dq) = w;
    }
    LDS_WAIT(); __builtin_amdgcn_wave_barrier();
}

__device__ __forceinline__ void unpack8(const u32x4 a, float (&o)[8]) { o[0] = bf_lo(a.x); o[1] = bf_hi(a.x); o[2] = bf_lo(a.y); o[3] = bf_hi(a.y); o[4] = bf_lo(a.z); o[5] = bf_hi(a.z); o[6] = bf_lo(a.w); o[7] = bf_hi(a.w); }
__device__ __forceinline__ void conv_row(int l, int m, const Params& p, const bf16_t* __restrict__ z, bf16_t* mixin, int lane) {
    const float* cw = p.conv_w + (size_t)l * 3 * CDIM;
    const bool prompt = m < MPROMPT;
    const int b = prompt ? m / LSEQ : m - MPROMPT, t = prompt ? m % LSEQ : 0;
    const bf16_t* zr = z + (size_t)m * INDIM;
    const bf16_t* z1 = (prompt && t >= 1) ? zr - INDIM : zr;
    const bf16_t* z2 = (prompt && t >= 2) ? zr - 2 * INDIM : zr;
    const float k1 = (prompt && t >= 1) ? 1.f : 0.f, k2 = (prompt && t >= 2) ? 1.f : 0.f;
    const float* st = p.state_conv + (((size_t)l * DB + (prompt ? 0 : b)) * 2) * CDIM;
    u32x4 gbv[2], gcv[2], hcv[2], a1[2], c1[2], a2[2], c2[2]; f32x4 sv[2][4], wv[2][6];
#pragma unroll
    for (int j = 0; j < 2; ++j) {
        const int c0 = lane * 8 + 512 * j;
        gbv[j] = *(const u32x4*)(zr + ZGB + c0); gcv[j] = *(const u32x4*)(zr + ZGC + c0); hcv[j] = *(const u32x4*)(zr + ZHC + c0);
        a1[j] = *(const u32x4*)(z1 + ZGC + c0); c1[j] = *(const u32x4*)(z1 + ZHC + c0); a2[j] = *(const u32x4*)(z2 + ZGC + c0); c2[j] = *(const u32x4*)(z2 + ZHC + c0);
        if (!prompt) { sv[j][0] = *(const f32x4*)(st + c0); sv[j][1] = *(const f32x4*)(st + c0 + 4); sv[j][2] = *(const f32x4*)(st + CDIM + c0); sv[j][3] = *(const f32x4*)(st + CDIM + c0 + 4); }
#pragma unroll
        for (int i = 0; i < 3; ++i) { wv[j][2 * i] = *(const f32x4*)(cw + i * CDIM + c0); wv[j][2 * i + 1] = *(const f32x4*)(cw + i * CDIM + c0 + 4); }
    }
#pragma unroll
    for (int j = 0; j < 2; ++j) {
        const int c0 = lane * 8 + 512 * j;
        float gb[8], gc[8], hc[8], u0[8], u1[8], u2[8], x[8], y[8];
        unpack8(gbv[j], gb); unpack8(gcv[j], gc); unpack8(hcv[j], hc);
#pragma unroll
        for (int i = 0; i < 8; ++i) u0[i] = gc[i] * hc[i];
        if (prompt) {
            unpack8(a1[j], x); unpack8(c1[j], y);
#pragma unroll
            for (int i = 0; i < 8; ++i) u1[i] = x[i] * y[i] * k1;
            unpack8(a2[j], x); unpack8(c2[j], y);
#pragma unroll
            for (int i = 0; i < 8; ++i) u2[i] = x[i] * y[i] * k2;
            if (t >= LSEQ - 2) { float* co = p.out + O_CP + (((size_t)l * NBATCH + b) * 2 + (t - (LSEQ - 2))) * CDIM + c0;
                *(f32x4*)co = (f32x4){u0[0], u0[1], u0[2], u0[3]}; *(f32x4*)(co + 4) = (f32x4){u0[4], u0[5], u0[6], u0[7]}; }
        } else {
#pragma unroll
            for (int i = 0; i < 4; ++i) { u2[i] = sv[j][0][i]; u2[4 + i] = sv[j][1][i]; u1[i] = sv[j][2][i]; u1[4 + i] = sv[j][3][i]; }
            float* co = p.out + O_CS + (((size_t)l * DB + b) * 2) * CDIM + c0;
            *(f32x4*)co = sv[j][2]; *(f32x4*)(co + 4) = sv[j][3];
            *(f32x4*)(co + CDIM) = (f32x4){u0[0], u0[1], u0[2], u0[3]}; *(f32x4*)(co + CDIM + 4) = (f32x4){u0[4], u0[5], u0[6], u0[7]};
        }
        float r[8];
#pragma unroll
        for (int i = 0; i < 8; ++i) { const float w0 = wv[j][i >> 2][i & 3], w1 = wv[j][2 + (i >> 2)][i & 3], w2 = wv[j][4 + (i >> 2)][i & 3]; r[i] = gb[i] * (w0 * u2[i] + w1 * u1[i] + w2 * u0[i]); }
        u32x4 w; w.x = cvt_pk_bf16(r[0], r[1]); w.y = cvt_pk_bf16(r[2], r[3]); w.z = cvt_pk_bf16(r[4], r[5]); w.w = cvt_pk_bf16(r[6], r[7]);
        *(u32x4*)(mixin + (size_t)m * D + 1024 + c0) = w;
    }
}

__device__ __forceinline__ void conv_job4(int l, int m0, const Params& p, const bf16_t* __restrict__ z, bf16_t* mixin, int lane) {
    const float* cw = p.conv_w + (size_t)l * 3 * CDIM;
    const int b = m0 / LSEQ, t0 = m0 % LSEQ;
    const float kprev = t0 > 0 ? 1.f : 0.f;
    const bf16_t* zr = z + (size_t)m0 * INDIM;
    const bf16_t* zp = t0 > 0 ? zr - 2 * INDIM : zr;
#pragma unroll
    for (int j = 0; j < 2; ++j) {
        const int c0 = lane * 8 + 512 * j;
        u32x4 gcv[6], hcv[6], gbv[4]; f32x4 wv[6];
        gcv[0] = *(const u32x4*)(zp + ZGC + c0); hcv[0] = *(const u32x4*)(zp + ZHC + c0);
        gcv[1] = *(const u32x4*)(zp + INDIM + ZGC + c0); hcv[1] = *(const u32x4*)(zp + INDIM + ZHC + c0);
#pragma unroll
        for (int r = 0; r < 4; ++r) { gcv[2 + r] = *(const u32x4*)(zr + (size_t)r * INDIM + ZGC + c0); hcv[2 + r] = *(const u32x4*)(zr + (size_t)r * INDIM + ZHC + c0); gbv[r] = *(const u32x4*)(zr + (size_t)r * INDIM + ZGB + c0); }
#pragma unroll
        for (int i = 0; i < 3; ++i) { wv[2 * i] = *(const f32x4*)(cw + i * CDIM + c0); wv[2 * i + 1] = *(const f32x4*)(cw + i * CDIM + c0 + 4); }
        float u[6][8];
#pragma unroll
        for (int r = 0; r < 6; ++r) { float x[8], y[8]; unpack8(gcv[r], x); unpack8(hcv[r], y); const float k = r < 2 ? kprev : 1.f;
#pragma unroll
            for (int i = 0; i < 8; ++i) u[r][i] = x[i] * y[i] * k; }
#pragma unroll
        for (int r = 0; r < 4; ++r) {
            float gb[8], o[8]; unpack8(gbv[r], gb);
#pragma unroll
            for (int i = 0; i < 8; ++i) { const float w0 = wv[i >> 2][i & 3], w1 = wv[2 + (i >> 2)][i & 3], w2 = wv[4 + (i >> 2)][i & 3]; o[i] = gb[i] * (w0 * u[r][i] + w1 * u[r + 1][i] + w2 * u[r + 2][i]); }
            u32x4 w; w.x = cvt_pk_bf16(o[0], o[1]); w.y = cvt_pk_bf16(o[2], o[3]); w.z = cvt_pk_bf16(o[4], o[5]); w.w = cvt_pk_bf16(o[6], o[7]);
            *(u32x4*)(mixin + (size_t)(m0 + r) * D + 1024 + c0) = w;
        }
        if (t0 == LSEQ - 4) {
#pragma unroll
            for (int r = 0; r < 2; ++r) { float* co = p.out + O_CP + (((size_t)l * NBATCH + b) * 2 + r) * CDIM + c0;
                *(f32x4*)co = (f32x4){u[4 + r][0], u[4 + r][1], u[4 + r][2], u[4 + r][3]}; *(f32x4*)(co + 4) = (f32x4){u[4 + r][4], u[4 + r][5], u[4 + r][6], u[4 + r][7]}; }
        }
    }
}

__device__ __forceinline__ void kv_prompt_row(int l, int idx, const Params& p, const bf16_t* __restrict__ z, int lane) {
    const int b = idx >> 7, w = idx & 127;
    const bf16_t* zr = z + (size_t)(b * LSEQ + (LSEQ - WIN) + w) * INDIM;
    const u32x2 kv = *(const u32x2*)(zr + ZK + 4 * lane), vv = *(const u32x2*)(zr + ZV + 4 * lane);
    const size_t o = (((size_t)l * NBATCH + b) * WIN + w) * 256 + 4 * lane;
    *(f32x4*)(p.out + O_KP + o) = (f32x4){bf_lo(kv.x), bf_hi(kv.x), bf_lo(kv.y), bf_hi(kv.y)};
    *(f32x4*)(p.out + O_VP + o) = (f32x4){bf_lo(vv.x), bf_hi(vv.x), bf_lo(vv.y), bf_hi(vv.y)};
}
__device__ __forceinline__ void kv_sample_row(int l, int idx, const Params& p, const bf16_t* __restrict__ z, int lane) {
    const int b = idx >> 7, w = idx & 127;
    const size_t o = (((size_t)l * DB + b) * WIN + w) * 256 + 4 * lane;
    f32x4 kq, vq;
    if (w < WIN - 1) { kq = *(const f32x4*)(p.cache_k + o + 256); vq = *(const f32x4*)(p.cache_v + o + 256); }
    else { const bf16_t* zr = z + (size_t)(MPROMPT + b) * INDIM; const u32x2 kv = *(const u32x2*)(zr + ZK + 4 * lane), vv = *(const u32x2*)(zr + ZV + 4 * lane);
        kq = (f32x4){bf_lo(kv.x), bf_hi(kv.x), bf_lo(kv.y), bf_hi(kv.y)}; vq = (f32x4){bf_lo(vv.x), bf_hi(vv.x), bf_lo(vv.y), bf_hi(vv.y)}; }
    *(f32x4*)(p.out + O_KS + o) = kq; *(f32x4*)(p.out + O_VS + o) = vq;
}

__device__ __forceinline__ void kv_sample_row2(int l, int i0, int i1, const Params& p, const bf16_t* __restrict__ z, int lane) {
    f32x4 kq[2], vq[2]; size_t o[2]; const int idx[2] = {i0, i1};
#pragma unroll
    for (int e = 0; e < 2; ++e) {
        const int b = idx[e] >> 7, w = idx[e] & 127;
        o[e] = (((size_t)l * DB + b) * WIN + w) * 256 + 4 * lane;
        if (w < WIN - 1) { kq[e] = *(const f32x4*)(p.cache_k + o[e] + 256); vq[e] = *(const f32x4*)(p.cache_v + o[e] + 256); }
        else { const bf16_t* zr = z + (size_t)(MPROMPT + b) * INDIM; const u32x2 kv = *(const u32x2*)(zr + ZK + 4 * lane), vv = *(const u32x2*)(zr + ZV + 4 * lane);
            kq[e] = (f32x4){bf_lo(kv.x), bf_hi(kv.x), bf_lo(kv.y), bf_hi(kv.y)}; vq[e] = (f32x4){bf_lo(vv.x), bf_hi(vv.x), bf_lo(vv.y), bf_hi(vv.y)}; }
    }
#pragma unroll
    for (int e = 0; e < 2; ++e) { *(f32x4*)(p.out + O_KS + o[e]) = kq[e]; *(f32x4*)(p.out + O_VS + o[e]) = vq[e]; }
}

__device__ __forceinline__ void filler_cache_copy(const Params& p, int l, int nwg, int wid, int lane) {
    const int G = gridDim.x, r = nwg % G, c = blockIdx.x;
    int worker, nw;
    if (r == 0) { worker = c * 8 + wid; nw = G * 8; } else if (c >= r) { worker = (c - r) * 8 + wid; nw = (G - r) * 8; } else return;
    for (int i = worker; i < DB * WIN / 2; i += nw) {
        const int i1 = i + DB * WIN / 2;
        if ((i & 127) != 127) kv_sample_row2(l, i, i1, p, (const bf16_t*)(p.ws + WS_ZACT), lane);
    }
}

constexpr int NU_ATT = NBATCH * 4 * 16;

__device__ __forceinline__ void mixer_phase(const Params& p, int l, LAS unsigned char* lds, int tid, int wid, int lane, unsigned long long& tacc_, unsigned long long& t0_) {
    const bf16_t* z = (const bf16_t*)(p.ws + WS_ZACT); bf16_t* mixin = (bf16_t*)(p.ws + WS_MIXIN);
    TB(9);
    for (int u = blockIdx.x; u < NU_ATT; u += gridDim.x) { const int qt = u & 15, bk = u >> 4; attn_prompt_unit(lds, bk >> 2, bk & 3, qt, z, mixin, p.sinks + l * NHEADS, tid, wid, lane); }
    TE(9);
    TB(10);
    const int gw = blockIdx.x * 8 + wid, NGW = gridDim.x * 8;
    if (gw < MPROMPT / 4) conv_job4(l, 4 * gw, p, z, mixin, lane);
    for (int j = NGW + (gw >> 7); j < MPROMPT / 4 && (gw & 127) == 5; j += NGW >> 7) conv_job4(l, 4 * j, p, z, mixin, lane);
    if ((gw & 63) == 33 && (gw >> 6) < DB) conv_row(l, MPROMPT + (gw >> 6), p, z, mixin, lane);
    if ((gw & 3) == 0 && (gw >> 2) < DB * NHEADS) { const int job = gw >> 2; attn_sample_wave(lds, l, job >> 4, job & 15, p, z, mixin, wid, lane); }
    for (int i = (int)NGW - 1 - gw; i < NBATCH * WIN; i += NGW) kv_prompt_row(l, i, p, z, lane);
    if ((gw & 63) == 34 && (gw >> 6) < DB) kv_sample_row(l, (gw >> 6) * WIN + (WIN - 1), p, z, lane);
    TE(10);
}

__global__ void __launch_bounds__(512, 2) hymba_fwd(Params p) {
    extern __shared__ __attribute__((aligned(16))) unsigned char lds_raw[];
    LAS unsigned char* lds = (LAS unsigned char*)lds_raw;
    cg::grid_group grid = cg::this_grid();
    const int tid = threadIdx.x, lane = tid & 63, wid = __builtin_amdgcn_readfirstlane(tid >> 6);

    unsigned* barw = (unsigned*)(p.ws + WS_BAR);
    unsigned* cntw = (unsigned*)(p.ws + WS_CNT);
    volatile LAS unsigned* xst = (volatile LAS unsigned*)(lds + MISC_OFF);
    if (tid < 2) xst[tid] = 0u;
    __syncthreads();
    const XcdBarrier xb = xcd_barrier_post(barw, xst);
    {
        LAS float* biasL = (LAS float*)(lds + BIAS_OFF);
        for (int i = tid; i < NHEADS * BIAS_STRIDE; i += 512) {
            const int h = i / BIAS_STRIDE, d = i % BIAS_STRIDE - BIAS_PAD;
            float v = -INFINITY;
            if (d >= 0 && d <= WIN) {
                int bkt;
                if (d < 16) bkt = d;
                else { const float df = (float)d; bkt = 16 + (int)(logf(df / 16.f) / logf(8.f) * 16.f); bkt = bkt > 31 ? 31 : bkt; }
                v = p.rel_bias[bkt * NHEADS + h];
            }
            biasL[i] = v;
        }
    }
    unsigned long long tacc_ = 0, t0_ = 0;
    TB(0);
    for (int rep = 0; rep < REP_PRO; ++rep) prologue(p, lds, wid, lane);
    TE(0);
    if (p.ws == nullptr) grid.sync();
    GSYNC();

    bf16_t* ZACT = (bf16_t*)(p.ws + WS_ZACT); bf16_t* MIXIN = (bf16_t*)(p.ws + WS_MIXIN); bf16_t* MIXB = (bf16_t*)(p.ws + WS_MIXB); bf16_t* MIXB1 = (bf16_t*)(p.ws + WS_MIXB1);
    const int vcu = (gridDim.x % 8 == 0) ? (int)((blockIdx.x % 8) * (gridDim.x / 8) + blockIdx.x / 8) : (int)blockIdx.x;
    const bf16_t* HB = (const bf16_t*)(p.ws + WS_HB); const float* RS = (const float*)(p.ws + WS_RS);
#pragma unroll 1
    for (int l = 0; l < DEPTH; ++l) {
        TB(1);
        {
            pg8::Gemm g{HB, (const bf16_t*)(p.ws + WS_WIN + l * SZ_WIN), MP, INDIM, D}; pg8::Epi<0> E{ZACT, INDIM, RS, ZACT};
            pg8::StaticOrder S; S.init(MP, INDIM, D, (int)gridDim.x, (int)blockIdx.x);
            for (int rep = 0; rep < REP_GIN; ++rep) pg8::gemm_phase<D, pg8::Epi<0>, pg8::StaticOrder>(lds, g, S, E);
            for (int rep = 0; rep < REP_FILL; ++rep) { int t2 = threadIdx.x; asm volatile("" : "+v"(t2)); const int w2 = __builtin_amdgcn_readfirstlane(t2 >> 6), l2 = t2 & 63;
                filler(p, l, I_IN, I_LAYER - I_DN, (MP / 256) * (INDIM / 256), lds, w2, l2);
                if (l + 1 < DEPTH) filler(p, l + 1, 0, I_IN / 2, (MP / 256) * (INDIM / 256), lds, w2, l2);
                filler_cache_copy(p, l, (MP / 256) * (INDIM / 256), w2, l2); }
        }
        TE(1);
        GSYNC();
        TB(2);
#ifndef NO_MIX
        for (int rep = 0; rep < REP_MIX; ++rep) { int t2 = threadIdx.x; asm volatile("" : "+v"(t2)); mixer_phase(p, l, lds, t2, __builtin_amdgcn_readfirstlane(t2 >> 6), t2 & 63, tacc_, t0_); }
#endif
        TE(2);
        GSYNC();
        TB(3);
        {
            pg8::Gemm g{MIXIN, (const bf16_t*)(p.ws + WS_WOUT + l * SZ_WOUT), MP, D, D}; pg8::Epi<0> E{MIXB, D, nullptr, MIXB1};
            pg8::StreamKOrder<D / 128> S; S.init((int)gridDim.x, vcu);
            for (int rep = 0; rep < REP_GOUT; ++rep) pg8::gemm_phase<D, pg8::Epi<0>, pg8::StreamKOrder<D / 128>>(lds, g, S, E);
            TE(3);
            TB(4);
            { int t2 = threadIdx.x; asm volatile("" : "+v"(t2)); sk_postnorm<D / 128>(p, S, cntw + (size_t)((l * 2 + 0) * 33) * 16, p.n_post_mix + l * D, false, vcu, t2, __builtin_amdgcn_readfirstlane(t2 >> 6), t2 & 63, tacc_, t0_); }
        }
        TE(4);
        GSYNC();
        TB(5);
        {
            pg8::Gemm g{HB, (const bf16_t*)(p.ws + WS_WGU + l * SZ_WGU), MP, NGU, D}; pg8::Epi<1> E{ZACT, DFF, RS, ZACT};
            pg8::StaticOrder S; S.init(MP, NGU, D, (int)gridDim.x, (int)blockIdx.x);
            for (int rep = 0; rep < REP_GGU; ++rep) pg8::gemm_phase<D, pg8::Epi<1>, pg8::StaticOrder>(lds, g, S, E);
            for (int rep = 0; rep < REP_FILL; ++rep) { int t2 = threadIdx.x; asm volatile("" : "+v"(t2)); const int w2 = __builtin_amdgcn_readfirstlane(t2 >> 6), l2 = t2 & 63;
                filler(p, l, I_LAYER - I_DN, I_LAYER, (MP / 256) * (NGU / 256), lds, w2, l2);
                if (l + 1 < DEPTH) filler(p, l + 1, I_IN / 2, I_IN, (MP / 256) * (NGU / 256), lds, w2, l2); }
        }
        TE(5);
        GSYNC();
        TB(6);
        {
            pg8::Gemm g{ZACT, (const bf16_t*)(p.ws + WS_WDN + l * SZ_WDN), MP, D, DFF}; pg8::Epi<0> E{MIXB, D, nullptr, MIXB1};
            pg8::StreamKOrder<DFF / 128> S; S.init((int)gridDim.x, vcu);
            for (int rep = 0; rep < REP_GDN; ++rep) pg8::gemm_phase<DFF, pg8::Epi<0>, pg8::StreamKOrder<DFF / 128>>(lds, g, S, E);
            TE(6);
            TB(7);
            { int t2 = threadIdx.x; asm volatile("" : "+v"(t2)); sk_postnorm<DFF / 128>(p, S, cntw + (size_t)((l * 2 + 1) * 33) * 16, p.n_post_ffn + l * D, l == DEPTH - 1, vcu, t2, __builtin_amdgcn_readfirstlane(t2 >> 6), t2 & 63, tacc_, t0_); }
        }
        TE(7);
        if (l != DEPTH - 1) GSYNC();
    }
    if (TMASK != 0 && blockIdx.x == TBLK) { const unsigned long long tend = __builtin_amdgcn_s_memrealtime() + (unsigned long long)TMULT * tacc_; while (__builtin_amdgcn_s_memrealtime() < tend) __builtin_amdgcn_s_sleep(8); }
}

extern "C" void kernel_launch(void* const* d_in, const int* in_sizes, int n_in, void* d_out, int out_size, void* d_ws, size_t ws_size, hipStream_t stream) {
    static int grid_blocks = 0;
    if (grid_blocks == 0) {
        if (n_in != 18 || ws_size < WS_END) { fprintf(stderr, "kernel_launch: unexpected inputs (n_in %d, ws %zu, need %zu)\n", n_in, ws_size, (size_t)WS_END); grid_blocks = -1; return; }
        int dev = 0, cus = 0, per_cu = 0;
        hipGetDevice(&dev);
        hipDeviceGetAttribute(&cus, hipDeviceAttributeMultiprocessorCount, dev);
        hipFuncSetAttribute((const void*)hymba_fwd, hipFuncAttributeMaxDynamicSharedMemorySize, LDS_BYTES);
        hipOccupancyMaxActiveBlocksPerMultiprocessor(&per_cu, (const void*)hymba_fwd, 512, LDS_BYTES);
        if (per_cu < 1) per_cu = 1;
        grid_blocks = cus * per_cu;
    }
    if (grid_blocks < 0) return;
    if (hipMemsetAsync((char*)d_ws + WS_BAR, 0, WS_END - WS_BAR, stream) != hipSuccess) { fprintf(stderr, "kernel_launch: memset of the barrier words failed\n"); return; }
    Params p{};
    const float** pp = (const float**)&p;
    for (int i = 0; i < 18; ++i) pp[i] = (const float*)d_in[i];
    p.out = (float*)d_out; p.ws = (unsigned char*)d_ws;
    void* args[] = {&p};
    hipError_t e = hipLaunchCooperativeKernel((const void*)hymba_fwd, dim3(grid_blocks), dim3(512), args, LDS_BYTES, stream);
    if (e != hipSuccess) fprintf(stderr, "cooperative launch failed: %s (grid %d)\n", hipGetErrorString(e), grid_blocks);
}
```

```cpp
#include <hip/hip_runtime.h>
#include <hip/hip_cooperative_groups.h>
#include <cstdio>
#include <cstdint>
namespace cg = cooperative_groups;
#define REP_PRO 1
#define REP_MIX 1
#define REP_GIN 1
#define REP_GOUT 1
#define REP_GGU 1
#define REP_GDN 1
#define EXTRA_SYNC 0
#define REP_PN 0
#define REP_FILL 1
#define WGM_SET 5
#define TMASK 0
#define TMULT 4
#define TBLK 0
#define TB(k) do { if (TMASK & (1 << (k))) t0_ = __builtin_amdgcn_s_memrealtime(); } while (0)
#define TE(k) do { if (TMASK & (1 << (k))) tacc_ += __builtin_amdgcn_s_memrealtime() - t0_; } while (0)
#define GSYNC() do { TB(8); xcd_barrier(xb); for (int e_ = 0; e_ < EXTRA_SYNC; ++e_) xcd_barrier(xb); TE(8); } while (0)

#define LAS __attribute__((address_space(3)))
typedef unsigned short bf16_t;
typedef short bf16x8 __attribute__((ext_vector_type(8)));
typedef float f32x4 __attribute__((ext_vector_type(4)));
typedef float f32x2 __attribute__((ext_vector_type(2)));
typedef unsigned u32x4 __attribute__((ext_vector_type(4)));
typedef unsigned u32x2 __attribute__((ext_vector_type(2)));

constexpr int D = 2048, NBATCH = 4, SEQ = 2048, NMETA = 16, LSEQ = SEQ + NMETA, DEPTH = 4, DB = 32, WIN = 128;
constexpr int MPROMPT = NBATCH * LSEQ;
constexpr int MREAL = MPROMPT + DB;
constexpr int MP = 8448;
constexpr int INDIM = 4608, DFF = 5632, NGU = 2 * DFF, CDIM = 1024;
constexpr int ZQ = 0, ZK = 1024, ZV = 1280, ZGB = 1536, ZGC = 2560, ZHC = 3584;
constexpr float RMS_EPS = 1e-6f;
constexpr int NHEADS = 16;

constexpr size_t O_YP = 0, O_YS = 16777216, O_KP = 16842752, O_VP = 17367040, O_CP = 17891328, O_KS = 17924096, O_VS = 22118400, O_CS = 26312704;

constexpr size_t SZ_WIN = (size_t)INDIM * D * 2, SZ_WOUT = (size_t)D * D * 2, SZ_WGU = (size_t)NGU * D * 2, SZ_WDN = (size_t)D * DFF * 2;
constexpr size_t WS_WIN = 0;
constexpr size_t WS_WOUT = WS_WIN + DEPTH * SZ_WIN;
constexpr size_t WS_WGU = WS_WOUT + DEPTH * SZ_WOUT;
constexpr size_t WS_WDN = WS_WGU + DEPTH * SZ_WGU;
constexpr size_t WS_ZACT = WS_WDN + DEPTH * SZ_WDN;
constexpr size_t WS_MIXIN = WS_ZACT + (size_t)MP * DFF * 2;
constexpr size_t WS_MIXB = WS_MIXIN + (size_t)MP * D * 2;
constexpr size_t WS_MIXB1 = WS_MIXB + (size_t)MP * D * 2;
constexpr size_t WS_HB = WS_MIXB1 + (size_t)MP * D * 2;
constexpr size_t WS_RS = WS_HB + (size_t)MP * D * 2;
constexpr size_t WS_BAR = WS_RS + (size_t)MP * 4;
constexpr size_t WS_CNT = WS_BAR + 16384;
constexpr size_t WS_END = WS_CNT + (size_t)DEPTH * 2 * 33 * 64;

constexpr int RING_BYTES = 131072, BIAS_OFF = RING_BYTES, LDS_BYTES = 147456;
constexpr int BIAS_STRIDE = 176, BIAS_PAD = 16;
constexpr int MISC_OFF = BIAS_OFF + NHEADS * BIAS_STRIDE * 4;

__device__ __forceinline__ unsigned cvt_pk_bf16(float lo, float hi) { unsigned r; asm volatile("v_cvt_pk_bf16_f32 %0, %1, %2" : "=v"(r) : "v"(lo), "v"(hi)); return r; }
__device__ __forceinline__ float bf_lo(unsigned u) { return __uint_as_float(u << 16); }
__device__ __forceinline__ float bf_hi(unsigned u) { return __uint_as_float(u & 0xffff0000u); }
__device__ __forceinline__ float wave_sum(float v) {
#pragma unroll
    for (int o = 1; o < 64; o <<= 1) v += __shfl_xor(v, o);
    return v;
}
__device__ __forceinline__ float wave_max(float v) {
#pragma unroll
    for (int o = 1; o < 64; o <<= 1) v = fmaxf(v, __shfl_xor(v, o));
    return v;
}
#define LDS_WAIT() asm volatile("s_waitcnt lgkmcnt(0)" ::: "memory")
#define WT_STORES 0
#define WT_SK 1
#define WT_LAST 0
__device__ __forceinline__ void store16_wt(void* p, u32x4 v, bool wt) {
    if (wt) asm volatile("global_store_dwordx4 %0, %1, off sc1\n\ts_nop 1" :: "v"(p), "v"(v) : "memory");
    else *(u32x4*)p = v;
}
__device__ __forceinline__ void store8_wt(void* p, u32x2 v) {
#if WT_STORES
    asm volatile("global_store_dwordx2 %0, %1, off sc1\n\ts_nop 1" :: "v"(p), "v"(v) : "memory");
#else
    *(u32x2*)p = v;
#endif
}


#define XB_TMO      128
#define XB_XCNT(j)  (256  + 64 * (j))
#define XB_XSUB(j)  (1280 + 64 * (j))
#define XB_XGEN(j)  (2304 + 64 * (j))
#define XB_TOP      3328
#define XB_TOPGEN   3392
#define XCD_BAR_WORDS 3456
#define XB_SPIN_CAP (1u << 18)
__device__ __forceinline__ unsigned xb_ld(unsigned* p)              { return __hip_atomic_load(p, __ATOMIC_RELAXED, __HIP_MEMORY_SCOPE_AGENT); }
__device__ __forceinline__ unsigned xb_add(unsigned* p, unsigned v) { return __hip_atomic_fetch_add(p, v, __ATOMIC_RELAXED, __HIP_MEMORY_SCOPE_AGENT); }
__device__ __forceinline__ unsigned xb_xcc_id() { return (unsigned)__builtin_amdgcn_s_getreg((3 << 11) | 20) & 0xFu; }
#define XB_SPIN(cond, bar) do { unsigned _sp = 0; while (cond) { __builtin_amdgcn_s_sleep(1); \
    if ((++_sp & 255u) == 0u) { if (xb_ld(&(bar)[XB_TMO])) break; if (_sp > XB_SPIN_CAP) { atomicAdd(&(bar)[XB_TMO], 1u); break; } } } } while (0)
struct XcdBarrier { unsigned* bar; unsigned x; volatile LAS unsigned* st; };
__device__ __forceinline__ XcdBarrier xcd_barrier_post(unsigned* bar, volatile LAS unsigned* st) {
    XcdBarrier b; b.bar = bar; b.x = xb_xcc_id(); b.st = st;
    if (threadIdx.x == 0) (void)xb_add(&bar[XB_XCNT(b.x)], 1u);
    return b;
}
__device__ __forceinline__ void xcd_barrier_complete(unsigned* bar, unsigned x, unsigned& nloc, unsigned& nx) {
    const unsigned G = gridDim.x * gridDim.y * gridDim.z;
    unsigned sum, cnt, mine, sp = 0u;
    for (;;) {
        sum = 0u; cnt = 0u; mine = 0u;
#pragma unroll
        for (unsigned j = 0; j < 16; ++j) { const unsigned c = xb_ld(&bar[XB_XCNT(j)]); sum += c; cnt += (c > 0u) ? 1u : 0u; mine = (j == x) ? c : mine; }
        if (sum == G) break;
        __builtin_amdgcn_s_sleep(1);
        if ((++sp & 255u) == 0u) { if (xb_ld(&bar[XB_TMO])) break; if (sp > XB_SPIN_CAP) { atomicAdd(&bar[XB_TMO], 1u); break; } }
    }
    nloc = mine > 0u ? mine : 1u; nx = cnt > 0u ? cnt : 1u;
}
__device__ __forceinline__ void xcd_barrier(const XcdBarrier& b) {
    asm volatile("s_waitcnt vmcnt(0)" ::: "memory");
    __syncthreads();
    if (threadIdx.x == 0) {
        unsigned* bar = b.bar;
        __builtin_amdgcn_s_waitcnt(0);
        unsigned nloc = b.st[0], nx = b.st[1];
        if (nloc == 0u) { xcd_barrier_complete(bar, b.x, nloc, nx); b.st[0] = nloc; b.st[1] = nx; }
        const unsigned old = xb_add(&bar[XB_XSUB(b.x)], 1u);
        const unsigned gen = old / nloc;
        if (old + 1u == (gen + 1u) * nloc) {
            __builtin_amdgcn_fence(__ATOMIC_RELEASE, "agent");
            asm volatile("s_waitcnt vmcnt(0)" ::: "memory");
            const unsigned og = xb_add(&bar[XB_TOP], 1u);
            const unsigned tg = og / nx;
            if (og + 1u == (tg + 1u) * nx) xb_add(&bar[XB_TOPGEN], 1u);
            else XB_SPIN(xb_ld(&bar[XB_TOPGEN]) == tg, bar);
            __builtin_amdgcn_fence(__ATOMIC_ACQUIRE, "agent");
            xb_add(&bar[XB_XGEN(b.x)], 1u);
            asm volatile("s_waitcnt vmcnt(0)" ::: "memory");
        } else {
            XB_SPIN(xb_ld(&bar[XB_XGEN(b.x)]) == gen, bar);
            __builtin_amdgcn_fence(__ATOMIC_ACQUIRE, "agent");
            asm volatile("s_waitcnt vmcnt(0)" ::: "memory");
        }
    }
    __syncthreads();
}

namespace pg8 {
constexpr int BM = 256, BK = 64, HALF = 128, HTB = HALF * BK * 2, STAGE_BYTES = 8 * HTB, NXCD = 8, WGM = WGM_SET;
__host__ __device__ __forceinline__ int lds_byte(int r, int c) { const int st = (r >> 4) * 2 + (c >> 5), rr = r & 15, cc = c & 31, ob = rr * 64 + cc * 2; return st * 1024 + (ob ^ (((ob >> 9) & 1) << 5)); }
__host__ __device__ __forceinline__ void stage_rc(int b, int& R, int& C) { const int st = b / 1024, sb = b % 1024, swz = sb ^ (((sb >> 9) & 1) << 5); R = (st >> 1) * 16 + swz / 64; C = (st & 1) * 32 + (swz % 64) / 2; }
__host__ __device__ __forceinline__ int perm32(int rho) { const int n = rho >> 4, i = rho & 15; return 8 * (i >> 2) + 4 * n + (i & 3); }

struct Unit { int pm, pn, kt0, len, part; };
struct Gemm { const bf16_t* A; const bf16_t* Bt; int M, N, K; };

struct StaticOrder {
    static constexpr bool WT_ALL = false;
    int nM, nN, nwg, G, c, nt;
    __host__ __device__ void init(int M, int N, int K, int G_, int c_) { nM = M / BM; nN = N / BM; nwg = nM * nN; G = G_; c = c_; nt = K / BK; }
    __host__ __device__ bool next(int i, Unit& u) const {
        const long L = (long)i * G + c; if (L >= nwg) return false;
        int wgid = (int)L; { const int q = nwg / NXCD, r = nwg % NXCD, xcd = wgid % NXCD, off = wgid / NXCD; wgid = (xcd < r ? xcd * (q + 1) : r * (q + 1) + (xcd - r) * q) + off; }
        const int nig = WGM * nN, gid = wgid / nig, fm = gid * WGM, gsz = (nM - fm) < WGM ? (nM - fm) : WGM;
        u.pm = fm + ((wgid % nig) % gsz); u.pn = (wgid % nig) / gsz; u.kt0 = 0; u.len = nt; u.part = 0; return true;
    }
};
template <int PP> struct StreamKOrder {
    static constexpr bool WT_ALL = (WT_SK != 0);
    static constexpr int NPAN = MP / BM, NTILE = NPAN * 8, TP = NTILE * PP;
    int q0, q1;
    __device__ void init(int G, int v) { q0 = (int)((long)v * TP / G); q1 = (int)((long)(v + 1) * TP / G); }
    __device__ bool next(int i, Unit& u) const {
        const int t = q0 / PP + i, s = t * PP; const int a = q0 > s ? q0 : s, b = q1 < s + PP ? q1 : s + PP;
        if (a >= b) return false;
        u.pn = t / NPAN; u.pm = t % NPAN; u.kt0 = 2 * (a - s); u.len = 2 * (b - a); u.part = a > s ? 1 : 0; return true;
    }
    static __device__ __forceinline__ bool is_split(int t, int G) { const int s = t * PP; return (int)(((long)(s + 1) * G - 1) / TP) != (int)(((long)(s + PP) * G - 1) / TP); }
};

template <int MODE> struct Epi {
    static constexpr bool PERM = true;
    bf16_t* O; int ldc; const float* rs; bf16_t* O1;
    __device__ __forceinline__ void operator()(const f32x4 (&acc)[2][2][4][2], const Unit& u, int wr, int wc, int fr, int fq, bool wt) const {
        const int row0 = u.pm * BM + wr * 64 + fr;
        if constexpr (MODE == 0) {
            const int col0 = u.pn * BM + wc * 32 + 8 * fq;
#pragma unroll
            for (int ai = 0; ai < 2; ++ai)
#pragma unroll
                for (int m = 0; m < 4; ++m) {
                    const int row = row0 + ai * HALF + m * 16;
                    bf16_t* rowp = (u.part ? O1 : O) + (size_t)row * ldc + col0;
#pragma unroll
                    for (int bj = 0; bj < 2; ++bj) {
                        const f32x4 v0 = acc[ai][bj][m][0], v1 = acc[ai][bj][m][1];
                        u32x4 w; w.x = cvt_pk_bf16(v0[0], v0[1]); w.y = cvt_pk_bf16(v0[2], v0[3]); w.z = cvt_pk_bf16(v1[0], v1[1]); w.w = cvt_pk_bf16(v1[2], v1[3]);
                        store16_wt(rowp + bj * HALF, w, wt);
                    }
                }
        } else {
            const int col0 = u.pn * HALF + wc * 32 + 8 * fq;
#pragma unroll
            for (int ai = 0; ai < 2; ++ai)
#pragma unroll
                for (int m = 0; m < 4; ++m) {
                    const int row = row0 + ai * HALF + m * 16;
                    float o[8];
#pragma unroll
                    for (int n = 0; n < 2; ++n)
#pragma unroll
                        for (int j = 0; j < 4; ++j) {
                            const float g = acc[ai][0][m][n][j], up = acc[ai][1][m][n][j];
                            o[n * 4 + j] = (g * up) * __builtin_amdgcn_rcpf(1.f + __builtin_amdgcn_exp2f(g * -1.4426950408889634f));
                        }
                    u32x4 w; w.x = cvt_pk_bf16(o[0], o[1]); w.y = cvt_pk_bf16(o[2], o[3]); w.z = cvt_pk_bf16(o[4], o[5]); w.w = cvt_pk_bf16(o[6], o[7]);
                    store16_wt(O + (size_t)row * ldc + col0, w, wt);
                }
        }
    }
};

template <int K, class EpiT, class Sched>
__device__ __forceinline__ void gemm_phase(LAS unsigned char* lds, const Gemm g, const Sched& S, const EpiT& E) {
    int tid_ = threadIdx.x; asm volatile("" : "+v"(tid_));
    const int tid = tid_, wid = __builtin_amdgcn_readfirstlane(tid >> 6), lane = tid & 63, wr = wid >> 2, wc = wid & 3, fr = lane & 15, fq = lane >> 4;
    unsigned voffA[2], voffB[2];
#pragma unroll
    for (int i = 0; i < 2; ++i) { int R, C; stage_rc(tid * 16 + i * 8192, R, C); const int Rb = EpiT::PERM ? ((R & ~31) + perm32(R & 31)) : R;
        voffA[i] = (unsigned)(R * K + C) * 2u; voffB[i] = (unsigned)(Rb * K + C) * 2u; }
    const size_t kstep = (size_t)(BK * 2);
    const size_t hstep = (size_t)HALF * K * 2;
    const size_t tstep = 2 * hstep;
    const unsigned ldsw = (unsigned)wid * 1024u;
    const int aoff = lds_byte(wr * 64 + fr, fq * 8), boff = lds_byte(wc * 32 + fr, fq * 8);
#define PG8_SA(b, h) (((b) * 2 + (h)) * HTB)
#define PG8_SB(b, h) ((4 + (b) * 2 + (h)) * HTB)
#define PG8_STAGE(bufoff, gbase, voff) do { _Pragma("unroll") for (int _i = 0; _i < 2; ++_i) \
        __builtin_amdgcn_global_load_lds((const unsigned*)((const char*)(gbase) + (voff)[_i]), (LAS unsigned*)(lds + (bufoff) + ldsw + _i * 8192), 16, 0, 0); } while (0)
#define PG8_LDA(dst, b, h) do { _Pragma("unroll") for (int m = 0; m < 4; ++m) _Pragma("unroll") for (int k = 0; k < 2; ++k) dst[m][k] = *(const LAS bf16x8*)(lds + PG8_SA(b, h) + aoff + m * 2048 + k * 1024); } while (0)
#define PG8_LDB(dst, b, h) do { _Pragma("unroll") for (int n = 0; n < 2; ++n) _Pragma("unroll") for (int k = 0; k < 2; ++k) dst[n][k] = *(const LAS bf16x8*)(lds + PG8_SB(b, h) + boff + n * 2048 + k * 1024); } while (0)
#define PG8_MMA(ai, bj, At, Bt) do { __builtin_amdgcn_s_setprio(1); _Pragma("unroll") for (int m = 0; m < 4; ++m) _Pragma("unroll") for (int n = 0; n < 2; ++n) _Pragma("unroll") for (int k = 0; k < 2; ++k) \
        acc[ai][bj][m][n] = __builtin_amdgcn_mfma_f32_16x16x32_bf16(Bt[n][k], At[m][k], acc[ai][bj][m][n], 0, 0, 0); __builtin_amdgcn_s_setprio(0); } while (0)
#define PG8_WAIT_V(n) asm volatile("s_waitcnt vmcnt(" #n ")" ::: "memory")
#define PG8_WAIT_L(n) asm volatile("s_waitcnt lgkmcnt(" #n ")" ::: "memory")
#define PG8_BAR __builtin_amdgcn_s_barrier()
#define PG8_SCHED __builtin_amdgcn_sched_barrier(0)
    Unit cur, nxt; int ui = 0;
    if (!S.next(0, cur)) return;
    f32x4 acc[2][2][4][2];
#pragma unroll
    for (int a = 0; a < 2; ++a)
#pragma unroll
        for (int b = 0; b < 2; ++b)
#pragma unroll
            for (int m = 0; m < 4; ++m)
#pragma unroll
                for (int n = 0; n < 2; ++n) acc[a][b][m][n] = (f32x4){0.f, 0.f, 0.f, 0.f};
    bf16x8 At[4][2], B0[2][2], B1[2][2];
    const char* cA = (const char*)g.A + (size_t)cur.pm * tstep + (size_t)cur.kt0 * kstep; const char* cB = (const char*)g.Bt + (size_t)cur.pn * tstep + (size_t)cur.kt0 * kstep;
    PG8_STAGE(PG8_SB(0, 0), cB, voffB); PG8_STAGE(PG8_SB(0, 1), cB + hstep, voffB); PG8_STAGE(PG8_SA(0, 0), cA, voffA); PG8_STAGE(PG8_SA(0, 1), cA + hstep, voffA);
    if (wr == 1) PG8_BAR;
    PG8_WAIT_V(2); PG8_BAR;
    PG8_STAGE(PG8_SB(1, 0), cB + kstep, voffB); PG8_STAGE(PG8_SA(1, 0), cA + kstep, voffA); PG8_STAGE(PG8_SB(1, 1), cB + hstep + kstep, voffB);
    PG8_WAIT_V(6); PG8_BAR;
    for (;;) {
        const bool has_next = S.next(ui + 1, nxt);
        const char* nA = has_next ? (const char*)g.A + (size_t)nxt.pm * tstep + (size_t)nxt.kt0 * kstep : cA; const char* nB = has_next ? (const char*)g.Bt + (size_t)nxt.pn * tstep + (size_t)nxt.kt0 * kstep : cB;
        const int nt = cur.len;
        for (int t = 0; t < nt; t += 2) {
            const bool last = (t == nt - 2);
            const char* a1 = cA + (size_t)(t + 1) * kstep;
            const char* a2 = last ? nA : cA + (size_t)(t + 2) * kstep; const char* b2 = last ? nB : cB + (size_t)(t + 2) * kstep;
            const char* a3 = a2 + kstep; const char* b3 = b2 + kstep;
            PG8_LDB(B0, 0, 0); PG8_LDB(B1, 0, 1); PG8_SCHED; PG8_LDA(At, 0, 0); PG8_STAGE(PG8_SA(1, 1), a1 + hstep, voffA);
            PG8_WAIT_V(8); PG8_WAIT_L(0); PG8_BAR; PG8_MMA(0, 0, At, B0); PG8_MMA(0, 1, At, B1); PG8_BAR; PG8_SCHED;
            PG8_LDA(At, 0, 1); PG8_STAGE(PG8_SB(0, 0), b2, voffB); PG8_STAGE(PG8_SB(0, 1), b2 + hstep, voffB); PG8_STAGE(PG8_SA(0, 0), a2, voffA);
            PG8_WAIT_V(8); PG8_WAIT_L(0); PG8_BAR; PG8_MMA(1, 0, At, B0); PG8_MMA(1, 1, At, B1); PG8_BAR; PG8_SCHED;
            PG8_LDB(B0, 1, 0); PG8_LDB(B1, 1, 1); PG8_SCHED; PG8_LDA(At, 1, 0); PG8_STAGE(PG8_SA(0, 1), a2 + hstep, voffA);
            PG8_WAIT_V(8); PG8_WAIT_L(0); PG8_BAR; PG8_MMA(0, 0, At, B0); PG8_MMA(0, 1, At, B1); PG8_BAR; PG8_SCHED;
            PG8_LDA(At, 1, 1); PG8_STAGE(PG8_SB(1, 0), b3, voffB); PG8_STAGE(PG8_SB(1, 1), b3 + hstep, voffB); PG8_STAGE(PG8_SA(1, 0), a3, voffA);
            PG8_WAIT_V(8); PG8_WAIT_L(0); PG8_BAR; PG8_MMA(1, 0, At, B0); PG8_MMA(1, 1, At, B1); PG8_BAR; PG8_SCHED;
        }
        if (wr == 0) PG8_BAR;
        E(acc, cur, wr, wc, fr, fq, Sched::WT_ALL ? true : (WT_LAST != 0 && !has_next));
        if (!has_next) break;
#pragma unroll
        for (int a = 0; a < 2; ++a)
#pragma unroll
            for (int b = 0; b < 2; ++b)
#pragma unroll
                for (int m = 0; m < 4; ++m)
#pragma unroll
                    for (int n = 0; n < 2; ++n) acc[a][b][m][n] = (f32x4){0.f, 0.f, 0.f, 0.f};
        cur = nxt; cA = nA; cB = nB; ++ui;
        if (wr == 1) PG8_BAR;
    }
    PG8_WAIT_V(0);
    PG8_BAR;
#undef PG8_SA
#undef PG8_SB
#undef PG8_STAGE
#undef PG8_LDA
#undef PG8_LDB
#undef PG8_MMA
#undef PG8_WAIT_V
#undef PG8_WAIT_L
#undef PG8_BAR
#undef PG8_SCHED
}
}

struct Params {
    const float *x_prompt, *x_sample, *cache_k, *cache_v, *state_conv, *meta, *rel_bias, *w_in, *conv_w, *sinks, *w_out,
        *n_pre_mix, *n_post_mix, *n_pre_ffn, *n_post_ffn, *w_gate, *w_up, *w_down;
    float* out; unsigned char* ws;
};

constexpr int I_IN = (D / 64) * (INDIM / 64), I_OUT = (D / 64) * (D / 64), I_G = (D / 64) * (DFF / 64), I_DN = (DFF / 64) * (D / 64);
constexpr int I_LAYER = I_IN + I_OUT + 2 * I_G + I_DN;
struct ItemDesc { const float* W; const float* gain; bf16_t* WT; int K, N, mode, k0, n0; };
struct ItemRegs { f32x4 v0[8], v1[8]; f32x2 gg[8]; };
__device__ __forceinline__ void item_decode(const Params& p, int l, int it, ItemDesc& d) {
    int r = it;
    if (r < I_IN) { d.W = p.w_in + (size_t)l * D * INDIM; d.K = D; d.N = INDIM; d.WT = (bf16_t*)(p.ws + WS_WIN) + (size_t)l * INDIM * D; d.gain = p.n_pre_mix + l * D; d.mode = 0; }
    else if ((r -= I_IN) < I_OUT) { d.W = p.w_out + (size_t)l * D * D; d.K = D; d.N = D; d.WT = (bf16_t*)(p.ws + WS_WOUT) + (size_t)l * D * D; d.gain = nullptr; d.mode = 0; }
    else if ((r -= I_OUT) < I_G) { d.W = p.w_gate + (size_t)l * D * DFF; d.K = D; d.N = DFF; d.WT = (bf16_t*)(p.ws + WS_WGU) + (size_t)l * NGU * D; d.gain = p.n_pre_ffn + l * D; d.mode = 1; }
    else if ((r -= I_G) < I_G) { d.W = p.w_up + (size_t)l * D * DFF; d.K = D; d.N = DFF; d.WT = (bf16_t*)(p.ws + WS_WGU) + (size_t)l * NGU * D; d.gain = p.n_pre_ffn + l * D; d.mode = 2; }
    else { r -= I_G; d.W = p.w_down + (size_t)l * DFF * D; d.K = DFF; d.N = D; d.WT = (bf16_t*)(p.ws + WS_WDN) + (size_t)l * D * DFF; d.gain = nullptr; d.mode = 0; }
    const int nblk = d.N / 64; d.k0 = 64 * (r / nblk); d.n0 = 64 * (r % nblk);
}
__device__ __forceinline__ void item_load(const ItemDesc& d, int lane, ItemRegs& R) {
    const int c4 = lane & 15, kq = lane >> 4;
#pragma unroll
    for (int i = 0; i < 8; ++i) { const int kp = kq + 4 * i; const float* s = d.W + (size_t)(d.k0 + 2 * kp) * d.N + d.n0 + 4 * c4; R.v0[i] = *(const f32x4*)s; R.v1[i] = *(const f32x4*)(s + d.N); }
#pragma unroll
    for (int i = 0; i < 8; ++i) { const int kp = kq + 4 * i; R.gg[i] = d.gain ? *(const f32x2*)(d.gain + d.k0 + 2 * kp) : (f32x2){1.f, 1.f}; }
}
__device__ __forceinline__ void item_finish(const ItemDesc& d, LAS unsigned* scr, int lane, const ItemRegs& R) {
    const int c4 = lane & 15, kq = lane >> 4;
#pragma unroll
    for (int i = 0; i < 8; ++i) { const int kp = kq + 4 * i; const float g0 = R.gg[i].x, g1 = R.gg[i].y;
        LAS unsigned* q = scr + (4 * c4) * 33 + kp;
        q[0] = cvt_pk_bf16(R.v0[i].x * g0, R.v1[i].x * g1); q[33] = cvt_pk_bf16(R.v0[i].y * g0, R.v1[i].y * g1); q[66] = cvt_pk_bf16(R.v0[i].z * g0, R.v1[i].z * g1); q[99] = cvt_pk_bf16(R.v0[i].w * g0, R.v1[i].w * g1); }
    LDS_WAIT(); __builtin_amdgcn_wave_barrier(); asm volatile("" ::: "memory");
    int rbase = d.n0;
    if (d.mode) rbase = ((d.n0 >> 7) << 8) + (d.n0 & 127) + (d.mode == 2 ? 128 : 0);
    const int kc = lane & 7;
#pragma unroll
    for (int j = 0; j < 8; ++j) { const int n = (lane >> 3) + 8 * j; const LAS unsigned* s = scr + n * 33 + 4 * kc;
        u32x4 o; o.x = s[0]; o.y = s[1]; o.z = s[2]; o.w = s[3];
        *(u32x4*)(d.WT + (size_t)(rbase + n) * d.K + d.k0 + 8 * kc) = o; }
    LDS_WAIT(); __builtin_amdgcn_wave_barrier(); asm volatile("" ::: "memory");
}
__device__ __forceinline__ void convert_items(const Params& p, int l, int it0, int it1, int worker, int nw, LAS unsigned char* lds, int wid, int lane) {
    LAS unsigned* scr = (LAS unsigned*)(lds + wid * 16384);
    int it = it0 + worker;
    if (it >= it1) return;
    ItemDesc dA, dB; ItemRegs A, B;
    item_decode(p, l, it, dA); item_load(dA, lane, A);
    for (;;) {
        const int itB = it + nw; const bool hB = itB < it1;
        if (hB) { item_decode(p, l, itB, dB); item_load(dB, lane, B); }
        item_finish(dA, scr, lane, A);
        if (!hB) break;
        const int itA = itB + nw; const bool hA = itA < it1;
        if (hA) { item_decode(p, l, itA, dA); item_load(dA, lane, A); }
        item_finish(dB, scr, lane, B);
        if (!hA) break;
        it = itA;
    }
}
__device__ __forceinline__ void filler(const Params& p, int l, int it0, int it1, int nwg, LAS unsigned char* lds, int wid, int lane) {
    const int G = gridDim.x, r = nwg % G, c = blockIdx.x;
    if (r == 0) convert_items(p, l, it0, it1, c * 8 + wid, G * 8, lds, wid, lane);
    else if (c >= r) convert_items(p, l, it0, it1, (c - r) * 8 + wid, (G - r) * 8, lds, wid, lane);
}

__device__ __forceinline__ void prologue(const Params& p, LAS unsigned char* lds, int wid, int lane) {
    const int gw = blockIdx.x * 8 + wid, NGW = gridDim.x * 8;
    convert_items(p, 0, 0, I_IN, gw, NGW, lds, wid, lane);
    bf16_t* HB = (bf16_t*)(p.ws + WS_HB); float* RS = (float*)(p.ws + WS_RS);
    for (int m = gw; m < MREAL; m += NGW) {
        const float* src;
        if (m < MPROMPT) { const int b = m / LSEQ, t = m % LSEQ; src = t < NMETA ? p.meta + (size_t)t * D : p.x_prompt + ((size_t)b * SEQ + (t - NMETA)) * D; }
        else src = p.x_sample + (size_t)(m - MPROMPT) * D;
        const f32x4* xr = (const f32x4*)src + lane; u32x2* hb = (u32x2*)(HB + (size_t)m * D) + lane;
        float ss = 0.f; f32x4 v[8];
#pragma unroll
        for (int j = 0; j < 8; ++j) { v[j] = xr[64 * j]; ss += (v[j].x * v[j].x + v[j].y * v[j].y) + (v[j].z * v[j].z + v[j].w * v[j].w); }
        ss = wave_sum(ss);
        const float r = 1.f / sqrtf(ss * (1.f / D) + RMS_EPS);
#pragma unroll
        for (int j = 0; j < 8; ++j) { u32x2 w; w.x = cvt_pk_bf16(v[j].x * r, v[j].y * r); w.y = cvt_pk_bf16(v[j].z * r, v[j].w * r); hb[64 * j] = w; }
        if (lane == 0) RS[m] = r;
    }
}

template <int PP> __device__ __forceinline__ void postnorm_row(const Params& p, const float* __restrict__ g, bool last, int m, int lane, bool dry) {
    bf16_t* HB = (bf16_t*)(p.ws + WS_HB); float* RS = (float*)(p.ws + WS_RS); const bf16_t* MIXB = (const bf16_t*)(p.ws + WS_MIXB); const bf16_t* MIXB1 = (const bf16_t*)(p.ws + WS_MIXB1);
    const u32x2* mr = (const u32x2*)(MIXB + (size_t)m * D) + lane; const u32x2* mr1 = (const u32x2*)(MIXB1 + (size_t)m * D) + lane;
    u32x2* hb = (u32x2*)(HB + (size_t)m * D) + lane; const f32x4* gr = (const f32x4*)g + lane;
    const int pmrow = m >> 8;
    u32x2 w0[8], w1[8], hw[8]; f32x4 gv[8];
#pragma unroll
    for (int j = 0; j < 8; ++j) { w0[j] = mr[64 * j]; w1[j] = mr1[64 * j]; hw[j] = hb[64 * j]; }
#pragma unroll
    for (int j = 0; j < 8; ++j) gv[j] = gr[64 * j];
    f32x4 mv[8]; float ss = 0.f;
#pragma unroll
    for (int j = 0; j < 8; ++j) { mv[j] = (f32x4){bf_lo(w0[j].x), bf_hi(w0[j].x), bf_lo(w0[j].y), bf_hi(w0[j].y)};
        if (pg8::StreamKOrder<PP>::is_split(j * (MP / 256) + pmrow, (int)gridDim.x)) mv[j] += (f32x4){bf_lo(w1[j].x), bf_hi(w1[j].x), bf_lo(w1[j].y), bf_hi(w1[j].y)};
        ss += (mv[j].x * mv[j].x + mv[j].y * mv[j].y) + (mv[j].z * mv[j].z + mv[j].w * mv[j].w); }
    ss = wave_sum(ss);
    const float r = 1.f / sqrtf(ss * (1.f / D) + RMS_EPS);
    float* yrow = nullptr;
    if (last) { if (m < MPROMPT) { const int b = m / LSEQ, t = m % LSEQ; if (t >= NMETA) yrow = p.out + O_YP + ((size_t)b * SEQ + (t - NMETA)) * D; } else yrow = p.out + O_YS + (size_t)(m - MPROMPT) * D; }
    const float rinv = 1.f / RS[m];
    float s2 = 0.f; f32x4 hn[8];
#pragma unroll
    for (int j = 0; j < 8; ++j) {
        const f32x4 hv = (f32x4){bf_lo(hw[j].x), bf_hi(hw[j].x), bf_lo(hw[j].y), bf_hi(hw[j].y)};
        hn[j] = hv * rinv + mv[j] * r * gv[j];
        s2 += (hn[j].x * hn[j].x + hn[j].y * hn[j].y) + (hn[j].z * hn[j].z + hn[j].w * hn[j].w);
        if (yrow) ((f32x4*)yrow)[lane + 64 * j] = hn[j];
    }
    s2 = wave_sum(s2);
    const float rn = 1.f / sqrtf(s2 * (1.f / D) + RMS_EPS);
#pragma unroll
    for (int j = 0; j < 8; ++j) { u32x2 w; w.x = cvt_pk_bf16(hn[j].x * rn, hn[j].y * rn); w.y = cvt_pk_bf16(hn[j].z * rn, hn[j].w * rn); (dry ? (u32x2*)(p.ws + WS_ZACT) + (size_t)m * (D / 4) + lane : hb)[64 * j] = w; }
    if (lane == 0 && !dry) RS[m] = rn;
}
template <int PP> __device__ __forceinline__ void postnorm_row2(const Params& p, const float* __restrict__ g, bool last, int m0, int lane) {
    bf16_t* HB = (bf16_t*)(p.ws + WS_HB); float* RS = (float*)(p.ws + WS_RS); const bf16_t* MIXB = (const bf16_t*)(p.ws + WS_MIXB); const bf16_t* MIXB1 = (const bf16_t*)(p.ws + WS_MIXB1);
    const int pmrow = m0 >> 8;
    const f32x4* gr = (const f32x4*)g + lane;
    u32x2 w0[2][8], w1[2][8], hw[2][8]; f32x4 gv[8];
#pragma unroll
    for (int e = 0; e < 2; ++e) {
        const u32x2* mr = (const u32x2*)(MIXB + (size_t)(m0 + e) * D) + lane; const u32x2* mr1 = (const u32x2*)(MIXB1 + (size_t)(m0 + e) * D) + lane; const u32x2* hb = (const u32x2*)(HB + (size_t)(m0 + e) * D) + lane;
#pragma unroll
        for (int j = 0; j < 8; ++j) { w0[e][j] = mr[64 * j]; w1[e][j] = mr1[64 * j]; hw[e][j] = hb[64 * j]; }
    }
#pragma unroll
    for (int j = 0; j < 8; ++j) gv[j] = gr[64 * j];
#pragma unroll
    for (int e = 0; e < 2; ++e) {
        const int m = m0 + e;
        f32x4 mv[8]; float ss = 0.f;
#pragma unroll
        for (int j = 0; j < 8; ++j) { mv[j] = (f32x4){bf_lo(w0[e][j].x), bf_hi(w0[e][j].x), bf_lo(w0[e][j].y), bf_hi(w0[e][j].y)};
            if (pg8::StreamKOrder<PP>::is_split(j * (MP / 256) + pmrow, (int)gridDim.x)) mv[j] += (f32x4){bf_lo(w1[e][j].x), bf_hi(w1[e][j].x), bf_lo(w1[e][j].y), bf_hi(w1[e][j].y)};
            ss += (mv[j].x * mv[j].x + mv[j].y * mv[j].y) + (mv[j].z * mv[j].z + mv[j].w * mv[j].w); }
        ss = wave_sum(ss);
        const float r = 1.f / sqrtf(ss * (1.f / D) + RMS_EPS);
        float* yrow = nullptr;
        if (last) { if (m < MPROMPT) { const int b = m / LSEQ, t = m % LSEQ; if (t >= NMETA) yrow = p.out + O_YP + ((size_t)b * SEQ + (t - NMETA)) * D; } else yrow = p.out + O_YS + (size_t)(m - MPROMPT) * D; }
        u32x2* hbw = (u32x2*)(HB + (size_t)m * D) + lane;
        const float rinv = 1.f / RS[m];
        float s2 = 0.f; f32x4 hn[8];
#pragma unroll
        for (int j = 0; j < 8; ++j) {
            const f32x4 hv = (f32x4){bf_lo(hw[e][j].x), bf_hi(hw[e][j].x), bf_lo(hw[e][j].y), bf_hi(hw[e][j].y)};
            hn[j] = hv * rinv + mv[j] * r * gv[j];
            s2 += (hn[j].x * hn[j].x + hn[j].y * hn[j].y) + (hn[j].z * hn[j].z + hn[j].w * hn[j].w);
            if (yrow) ((f32x4*)yrow)[lane + 64 * j] = hn[j];
        }
        s2 = wave_sum(s2);
        const float rn = 1.f / sqrtf(s2 * (1.f / D) + RMS_EPS);
        if (!last) {
#pragma unroll
            for (int j = 0; j < 8; ++j) { u32x2 w; w.x = cvt_pk_bf16(hn[j].x * rn, hn[j].y * rn); w.y = cvt_pk_bf16(hn[j].z * rn, hn[j].w * rn); hbw[64 * j] = w; }
            if (lane == 0) RS[m] = rn;
        }
    }
}
template <int PP> __device__ __forceinline__ void postnorm(const Params& p, const float* __restrict__ g, bool last, int wid, int lane, bool dry = false) {
    const int gw = blockIdx.x * 8 + wid, NGW = gridDim.x * 8;
    for (int m = gw; m < MREAL; m += NGW) postnorm_row<PP>(p, g, last, m, lane, dry);
}
template <int PP> __device__ __forceinline__ void sk_postnorm(const Params& p, const pg8::StreamKOrder<PP>& S, unsigned* cnt, const float* __restrict__ g, bool last, int vcu, int tid, int wid, int lane, unsigned long long& tacc_, unsigned long long& t0_) {
    const int G = gridDim.x, gwv = vcu * 8 + wid, NGW = G * 8;
    constexpr int NMAIN = 8192 / 32;
    TB(11);
    asm volatile("s_waitcnt vmcnt(0)" ::: "memory");
    __syncthreads();
    TE(11);
    TB(12);
    if (tid == 0) {
#if !WT_SK
        __builtin_amdgcn_fence(__ATOMIC_RELEASE, "agent");
        asm volatile("s_waitcnt vmcnt(0)" ::: "memory");
#endif
        pg8::Unit u; for (int i = 0; S.next(i, u); ++i) (void)xb_add(cnt + 16 * u.pm, 1u);
        for (int c = vcu; c < NMAIN + 1; c += G) {
            int pm = c >> 3;
            if (c >= NMAIN) break;
            unsigned want = 0; for (int j = 0; j < 8; ++j) want += 1u + (pg8::StreamKOrder<PP>::is_split(j * (MP / 256) + pm, G) ? 1u : 0u);
            unsigned sp = 0; while (xb_ld(cnt + 16 * pm) < want) { __builtin_amdgcn_s_sleep(1); if (++sp > (1u << 22)) break; }
        }
        if (vcu * 8 < MREAL - 8192) {
            unsigned want = 0; for (int j = 0; j < 8; ++j) want += 1u + (pg8::StreamKOrder<PP>::is_split(j * (MP / 256) + 32, G) ? 1u : 0u);
            unsigned sp = 0; while (xb_ld(cnt + 16 * 32) < want) { __builtin_amdgcn_s_sleep(1); if (++sp > (1u << 22)) break; }
        }
        __builtin_amdgcn_fence(__ATOMIC_ACQUIRE, "agent");
        asm volatile("s_waitcnt vmcnt(0)" ::: "memory");
    }
    __syncthreads();
    TE(12);
    TB(13);
    for (int c = vcu; c < NMAIN; c += G)
        for (int i = 0; i < 4; i += 2) postnorm_row2<PP>(p, g, last, 32 * c + 4 * wid + i, lane);
    for (int i = gwv; i < MREAL - 8192; i += NGW) postnorm_row<PP>(p, g, last, 8192 + i, lane, false);
    TE(13);
}

constexpr int AT_QT = 128, AT_NT = 4, AT_KR = 304, AT_KS = 72, AT_VS = 312, AT_PS = 168;
constexpr int AT_K_OFF = 0, AT_V_OFF = AT_KR * AT_KS * 2  , AT_P_OFF = AT_V_OFF + 64 * AT_VS * 2  , AT_P_WAVE = 16 * AT_PS * 2  ;
static_assert(AT_P_OFF + 8 * AT_P_WAVE <= RING_BYTES && (AT_V_OFF % 16) == 0 && (AT_P_OFF % 16) == 0, "attention LDS map");

__device__ __forceinline__ void attn_prompt_unit(LAS unsigned char* lds, int b, int kvh, int qt, const bf16_t* __restrict__ z, bf16_t* mixin, const float* __restrict__ sinks, int tid, int wid, int lane) {
    LAS bf16_t* Ks = (LAS bf16_t*)(lds + AT_K_OFF);
    LAS bf16_t* Vt = (LAS bf16_t*)(lds + AT_V_OFF);
    LAS bf16_t* Pw = (LAS bf16_t*)(lds + AT_P_OFF + wid * AT_P_WAVE);
    const LAS float* biasL = (const LAS float*)(lds + BIAS_OFF);
    const int q0 = qt * AT_QT, rowb = b * LSEQ;
    const int h = kvh * 4 + (wid & 3), i16 = lane & 15, g = lane >> 4;
    const int ntile = AT_NT + ((qt == 15 && (wid >> 2) == 0) ? 1 : 0);
    bf16x8 qf[AT_NT + 1][2];
#pragma unroll
    for (int tile = 0; tile < AT_NT + 1; ++tile) {
        const int tq0 = tile < AT_NT ? q0 + (wid >> 2) * (AT_QT / 2) + tile * 16 : 2048;
        int tq = tq0 + i16; tq = tq > LSEQ - 1 ? LSEQ - 1 : tq;
        const bf16_t* qp = z + (size_t)(rowb + tq) * INDIM + ZQ + h * 64 + 8 * g;
        if (tile < ntile) { qf[tile][0] = *(const bf16x8*)qp; qf[tile][1] = *(const bf16x8*)(qp + 32); }
        else { qf[tile][0] = (bf16x8){0, 0, 0, 0, 0, 0, 0, 0}; qf[tile][1] = qf[tile][0]; }
    }
    const float sink = sinks[h];
    {
        constexpr int NIT = (AT_KR * 8 + 511) / 512;
        u32x4 kv[NIT], vv[NIT];
#pragma unroll
        for (int it = 0; it < NIT; ++it) {
            const int c = tid + it * 512;
            if (it < NIT - 1 || c < AT_KR * 8) {
                const int kr = c >> 3, ch = c & 7; int t = q0 - 144 + kr; t = t < 0 ? 0 : (t > LSEQ - 1 ? LSEQ - 1 : t);
                const bf16_t* src = z + (size_t)(rowb + t) * INDIM + kvh * 64 + ch * 8;
                kv[it] = *(const u32x4*)(src + ZK); vv[it] = *(const u32x4*)(src + ZV);
            }
        }
#pragma unroll
        for (int it = 0; it < NIT; ++it) {
            const int c = tid + it * 512;
            if (it < NIT - 1 || c < AT_KR * 8) {
                const int kr = c >> 3, ch = c & 7;
                *(LAS u32x4*)(Ks + kr * AT_KS + ch * 8) = kv[it];
                LAS bf16_t* vd = Vt + (ch * 8) * AT_VS + kr;
                vd[0 * AT_VS] = (bf16_t)(vv[it].x & 0xffffu); vd[1 * AT_VS] = (bf16_t)(vv[it].x >> 16);
                vd[2 * AT_VS] = (bf16_t)(vv[it].y & 0xffffu); vd[3 * AT_VS] = (bf16_t)(vv[it].y >> 16);
                vd[4 * AT_VS] = (bf16_t)(vv[it].z & 0xffffu); vd[5 * AT_VS] = (bf16_t)(vv[it].z >> 16);
                vd[6 * AT_VS] = (bf16_t)(vv[it].w & 0xffffu); vd[7 * AT_VS] = (bf16_t)(vv[it].w >> 16);
            }
        }
    }
    __syncthreads();
#pragma unroll
    for (int tile = 0; tile < AT_NT + 1; ++tile) {
        if (tile >= ntile) break;
        const int tq0 = tile < AT_NT ? q0 + (wid >> 2) * (AT_QT / 2) + tile * 16 : 2048;
        const int koff = tq0 - q0;
        const int t = tq0 + i16;
        f32x4 s[10];
#pragma unroll
        for (int nt = 1; nt < 10; ++nt) {
            const LAS bf16_t* kp = Ks + (koff + nt * 16 + i16) * AT_KS + 8 * g;
            const bf16x8 k0 = *(const LAS bf16x8*)kp, k1 = *(const LAS bf16x8*)(kp + 32);
            f32x4 a = (f32x4){0.f, 0.f, 0.f, 0.f};
            a = __builtin_amdgcn_mfma_f32_16x16x32_bf16(k0, qf[tile][0], a, 0, 0, 0);
            a = __builtin_amdgcn_mfma_f32_16x16x32_bf16(k1, qf[tile][1], a, 0, 0, 0);
            s[nt] = a;
        }
        const LAS float* bp = biasL + h * BIAS_STRIDE + BIAS_PAD + 144 + i16 - 4 * g;
        float mx = sink;
        if (tq0 >= 144) {
#pragma unroll
            for (int nt = 1; nt < 10; ++nt)
#pragma unroll
                for (int r = 0; r < 4; ++r) { const float v = s[nt][r] * 0.125f + bp[-(nt * 16 + r)]; s[nt][r] = v; mx = fmaxf(mx, v); }
        } else {
#pragma unroll
            for (int nt = 1; nt < 10; ++nt)
#pragma unroll
                for (int r = 0; r < 4; ++r) { const int tk = tq0 - 144 + nt * 16 + 4 * g + r; const float v = tk >= 0 ? s[nt][r] * 0.125f + bp[-(nt * 16 + r)] : -INFINITY; s[nt][r] = v; mx = fmaxf(mx, v); }
        }
        mx = fmaxf(mx, __shfl_xor(mx, 16)); mx = fmaxf(mx, __shfl_xor(mx, 32));
        float sum = 0.f;
        *(LAS u32x2*)(Pw + i16 * AT_PS + 4 * g) = (u32x2){0u, 0u};
#pragma unroll
        for (int nt = 1; nt < 10; ++nt) {
            const float e0 = __expf(s[nt][0] - mx), e1 = __expf(s[nt][1] - mx), e2 = __expf(s[nt][2] - mx), e3 = __expf(s[nt][3] - mx);
            sum += (e0 + e1) + (e2 + e3);
            u32x2 w; w.x = cvt_pk_bf16(e0, e1); w.y = cvt_pk_bf16(e2, e3);
            *(LAS u32x2*)(Pw + i16 * AT_PS + nt * 16 + 4 * g) = w;
        }
        sum += __shfl_xor(sum, 16); sum += __shfl_xor(sum, 32);
        const float inv = 1.f / (sum + __expf(sink - mx));
        LDS_WAIT(); __builtin_amdgcn_wave_barrier();
        f32x4 o[4];
#pragma unroll
        for (int dn = 0; dn < 4; ++dn) o[dn] = (f32x4){0.f, 0.f, 0.f, 0.f};
#pragma unroll
        for (int ks = 0; ks < 5; ++ks) {
            const bf16x8 pf = *(const LAS bf16x8*)(Pw + i16 * AT_PS + ks * 32 + 8 * g);
#pragma unroll
            for (int dn = 0; dn < 4; ++dn) {
                const bf16x8 vf = *(const LAS bf16x8*)(Vt + (dn * 16 + i16) * AT_VS + koff + ks * 32 + 8 * g);
                o[dn] = __builtin_amdgcn_mfma_f32_16x16x32_bf16(vf, pf, o[dn], 0, 0, 0);
            }
        }
        if (t < LSEQ) {
            bf16_t* op = mixin + (size_t)(rowb + t) * D + h * 64 + 4 * g;
#pragma unroll
            for (int dn = 0; dn < 4; ++dn) { u32x2 w; w.x = cvt_pk_bf16(o[dn][0] * inv, o[dn][1] * inv); w.y = cvt_pk_bf16(o[dn][2] * inv, o[dn][3] * inv); *(u32x2*)(op + dn * 16) = w; }
        }
        LDS_WAIT(); __builtin_amdgcn_wave_barrier();
    }
    __syncthreads();
}

__device__ __forceinline__ void attn_sample_wave(LAS unsigned char* lds, int l, int b, int h, const Params& p, const bf16_t* __restrict__ z, bf16_t* mixin, int wid, int lane) {
    LAS float* qs = (LAS float*)(lds + wid * 1024);
    LAS float* ps = qs + 64;
    const LAS float* biasL = (const LAS float*)(lds + BIAS_OFF);
    const int kvh = h >> 2;
    const bf16_t* zr = z + (size_t)(MPROMPT + b) * INDIM;
    const float qv = __uint_as_float((unsigned)zr[ZQ + h * 64 + lane] << 16) * 0.125f;
    qs[lane] = qv;
    LDS_WAIT(); __builtin_amdgcn_wave_barrier();
    const float* ck = p.cache_k + (((size_t)l * DB + b) * WIN) * 256 + kvh * 64;
    const float* cv = p.cache_v + (((size_t)l * DB + b) * WIN) * 256 + kvh * 64;
    float sc0 = 0.f, sc1 = 0.f;
    {
        const f32x4* k0 = (const f32x4*)(ck + (size_t)lane * 256); const f32x4* k1 = (const f32x4*)(ck + (size_t)(lane + 64) * 256);
#pragma unroll
        for (int d4 = 0; d4 < 16; ++d4) { const f32x4 q4 = *(const LAS f32x4*)(qs + 4 * d4); const f32x4 a = k0[d4], c = k1[d4];
            sc0 += (a.x * q4.x + a.y * q4.y) + (a.z * q4.z + a.w * q4.w); sc1 += (c.x * q4.x + c.y * q4.y) + (c.z * q4.z + c.w * q4.w); }
    }
    const float knew = __uint_as_float((unsigned)zr[ZK + kvh * 64 + lane] << 16);
    const float sc2 = wave_sum(qv * knew);
    const float sink = p.sinks[l * NHEADS + h];
    const float v0 = sc0 + biasL[h * BIAS_STRIDE + BIAS_PAD + (WIN - lane)], v1 = sc1 + biasL[h * BIAS_STRIDE + BIAS_PAD + (64 - lane)], v2 = sc2 + biasL[h * BIAS_STRIDE + BIAS_PAD];
    float mx = wave_max(fmaxf(v0, v1)); mx = fmaxf(mx, fmaxf(v2, sink));
    const float e0 = __expf(v0 - mx), e1 = __expf(v1 - mx), e2 = __expf(v2 - mx);
    const float sum = wave_sum(e0 + e1) + e2 + __expf(sink - mx);
    ps[lane] = e0; ps[lane + 64] = e1;
    LDS_WAIT(); __builtin_amdgcn_wave_barrier();
    const int sg = lane >> 4, dq = lane & 15;
    f32x4 oa = (f32x4){0.f, 0.f, 0.f, 0.f}, ob4 = (f32x4){0.f, 0.f, 0.f, 0.f};
#pragma unroll
    for (int it = 0; it < 2; ++it) {
        f32x4 vr[16];
#pragma unroll
        for (int i = 0; i < 16; ++i) vr[i] = *(const f32x4*)(cv + (size_t)(sg + 4 * (i + 16 * it)) * 256 + 4 * dq);
#pragma unroll
        for (int i = 0; i < 16; i += 2) { oa += vr[i] * ps[sg + 4 * (i + 16 * it)]; ob4 += vr[i + 1] * ps[sg + 4 * (i + 1 + 16 * it)]; }
    }
    oa += ob4;
#pragma unroll
    for (int c = 0; c < 4; ++c) { oa[c] += __shfl_xor(oa[c], 16); oa[c] += __shfl_xor(oa[c], 32); }
    if (sg == 0) {
        const u32x2 vn = *(const u32x2*)(zr + ZV + kvh * 64 + 4 * dq);
        const float rs_ = 1.f / sum;
        const float o0 = (oa[0] + e2 * bf_lo(vn.x)) * rs_, o1 = (oa[1] + e2 * bf_hi(vn.x)) * rs_, o2 = (oa[2] + e2 * bf_lo(vn.y)) * rs_, o3 = (oa[3] + e2 * bf_hi(vn.y)) * rs_;
        u32x2 w; w.x = cvt_pk_bf16(o0, o1); w.y = cvt_pk_bf16(o2, o3);
        *(u32x2*)(mixin + (size_t)(MPROMPT + b) * D + h * 64 + 4 * dq) = w;
    }
    LDS_WAIT(); __builtin_amdgcn_wave_barrier();
}

__device__ __forceinline__ void unpack8(const u32x4 a, float (&o)[8]) { o[0] = bf_lo(a.x); o[1] = bf_hi(a.x); o[2] = bf_lo(a.y); o[3] = bf_hi(a.y); o[4] = bf_lo(a.z); o[5] = bf_hi(a.z); o[6] = bf_lo(a.w); o[7] = bf_hi(a.w); }
__device__ __forceinline__ void conv_row(int l, int m, const Params& p, const bf16_t* __restrict__ z, bf16_t* mixin, int lane) {
    const float* cw = p.conv_w + (size_t)l * 3 * CDIM;
    const bool prompt = m < MPROMPT;
    const int b = prompt ? m / LSEQ : m - MPROMPT, t = prompt ? m % LSEQ : 0;
    const bf16_t* zr = z + (size_t)m * INDIM;
    const bf16_t* z1 = (prompt && t >= 1) ? zr - INDIM : zr;
    const bf16_t* z2 = (prompt && t >= 2) ? zr - 2 * INDIM : zr;
    const float k1 = (prompt && t >= 1) ? 1.f : 0.f, k2 = (prompt && t >= 2) ? 1.f : 0.f;
    const float* st = p.state_conv + (((size_t)l * DB + (prompt ? 0 : b)) * 2) * CDIM;
    u32x4 gbv[2], gcv[2], hcv[2], a1[2], c1[2], a2[2], c2[2]; f32x4 sv[2][4], wv[2][6];
#pragma unroll
    for (int j = 0; j < 2; ++j) {
        const int c0 = lane * 8 + 512 * j;
        gbv[j] = *(const u32x4*)(zr + ZGB + c0); gcv[j] = *(const u32x4*)(zr + ZGC + c0); hcv[j] = *(const u32x4*)(zr + ZHC + c0);
        a1[j] = *(const u32x4*)(z1 + ZGC + c0); c1[j] = *(const u32x4*)(z1 + ZHC + c0); a2[j] = *(const u32x4*)(z2 + ZGC + c0); c2[j] = *(const u32x4*)(z2 + ZHC + c0);
        if (!prompt) { sv[j][0] = *(const f32x4*)(st + c0); sv[j][1] = *(const f32x4*)(st + c0 + 4); sv[j][2] = *(const f32x4*)(st + CDIM + c0); sv[j][3] = *(const f32x4*)(st + CDIM + c0 + 4); }
#pragma unroll
        for (int i = 0; i < 3; ++i) { wv[j][2 * i] = *(const f32x4*)(cw + i * CDIM + c0); wv[j][2 * i + 1] = *(const f32x4*)(cw + i * CDIM + c0 + 4); }
    }
#pragma unroll
    for (int j = 0; j < 2; ++j) {
        const int c0 = lane * 8 + 512 * j;
        float gb[8], gc[8], hc[8], u0[8], u1[8], u2[8], x[8], y[8];
        unpack8(gbv[j], gb); unpack8(gcv[j], gc); unpack8(hcv[j], hc);
#pragma unroll
        for (int i = 0; i < 8; ++i) u0[i] = gc[i] * hc[i];
        if (prompt) {
            unpack8(a1[j], x); unpack8(c1[j], y);
#pragma unroll
            for (int i = 0; i < 8; ++i) u1[i] = x[i] * y[i] * k1;
            unpack8(a2[j], x); unpack8(c2[j], y);
#pragma unroll
            for (int i = 0; i < 8; ++i) u2[i] = x[i] * y[i] * k2;
            if (t >= LSEQ - 2) { float* co = p.out + O_CP + (((size_t)l * NBATCH + b) * 2 + (t - (LSEQ - 2))) * CDIM + c0;
                *(f32x4*)co = (f32x4){u0[0], u0[1], u0[2], u0[3]}; *(f32x4*)(co + 4) = (f32x4){u0[4], u0[5], u0[6], u0[7]}; }
        } else {
#pragma unroll
            for (int i = 0; i < 4; ++i) { u2[i] = sv[j][0][i]; u2[4 + i] = sv[j][1][i]; u1[i] = sv[j][2][i]; u1[4 + i] = sv[j][3][i]; }
            float* co = p.out + O_CS + (((size_t)l * DB + b) * 2) * CDIM + c0;
            *(f32x4*)co = sv[j][2]; *(f32x4*)(co + 4) = sv[j][3];
            *(f32x4*)(co + CDIM) = (f32x4){u0[0], u0[1], u0[2], u0[3]}; *(f32x4*)(co + CDIM + 4) = (f32x4){u0[4], u0[5], u0[6], u0[7]};
        }
        float r[8];
#pragma unroll
        for (int i = 0; i < 8; ++i) { const float w0 = wv[j][i >> 2][i & 3], w1 = wv[j][2 + (i >> 2)][i & 3], w2 = wv[j][4 + (i >> 2)][i & 3]; r[i] = gb[i] * (w0 * u2[i] + w1 * u1[i] + w2 * u0[i]); }
        u32x4 w; w.x = cvt_pk_bf16(r[0], r[1]); w.y = cvt_pk_bf16(r[2], r[3]); w.z = cvt_pk_bf16(r[4], r[5]); w.w = cvt_pk_bf16(r[6], r[7]);
        *(u32x4*)(mixin + (size_t)m * D + 1024 + c0) = w;
    }
}

__device__ __forceinline__ void conv_job4(int l, int m0, const Params& p, const bf16_t* __restrict__ z, bf16_t* mixin, int lane) {
    const float* cw = p.conv_w + (size_t)l * 3 * CDIM;
    const int b = m0 / LSEQ, t0 = m0 % LSEQ;
    const float kprev = t0 > 0 ? 1.f : 0.f;
    const bf16_t* zr = z + (size_t)m0 * INDIM;
    const bf16_t* zp = t0 > 0 ? zr - 2 * INDIM : zr;
#pragma unroll
    for (int j = 0; j < 2; ++j) {
        const int c0 = lane * 8 + 512 * j;
        u32x4 gcv[6], hcv[6], gbv[4]; f32x4 wv[6];
        gcv[0] = *(const u32x4*)(zp + ZGC + c0); hcv[0] = *(const u32x4*)(zp + ZHC + c0);
        gcv[1] = *(const u32x4*)(zp + INDIM + ZGC + c0); hcv[1] = *(const u32x4*)(zp + INDIM + ZHC + c0);
#pragma unroll
        for (int r = 0; r < 4; ++r) { gcv[2 + r] = *(const u32x4*)(zr + (size_t)r * INDIM + ZGC + c0); hcv[2 + r] = *(const u32x4*)(zr + (size_t)r * INDIM + ZHC + c0); gbv[r] = *(const u32x4*)(zr + (size_t)r * INDIM + ZGB + c0); }
#pragma unroll
        for (int i = 0; i < 3; ++i) { wv[2 * i] = *(const f32x4*)(cw + i * CDIM + c0); wv[2 * i + 1] = *(const f32x4*)(cw + i * CDIM + c0 + 4); }
        float u[6][8];
#pragma unroll
        for (int r = 0; r < 6; ++r) { float x[8], y[8]; unpack8(gcv[r], x); unpack8(hcv[r], y); const float k = r < 2 ? kprev : 1.f;
#pragma unroll
            for (int i = 0; i < 8; ++i) u[r][i] = x[i] * y[i] * k; }
#pragma unroll
        for (int r = 0; r < 4; ++r) {
            float gb[8], o[8]; unpack8(gbv[r], gb);
#pragma unroll
            for (int i = 0; i < 8; ++i) { const float w0 = wv[i >> 2][i & 3], w1 = wv[2 + (i >> 2)][i & 3], w2 = wv[4 + (i >> 2)][i & 3]; o[i] = gb[i] * (w0 * u[r][i] + w1 * u[r + 1][i] + w2 * u[r + 2][i]); }
            u32x4 w; w.x = cvt_pk_bf16(o[0], o[1]); w.y = cvt_pk_bf16(o[2], o[3]); w.z = cvt_pk_bf16(o[4], o[5]); w.w = cvt_pk_bf16(o[6], o[7]);
            *(u32x4*)(mixin + (size_t)(m0 + r) * D + 1024 + c0) = w;
        }
        if (t0 == LSEQ - 4) {
#pragma unroll
            for (int r = 0; r < 2; ++r) { float* co = p.out + O_CP + (((size_t)l * NBATCH + b) * 2 + r) * CDIM + c0;
                *(f32x4*)co = (f32x4){u[4 + r][0], u[4 + r][1], u[4 + r][2], u[4 + r][3]}; *(f32x4*)(co + 4) = (f32x4){u[4 + r][4], u[4 + r][5], u[4 + r][6], u[4 + r][7]}; }
        }
    }
}

__device__ __forceinline__ void kv_prompt_row(int l, int idx, const Params& p, const bf16_t* __restrict__ z, int lane) {
    const int b = idx >> 7, w = idx & 127;
    const bf16_t* zr = z + (size_t)(b * LSEQ + (LSEQ - WIN) + w) * INDIM;
    const u32x2 kv = *(const u32x2*)(zr + ZK + 4 * lane), vv = *(const u32x2*)(zr + ZV + 4 * lane);
    const size_t o = (((size_t)l * NBATCH + b) * WIN + w) * 256 + 4 * lane;
    *(f32x4*)(p.out + O_KP + o) = (f32x4){bf_lo(kv.x), bf_hi(kv.x), bf_lo(kv.y), bf_hi(kv.y)};
    *(f32x4*)(p.out + O_VP + o) = (f32x4){bf_lo(vv.x), bf_hi(vv.x), bf_lo(vv.y), bf_hi(vv.y)};
}
__device__ __forceinline__ void kv_sample_row(int l, int idx, const Params& p, const bf16_t* __restrict__ z, int lane) {
    const int b = idx >> 7, w = idx & 127;
    const size_t o = (((size_t)l * DB + b) * WIN + w) * 256 + 4 * lane;
    f32x4 kq, vq;
    if (w < WIN - 1) { kq = *(const f32x4*)(p.cache_k + o + 256); vq = *(const f32x4*)(p.cache_v + o + 256); }
    else { const bf16_t* zr = z + (size_t)(MPROMPT + b) * INDIM; const u32x2 kv = *(const u32x2*)(zr + ZK + 4 * lane), vv = *(const u32x2*)(zr + ZV + 4 * lane);
        kq = (f32x4){bf_lo(kv.x), bf_hi(kv.x), bf_lo(kv.y), bf_hi(kv.y)}; vq = (f32x4){bf_lo(vv.x), bf_hi(vv.x), bf_lo(vv.y), bf_hi(vv.y)}; }
    *(f32x4*)(p.out + O_KS + o) = kq; *(f32x4*)(p.out + O_VS + o) = vq;
}

__device__ __forceinline__ void kv_sample_row2(int l, int i0, int i1, const Params& p, const bf16_t* __restrict__ z, int lane) {
    f32x4 kq[2], vq[2]; size_t o[2]; const int idx[2] = {i0, i1};
#pragma unroll
    for (int e = 0; e < 2; ++e) {
        const int b = idx[e] >> 7, w = idx[e] & 127;
        o[e] = (((size_t)l * DB + b) * WIN + w) * 256 + 4 * lane;
        if (w < WIN - 1) { kq[e] = *(const f32x4*)(p.cache_k + o[e] + 256); vq[e] = *(const f32x4*)(p.cache_v + o[e] + 256); }
        else { const bf16_t* zr = z + (size_t)(MPROMPT + b) * INDIM; const u32x2 kv = *(const u32x2*)(zr + ZK + 4 * lane), vv = *(const u32x2*)(zr + ZV + 4 * lane);
            kq[e] = (f32x4){bf_lo(kv.x), bf_hi(kv.x), bf_lo(kv.y), bf_hi(kv.y)}; vq[e] = (f32x4){bf_lo(vv.x), bf_hi(vv.x), bf_lo(vv.y), bf_hi(vv.y)}; }
    }
#pragma unroll
    for (int e = 0; e < 2; ++e) { *(f32x4*)(p.out + O_KS + o[e]) = kq[e]; *(f32x4*)(p.out + O_VS + o[e]) = vq[e]; }
}

__device__ __forceinline__ void filler_cache_copy(const Params& p, int l, int nwg, int wid, int lane) {
    const int G = gridDim.x, r = nwg % G, c = blockIdx.x;
    int worker, nw;
    if (r == 0) { worker = c * 8 + wid; nw = G * 8; } else if (c >= r) { worker = (c - r) * 8 + wid; nw = (G - r) * 8; } else return;
    for (int i = worker; i < DB * WIN / 2; i += nw) {
        const int i1 = i + DB * WIN / 2;
        if ((i & 127) != 127) kv_sample_row2(l, i, i1, p, (const bf16_t*)(p.ws + WS_ZACT), lane);
    }
}

constexpr int NU_ATT = NBATCH * 4 * 16;

__device__ __forceinline__ void mixer_phase(const Params& p, int l, LAS unsigned char* lds, int tid, int wid, int lane, unsigned long long& tacc_, unsigned long long& t0_) {
    const bf16_t* z = (const bf16_t*)(p.ws + WS_ZACT); bf16_t* mixin = (bf16_t*)(p.ws + WS_MIXIN);
    TB(9);
    for (int u = blockIdx.x; u < NU_ATT; u += gridDim.x) { const int qt = u & 15, bk = u >> 4; attn_prompt_unit(lds, bk >> 2, bk & 3, qt, z, mixin, p.sinks + l * NHEADS, tid, wid, lane); }
    TE(9);
    TB(10);
    const int gw = blockIdx.x * 8 + wid, NGW = gridDim.x * 8;
    if (gw < MPROMPT / 4) conv_job4(l, 4 * gw, p, z, mixin, lane);
    for (int j = NGW + (gw >> 7); j < MPROMPT / 4 && (gw & 127) == 5; j += NGW >> 7) conv_job4(l, 4 * j, p, z, mixin, lane);
    if ((gw & 63) == 33 && (gw >> 6) < DB) conv_row(l, MPROMPT + (gw >> 6), p, z, mixin, lane);
    if ((gw & 3) == 0 && (gw >> 2) < DB * NHEADS) { const int job = gw >> 2; attn_sample_wave(lds, l, job >> 4, job & 15, p, z, mixin, wid, lane); }
    for (int i = (int)NGW - 1 - gw; i < NBATCH * WIN; i += NGW) kv_prompt_row(l, i, p, z, lane);
    if ((gw & 63) == 34 && (gw >> 6) < DB) kv_sample_row(l, (gw >> 6) * WIN + (WIN - 1), p, z, lane);
    TE(10);
}

__global__ void __launch_bounds__(512, 2) hymba_fwd(Params p) {
    extern __shared__ __attribute__((aligned(16))) unsigned char lds_raw[];
    LAS unsigned char* lds = (LAS unsigned char*)lds_raw;
    cg::grid_group grid = cg::this_grid();
    const int tid = threadIdx.x, lane = tid & 63, wid = __builtin_amdgcn_readfirstlane(tid >> 6);

    unsigned* barw = (unsigned*)(p.ws + WS_BAR);
    unsigned* cntw = (unsigned*)(p.ws + WS_CNT);
    volatile LAS unsigned* xst = (volatile LAS unsigned*)(lds + MISC_OFF);
    if (tid < 2) xst[tid] = 0u;
    __syncthreads();
    const XcdBarrier xb = xcd_barrier_post(barw, xst);
    {
        LAS float* biasL = (LAS float*)(lds + BIAS_OFF);
        for (int i = tid; i < NHEADS * BIAS_STRIDE; i += 512) {
            const int h = i / BIAS_STRIDE, d = i % BIAS_STRIDE - BIAS_PAD;
            float v = -INFINITY;
            if (d >= 0 && d <= WIN) {
                int bkt;
                if (d < 16) bkt = d;
                else { const float df = (float)d; bkt = 16 + (int)(logf(df / 16.f) / logf(8.f) * 16.f); bkt = bkt > 31 ? 31 : bkt; }
                v = p.rel_bias[bkt * NHEADS + h];
            }
            biasL[i] = v;
        }
    }
    unsigned long long tacc_ = 0, t0_ = 0;
    TB(0);
    for (int rep = 0; rep < REP_PRO; ++rep) prologue(p, lds, wid, lane);
    TE(0);
    if (p.ws == nullptr) grid.sync();
    GSYNC();

    bf16_t* ZACT = (bf16_t*)(p.ws + WS_ZACT); bf16_t* MIXIN = (bf16_t*)(p.ws + WS_MIXIN); bf16_t* MIXB = (bf16_t*)(p.ws + WS_MIXB); bf16_t* MIXB1 = (bf16_t*)(p.ws + WS_MIXB1);
    const int vcu = (gridDim.x % 8 == 0) ? (int)((blockIdx.x % 8) * (gridDim.x / 8) + blockIdx.x / 8) : (int)blockIdx.x;
    const int skw = (gridDim.x == 256) ? ((vcu & 7) * 32 + (vcu >> 5) * 4 + ((vcu & 31) >> 3)) : vcu;
    const bf16_t* HB = (const bf16_t*)(p.ws + WS_HB); const float* RS = (const float*)(p.ws + WS_RS);
#pragma unroll 1
    for (int l = 0; l < DEPTH; ++l) {
        TB(1);
        {
            pg8::Gemm g{HB, (const bf16_t*)(p.ws + WS_WIN + l * SZ_WIN), MP, INDIM, D}; pg8::Epi<0> E{ZACT, INDIM, RS, ZACT};
            pg8::StaticOrder S; S.init(MP, INDIM, D, (int)gridDim.x, (int)blockIdx.x);
            for (int rep = 0; rep < REP_GIN; ++rep) pg8::gemm_phase<D, pg8::Epi<0>, pg8::StaticOrder>(lds, g, S, E);
            for (int rep = 0; rep < REP_FILL; ++rep) { int t2 = threadIdx.x; asm volatile("" : "+v"(t2)); const int w2 = __builtin_amdgcn_readfirstlane(t2 >> 6), l2 = t2 & 63;
                filler(p, l, I_IN, I_LAYER - I_DN, (MP / 256) * (INDIM / 256), lds, w2, l2);
                if (l + 1 < DEPTH) filler(p, l + 1, 0, I_IN / 2, (MP / 256) * (INDIM / 256), lds, w2, l2);
                filler_cache_copy(p, l, (MP / 256) * (INDIM / 256), w2, l2); }
        }
        TE(1);
        GSYNC();
        TB(2);
#ifndef NO_MIX
        for (int rep = 0; rep < REP_MIX; ++rep) { int t2 = threadIdx.x; asm volatile("" : "+v"(t2)); mixer_phase(p, l, lds, t2, __builtin_amdgcn_readfirstlane(t2 >> 6), t2 & 63, tacc_, t0_); }
#endif
        TE(2);
        GSYNC();
        TB(3);
        {
            pg8::Gemm g{MIXIN, (const bf16_t*)(p.ws + WS_WOUT + l * SZ_WOUT), MP, D, D}; pg8::Epi<0> E{MIXB, D, nullptr, MIXB1};
            pg8::StreamKOrder<D / 128> S; S.init((int)gridDim.x, skw);
            for (int rep = 0; rep < REP_GOUT; ++rep) pg8::gemm_phase<D, pg8::Epi<0>, pg8::StreamKOrder<D / 128>>(lds, g, S, E);
            TE(3);
            TB(4);
            { int t2 = threadIdx.x; asm volatile("" : "+v"(t2)); sk_postnorm<D / 128>(p, S, cntw + (size_t)((l * 2 + 0) * 33) * 16, p.n_post_mix + l * D, false, vcu, t2, __builtin_amdgcn_readfirstlane(t2 >> 6), t2 & 63, tacc_, t0_); }
        }
        TE(4);
        GSYNC();
        TB(5);
        {
            pg8::Gemm g{HB, (const bf16_t*)(p.ws + WS_WGU + l * SZ_WGU), MP, NGU, D}; pg8::Epi<1> E{ZACT, DFF, RS, ZACT};
            pg8::StaticOrder S; S.init(MP, NGU, D, (int)gridDim.x, (int)blockIdx.x);
            for (int rep = 0; rep < REP_GGU; ++rep) pg8::gemm_phase<D, pg8::Epi<1>, pg8::StaticOrder>(lds, g, S, E);
            for (int rep = 0; rep < REP_FILL; ++rep) { int t2 = threadIdx.x; asm volatile("" : "+v"(t2)); const int w2 = __builtin_amdgcn_readfirstlane(t2 >> 6), l2 = t2 & 63;
                filler(p, l, I_LAYER - I_DN, I_LAYER, (MP / 256) * (NGU / 256), lds, w2, l2);
                if (l + 1 < DEPTH) filler(p, l + 1, I_IN / 2, I_IN, (MP / 256) * (NGU / 256), lds, w2, l2); }
        }
        TE(5);
        GSYNC();
        TB(6);
        {
            pg8::Gemm g{ZACT, (const bf16_t*)(p.ws + WS_WDN + l * SZ_WDN), MP, D, DFF}; pg8::Epi<0> E{MIXB, D, nullptr, MIXB1};
            pg8::StreamKOrder<DFF / 128> S; S.init((int)gridDim.x, skw);
            for (int rep = 0; rep < REP_GDN; ++rep) pg8::gemm_phase<DFF, pg8::Epi<0>, pg8::StreamKOrder<DFF / 128>>(lds, g, S, E);
            TE(6);
            TB(7);
            { int t2 = threadIdx.x; asm volatile("" : "+v"(t2)); sk_postnorm<DFF / 128>(p, S, cntw + (size_t)((l * 2 + 1) * 33) * 16, p.n_post_ffn + l * D, l == DEPTH - 1, vcu, t2, __builtin_amdgcn_readfirstlane(t2 >> 6), t2 & 63, tacc_, t0_); }
        }
        TE(7);
        if (l != DEPTH - 1) GSYNC();
    }
    if (TMASK != 0 && blockIdx.x == TBLK) { const unsigned long long tend = __builtin_amdgcn_s_memrealtime() + (unsigned long long)TMULT * tacc_; while (__builtin_amdgcn_s_memrealtime() < tend) __builtin_amdgcn_s_sleep(8); }
}

extern "C" void kernel_launch(void* const* d_in, const int* in_sizes, int n_in, void* d_out, int out_size, void* d_ws, size_t ws_size, hipStream_t stream) {
    static int grid_blocks = 0;
    if (grid_blocks == 0) {
        if (n_in != 18 || ws_size < WS_END) { fprintf(stderr, "kernel_launch: unexpected inputs (n_in %d, ws %zu, need %zu)\n", n_in, ws_size, (size_t)WS_END); grid_blocks = -1; return; }
        int dev = 0, cus = 0, per_cu = 0;
        hipGetDevice(&dev);
        hipDeviceGetAttribute(&cus, hipDeviceAttributeMultiprocessorCount, dev);
        hipFuncSetAttribute((const void*)hymba_fwd, hipFuncAttributeMaxDynamicSharedMemorySize, LDS_BYTES);
        hipOccupancyMaxActiveBlocksPerMultiprocessor(&per_cu, (const void*)hymba_fwd, 512, LDS_BYTES);
        if (per_cu < 1) per_cu = 1;
        grid_blocks = cus * per_cu;
    }
    if (grid_blocks < 0) return;
    if (hipMemsetAsync((char*)d_ws + WS_BAR, 0, WS_END - WS_BAR, stream) != hipSuccess) { fprintf(stderr, "kernel_launch: memset of the barrier words failed\n"); return; }
    Params p{};
    const float** pp = (const float**)&p;
    for (int i = 0; i < 18; ++i) pp[i] = (const float*)d_in[i];
    p.out = (float*)d_out; p.ws = (unsigned char*)d_ws;
    void* args[] = {&p};
    hipError_t e = hipLaunchCooperativeKernel((const void*)hymba_fwd, dim3(grid_blocks), dim3(512), args, LDS_BYTES, stream);
    if (e != hipSuccess) fprintf(stderr, "cooperative launch failed: %s (grid %d)\n", hipGetErrorString(e), grid_blocks);
}
```

```cpp
#include <hip/hip_runtime.h>
#include <hip/hip_cooperative_groups.h>
#include <cstdio>
#include <cstdint>
namespace cg = cooperative_groups;
#define REP_PRO 1
#define REP_MIX 1
#define REP_GIN 1
#define REP_GOUT 1
#define REP_GGU 1
#define REP_GDN 1
#define EXTRA_SYNC 0
#define REP_PN 0
#define REP_FILL 1
#define WGM_SET 5
#define TMASK 0
#define TMULT 4
#define TBLK 0
#define TB(k) do { if (TMASK & (1 << (k))) t0_ = __builtin_amdgcn_s_memrealtime(); } while (0)
#define TE(k) do { if (TMASK & (1 << (k))) tacc_ += __builtin_amdgcn_s_memrealtime() - t0_; } while (0)
#define GSYNC() do { TB(8); xcd_barrier(xb); for (int e_ = 0; e_ < EXTRA_SYNC; ++e_) xcd_barrier(xb); TE(8); } while (0)

#define LAS __attribute__((address_space(3)))
typedef unsigned short bf16_t;
typedef short bf16x8 __attribute__((ext_vector_type(8)));
typedef float f32x4 __attribute__((ext_vector_type(4)));
typedef float f32x2 __attribute__((ext_vector_type(2)));
typedef unsigned u32x4 __attribute__((ext_vector_type(4)));
typedef unsigned u32x2 __attribute__((ext_vector_type(2)));

constexpr int D = 2048, NBATCH = 4, SEQ = 2048, NMETA = 16, LSEQ = SEQ + NMETA, DEPTH = 4, DB = 32, WIN = 128;
constexpr int MPROMPT = NBATCH * LSEQ;
constexpr int MREAL = MPROMPT + DB;
constexpr int MP = 8448;
constexpr int INDIM = 4608, DFF = 5632, NGU = 2 * DFF, CDIM = 1024;
constexpr int ZQ = 0, ZK = 1024, ZV = 1280, ZGB = 1536, ZGC = 2560, ZHC = 3584;
constexpr float RMS_EPS = 1e-6f;
constexpr int NHEADS = 16;

constexpr size_t O_YP = 0, O_YS = 16777216, O_KP = 16842752, O_VP = 17367040, O_CP = 17891328, O_KS = 17924096, O_VS = 22118400, O_CS = 26312704;

constexpr size_t SZ_WIN = (size_t)INDIM * D * 2, SZ_WOUT = (size_t)D * D * 2, SZ_WGU = (size_t)NGU * D * 2, SZ_WDN = (size_t)D * DFF * 2;
constexpr size_t WS_WIN = 0;
constexpr size_t WS_WOUT = WS_WIN + DEPTH * SZ_WIN;
constexpr size_t WS_WGU = WS_WOUT + DEPTH * SZ_WOUT;
constexpr size_t WS_WDN = WS_WGU + DEPTH * SZ_WGU;
constexpr size_t WS_ZACT = WS_WDN + DEPTH * SZ_WDN;
constexpr size_t WS_MIXIN = WS_ZACT + (size_t)MP * DFF * 2;
constexpr size_t WS_MIXB = WS_MIXIN + (size_t)MP * D * 2;
constexpr size_t WS_MIXB1 = WS_MIXB + (size_t)MP * D * 2;
constexpr size_t WS_HB = WS_MIXB1 + (size_t)MP * D * 2;
constexpr size_t WS_RS = WS_HB + (size_t)MP * D * 2;
constexpr size_t WS_BAR = WS_RS + (size_t)MP * 4;
constexpr size_t WS_CNT = WS_BAR + 16384;
constexpr size_t WS_END = WS_CNT + (size_t)DEPTH * 2 * 33 * 64;

constexpr int RING_BYTES = 131072, BIAS_OFF = RING_BYTES, LDS_BYTES = 147456;
constexpr int BIAS_STRIDE = 176, BIAS_PAD = 16;
constexpr int MISC_OFF = BIAS_OFF + NHEADS * BIAS_STRIDE * 4;

__device__ __forceinline__ unsigned cvt_pk_bf16(float lo, float hi) { unsigned r; asm volatile("v_cvt_pk_bf16_f32 %0, %1, %2" : "=v"(r) : "v"(lo), "v"(hi)); return r; }
__device__ __forceinline__ float bf_lo(unsigned u) { return __uint_as_float(u << 16); }
__device__ __forceinline__ float bf_hi(unsigned u) { return __uint_as_float(u & 0xffff0000u); }
__device__ __forceinline__ float wave_sum(float v) {
#pragma unroll
    for (int o = 1; o < 64; o <<= 1) v += __shfl_xor(v, o);
    return v;
}
__device__ __forceinline__ float wave_max(float v) {
#pragma unroll
    for (int o = 1; o < 64; o <<= 1) v = fmaxf(v, __shfl_xor(v, o));
    return v;
}
#define LDS_WAIT() asm volatile("s_waitcnt lgkmcnt(0)" ::: "memory")
#define WT_STORES 0
#define WT_SK 1
#define WT_LAST 0
__device__ __forceinline__ void store16_wt(void* p, u32x4 v, bool wt) {
    if (wt) asm volatile("global_store_dwordx4 %0, %1, off sc1\n\ts_nop 1" :: "v"(p), "v"(v) : "memory");
    else *(u32x4*)p = v;
}
__device__ __forceinline__ void store8_wt(void* p, u32x2 v) {
#if WT_STORES
    asm volatile("global_store_dwordx2 %0, %1, off sc1\n\ts_nop 1" :: "v"(p), "v"(v) : "memory");
#else
    *(u32x2*)p = v;
#endif
}


#define XB_TMO      128
#define XB_XCNT(j)  (256  + 64 * (j))
#define XB_XSUB(j)  (1280 + 64 * (j))
#define XB_XGEN(j)  (2304 + 64 * (j))
#define XB_TOP      3328
#define XB_TOPGEN   3392
#define XCD_BAR_WORDS 3456
#define XB_SPIN_CAP (1u << 18)
__device__ __forceinline__ unsigned xb_ld(unsigned* p)              { return __hip_atomic_load(p, __ATOMIC_RELAXED, __HIP_MEMORY_SCOPE_AGENT); }
__device__ __forceinline__ unsigned xb_add(unsigned* p, unsigned v) { return __hip_atomic_fetch_add(p, v, __ATOMIC_RELAXED, __HIP_MEMORY_SCOPE_AGENT); }
__device__ __forceinline__ unsigned xb_xcc_id() { return (unsigned)__builtin_amdgcn_s_getreg((3 << 11) | 20) & 0xFu; }
#define XB_SPIN(cond, bar) do { unsigned _sp = 0; while (cond) { __builtin_amdgcn_s_sleep(1); \
    if ((++_sp & 255u) == 0u) { if (xb_ld(&(bar)[XB_TMO])) break; if (_sp > XB_SPIN_CAP) { atomicAdd(&(bar)[XB_TMO], 1u); break; } } } } while (0)
struct XcdBarrier { unsigned* bar; unsigned x; volatile LAS unsigned* st; };
__device__ __forceinline__ XcdBarrier xcd_barrier_post(unsigned* bar, volatile LAS unsigned* st) {
    XcdBarrier b; b.bar = bar; b.x = xb_xcc_id(); b.st = st;
    if (threadIdx.x == 0) (void)xb_add(&bar[XB_XCNT(b.x)], 1u);
    return b;
}
__device__ __forceinline__ void xcd_barrier_complete(unsigned* bar, unsigned x, unsigned& nloc, unsigned& nx) {
    const unsigned G = gridDim.x * gridDim.y * gridDim.z;
    unsigned sum, cnt, mine, sp = 0u;
    for (;;) {
        sum = 0u; cnt = 0u; mine = 0u;
#pragma unroll
        for (unsigned j = 0; j < 16; ++j) { const unsigned c = xb_ld(&bar[XB_XCNT(j)]); sum += c; cnt += (c > 0u) ? 1u : 0u; mine = (j == x) ? c : mine; }
        if (sum == G) break;
        __builtin_amdgcn_s_sleep(1);
        if ((++sp & 255u) == 0u) { if (xb_ld(&bar[XB_TMO])) break; if (sp > XB_SPIN_CAP) { atomicAdd(&bar[XB_TMO], 1u); break; } }
    }
    nloc = mine > 0u ? mine : 1u; nx = cnt > 0u ? cnt : 1u;
}
__device__ __forceinline__ void xcd_barrier(const XcdBarrier& b) {
    asm volatile("s_waitcnt vmcnt(0)" ::: "memory");
    __syncthreads();
    if (threadIdx.x == 0) {
        unsigned* bar = b.bar;
        __builtin_amdgcn_s_waitcnt(0);
        unsigned nloc = b.st[0], nx = b.st[1];
        if (nloc == 0u) { xcd_barrier_complete(bar, b.x, nloc, nx); b.st[0] = nloc; b.st[1] = nx; }
        const unsigned old = xb_add(&bar[XB_XSUB(b.x)], 1u);
        const unsigned gen = old / nloc;
        if (old + 1u == (gen + 1u) * nloc) {
            __builtin_amdgcn_fence(__ATOMIC_RELEASE, "agent");
            asm volatile("s_waitcnt vmcnt(0)" ::: "memory");
            const unsigned og = xb_add(&bar[XB_TOP], 1u);
            const unsigned tg = og / nx;
            if (og + 1u == (tg + 1u) * nx) xb_add(&bar[XB_TOPGEN], 1u);
            else XB_SPIN(xb_ld(&bar[XB_TOPGEN]) == tg, bar);
            __builtin_amdgcn_fence(__ATOMIC_ACQUIRE, "agent");
            xb_add(&bar[XB_XGEN(b.x)], 1u);
            asm volatile("s_waitcnt vmcnt(0)" ::: "memory");
        } else {
            XB_SPIN(xb_ld(&bar[XB_XGEN(b.x)]) == gen, bar);
            __builtin_amdgcn_fence(__ATOMIC_ACQUIRE, "agent");
            asm volatile("s_waitcnt vmcnt(0)" ::: "memory");
        }
    }
    __syncthreads();
}

namespace pg8 {
constexpr int BM = 256, BK = 64, HALF = 128, HTB = HALF * BK * 2, STAGE_BYTES = 8 * HTB, NXCD = 8, WGM = WGM_SET;
__host__ __device__ __forceinline__ int lds_byte(int r, int c) { const int st = (r >> 4) * 2 + (c >> 5), rr = r & 15, cc = c & 31, ob = rr * 64 + cc * 2; return st * 1024 + (ob ^ (((ob >> 9) & 1) << 5)); }
__host__ __device__ __forceinline__ void stage_rc(int b, int& R, int& C) { const int st = b / 1024, sb = b % 1024, swz = sb ^ (((sb >> 9) & 1) << 5); R = (st >> 1) * 16 + swz / 64; C = (st & 1) * 32 + (swz % 64) / 2; }
__host__ __device__ __forceinline__ int perm32(int rho) { const int n = rho >> 4, i = rho & 15; return 8 * (i >> 2) + 4 * n + (i & 3); }

struct Unit { int pm, pn, kt0, len, part; };
struct Gemm { const bf16_t* A; const bf16_t* Bt; int M, N, K; };

struct StaticOrder {
    static constexpr bool WT_ALL = false;
    int nM, nN, nwg, G, c, nt;
    __host__ __device__ void init(int M, int N, int K, int G_, int c_) { nM = M / BM; nN = N / BM; nwg = nM * nN; G = G_; c = c_; nt = K / BK; }
    __host__ __device__ bool next(int i, Unit& u) const {
        const long L = (long)i * G + c; if (L >= nwg) return false;
        int wgid = (int)L; { const int q = nwg / NXCD, r = nwg % NXCD, xcd = wgid % NXCD, off = wgid / NXCD; wgid = (xcd < r ? xcd * (q + 1) : r * (q + 1) + (xcd - r) * q) + off; }
        const int nig = WGM * nN, gid = wgid / nig, fm = gid * WGM, gsz = (nM - fm) < WGM ? (nM - fm) : WGM;
        u.pm = fm + ((wgid % nig) % gsz); u.pn = (wgid % nig) / gsz; u.kt0 = 0; u.len = nt; u.part = 0; return true;
    }
};
template <int PP> struct StreamKOrder {
    static constexpr bool WT_ALL = (WT_SK != 0);
    static constexpr int NPAN = MP / BM, NTILE = NPAN * 8, TP = NTILE * PP;
    int q0, q1;
    __device__ void init(int G, int v) { q0 = (int)((long)v * TP / G); q1 = (int)((long)(v + 1) * TP / G); }
    __device__ bool next(int i, Unit& u) const {
        const int t = q0 / PP + i, s = t * PP; const int a = q0 > s ? q0 : s, b = q1 < s + PP ? q1 : s + PP;
        if (a >= b) return false;
        u.pn = t / NPAN; u.pm = t % NPAN; u.kt0 = 2 * (a - s); u.len = 2 * (b - a); u.part = a > s ? 1 : 0; return true;
    }
    static __device__ __forceinline__ bool is_split(int t, int G) { const int s = t * PP; return (int)(((long)(s + 1) * G - 1) / TP) != (int)(((long)(s + PP) * G - 1) / TP); }
};

template <int MODE> struct Epi {
    static constexpr bool PERM = true;
    bf16_t* O; int ldc; const float* rs; bf16_t* O1;
    __device__ __forceinline__ void operator()(const f32x4 (&acc)[2][2][4][2], const Unit& u, int wr, int wc, int fr, int fq, bool wt) const {
        const int row0 = u.pm * BM + wr * 64 + fr;
        if constexpr (MODE == 0) {
            const int col0 = u.pn * BM + wc * 32 + 8 * fq;
#pragma unroll
            for (int ai = 0; ai < 2; ++ai)
#pragma unroll
                for (int m = 0; m < 4; ++m) {
                    const int row = row0 + ai * HALF + m * 16;
                    bf16_t* rowp = (u.part ? O1 : O) + (size_t)row * ldc + col0;
#pragma unroll
                    for (int bj = 0; bj < 2; ++bj) {
                        const f32x4 v0 = acc[ai][bj][m][0], v1 = acc[ai][bj][m][1];
                        u32x4 w; w.x = cvt_pk_bf16(v0[0], v0[1]); w.y = cvt_pk_bf16(v0[2], v0[3]); w.z = cvt_pk_bf16(v1[0], v1[1]); w.w = cvt_pk_bf16(v1[2], v1[3]);
                        store16_wt(rowp + bj * HALF, w, wt);
                    }
                }
        } else {
            const int col0 = u.pn * HALF + wc * 32 + 8 * fq;
#pragma unroll
            for (int ai = 0; ai < 2; ++ai)
#pragma unroll
                for (int m = 0; m < 4; ++m) {
                    const int row = row0 + ai * HALF + m * 16;
                    float o[8];
#pragma unroll
                    for (int n = 0; n < 2; ++n)
#pragma unroll
                        for (int j = 0; j < 4; ++j) {
                            const float g = acc[ai][0][m][n][j], up = acc[ai][1][m][n][j];
                            o[n * 4 + j] = (g * up) * __builtin_amdgcn_rcpf(1.f + __builtin_amdgcn_exp2f(g * -1.4426950408889634f));
                        }
                    u32x4 w; w.x = cvt_pk_bf16(o[0], o[1]); w.y = cvt_pk_bf16(o[2], o[3]); w.z = cvt_pk_bf16(o[4], o[5]); w.w = cvt_pk_bf16(o[6], o[7]);
                    store16_wt(O + (size_t)row * ldc + col0, w, wt);
                }
        }
    }
};

template <int K, class EpiT, class Sched>
__device__ __forceinline__ void gemm_phase(LAS unsigned char* lds, const Gemm g, const Sched& S, const EpiT& E) {
    int tid_ = threadIdx.x; asm volatile("" : "+v"(tid_));
    const int tid = tid_, wid = __builtin_amdgcn_readfirstlane(tid >> 6), lane = tid & 63, wr = wid >> 2, wc = wid & 3, fr = lane & 15, fq = lane >> 4;
    unsigned voffA[2], voffB[2];
#pragma unroll
    for (int i = 0; i < 2; ++i) { int R, C; stage_rc(tid * 16 + i * 8192, R, C); const int Rb = EpiT::PERM ? ((R & ~31) + perm32(R & 31)) : R;
        voffA[i] = (unsigned)(R * K + C) * 2u; voffB[i] = (unsigned)(Rb * K + C) * 2u; }
    const size_t kstep = (size_t)(BK * 2);
    const size_t hstep = (size_t)HALF * K * 2;
    const size_t tstep = 2 * hstep;
    const unsigned ldsw = (unsigned)wid * 1024u;
    const int aoff = lds_byte(wr * 64 + fr, fq * 8), boff = lds_byte(wc * 32 + fr, fq * 8);
#define PG8_SA(b, h) (((b) * 2 + (h)) * HTB)
#define PG8_SB(b, h) ((4 + (b) * 2 + (h)) * HTB)
#define PG8_STAGE(bufoff, gbase, voff) do { _Pragma("unroll") for (int _i = 0; _i < 2; ++_i) \
        __builtin_amdgcn_global_load_lds((const unsigned*)((const char*)(gbase) + (voff)[_i]), (LAS unsigned*)(lds + (bufoff) + ldsw + _i * 8192), 16, 0, 0); } while (0)
#define PG8_LDA(dst, b, h) do { _Pragma("unroll") for (int m = 0; m < 4; ++m) _Pragma("unroll") for (int k = 0; k < 2; ++k) dst[m][k] = *(const LAS bf16x8*)(lds + PG8_SA(b, h) + aoff + m * 2048 + k * 1024); } while (0)
#define PG8_LDB(dst, b, h) do { _Pragma("unroll") for (int n = 0; n < 2; ++n) _Pragma("unroll") for (int k = 0; k < 2; ++k) dst[n][k] = *(const LAS bf16x8*)(lds + PG8_SB(b, h) + boff + n * 2048 + k * 1024); } while (0)
#define PG8_MMA(ai, bj, At, Bt) do { __builtin_amdgcn_s_setprio(1); _Pragma("unroll") for (int m = 0; m < 4; ++m) _Pragma("unroll") for (int n = 0; n < 2; ++n) _Pragma("unroll") for (int k = 0; k < 2; ++k) \
        acc[ai][bj][m][n] = __builtin_amdgcn_mfma_f32_16x16x32_bf16(Bt[n][k], At[m][k], acc[ai][bj][m][n], 0, 0, 0); __builtin_amdgcn_s_setprio(0); } while (0)
#define PG8_WAIT_V(n) asm volatile("s_waitcnt vmcnt(" #n ")" ::: "memory")
#define PG8_WAIT_L(n) asm volatile("s_waitcnt lgkmcnt(" #n ")" ::: "memory")
#define PG8_BAR __builtin_amdgcn_s_barrier()
#define PG8_SCHED __builtin_amdgcn_sched_barrier(0)
    Unit cur, nxt; int ui = 0;
    if (!S.next(0, cur)) return;
    f32x4 acc[2][2][4][2];
#pragma unroll
    for (int a = 0; a < 2; ++a)
#pragma unroll
        for (int b = 0; b < 2; ++b)
#pragma unroll
            for (int m = 0; m < 4; ++m)
#pragma unroll
                for (int n = 0; n < 2; ++n) acc[a][b][m][n] = (f32x4){0.f, 0.f, 0.f, 0.f};
    bf16x8 At[4][2], B0[2][2], B1[2][2];
    const char* cA = (const char*)g.A + (size_t)cur.pm * tstep + (size_t)cur.kt0 * kstep; const char* cB = (const char*)g.Bt + (size_t)cur.pn * tstep + (size_t)cur.kt0 * kstep;
    PG8_STAGE(PG8_SB(0, 0), cB, voffB); PG8_STAGE(PG8_SB(0, 1), cB + hstep, voffB); PG8_STAGE(PG8_SA(0, 0), cA, voffA); PG8_STAGE(PG8_SA(0, 1), cA + hstep, voffA);
    if (wr == 1) PG8_BAR;
    PG8_WAIT_V(2); PG8_BAR;
    PG8_STAGE(PG8_SB(1, 0), cB + kstep, voffB); PG8_STAGE(PG8_SA(1, 0), cA + kstep, voffA); PG8_STAGE(PG8_SB(1, 1), cB + hstep + kstep, voffB);
    PG8_WAIT_V(6); PG8_BAR;
    for (;;) {
        const bool has_next = S.next(ui + 1, nxt);
        const char* nA = has_next ? (const char*)g.A + (size_t)nxt.pm * tstep + (size_t)nxt.kt0 * kstep : cA; const char* nB = has_next ? (const char*)g.Bt + (size_t)nxt.pn * tstep + (size_t)nxt.kt0 * kstep : cB;
        const int nt = cur.len;
        for (int t = 0; t < nt; t += 2) {
            const bool last = (t == nt - 2);
            const char* a1 = cA + (size_t)(t + 1) * kstep;
            const char* a2 = last ? nA : cA + (size_t)(t + 2) * kstep; const char* b2 = last ? nB : cB + (size_t)(t + 2) * kstep;
            const char* a3 = a2 + kstep; const char* b3 = b2 + kstep;
            PG8_LDB(B0, 0, 0); PG8_LDB(B1, 0, 1); PG8_SCHED; PG8_LDA(At, 0, 0); PG8_STAGE(PG8_SA(1, 1), a1 + hstep, voffA);
            PG8_WAIT_V(8); PG8_WAIT_L(0); PG8_BAR; PG8_MMA(0, 0, At, B0); PG8_MMA(0, 1, At, B1); PG8_BAR; PG8_SCHED;
            PG8_LDA(At, 0, 1); PG8_STAGE(PG8_SB(0, 0), b2, voffB); PG8_STAGE(PG8_SB(0, 1), b2 + hstep, voffB); PG8_STAGE(PG8_SA(0, 0), a2, voffA);
            PG8_WAIT_V(8); PG8_WAIT_L(0); PG8_BAR; PG8_MMA(1, 0, At, B0); PG8_MMA(1, 1, At, B1); PG8_BAR; PG8_SCHED;
            PG8_LDB(B0, 1, 0); PG8_LDB(B1, 1, 1); PG8_SCHED; PG8_LDA(At, 1, 0); PG8_STAGE(PG8_SA(0, 1), a2 + hstep, voffA);
            PG8_WAIT_V(8); PG8_WAIT_L(0); PG8_BAR; PG8_MMA(0, 0, At, B0); PG8_MMA(0, 1, At, B1); PG8_BAR; PG8_SCHED;
            PG8_LDA(At, 1, 1); PG8_STAGE(PG8_SB(1, 0), b3, voffB); PG8_STAGE(PG8_SB(1, 1), b3 + hstep, voffB); PG8_STAGE(PG8_SA(1, 0), a3, voffA);
            PG8_WAIT_V(8); PG8_WAIT_L(0); PG8_BAR; PG8_MMA(1, 0, At, B0); PG8_MMA(1, 1, At, B1); PG8_BAR; PG8_SCHED;
        }
        if (wr == 0) PG8_BAR;
        E(acc, cur, wr, wc, fr, fq, Sched::WT_ALL ? true : (WT_LAST != 0 && !has_next));
        if (!has_next) break;
#pragma unroll
        for (int a = 0; a < 2; ++a)
#pragma unroll
            for (int b = 0; b < 2; ++b)
#pragma unroll
                for (int m = 0; m < 4; ++m)
#pragma unroll
                    for (int n = 0; n < 2; ++n) acc[a][b][m][n] = (f32x4){0.f, 0.f, 0.f, 0.f};
        cur = nxt; cA = nA; cB = nB; ++ui;
        if (wr == 1) PG8_BAR;
    }
    PG8_WAIT_V(0);
    PG8_BAR;
#undef PG8_SA
#undef PG8_SB
#undef PG8_STAGE
#undef PG8_LDA
#undef PG8_LDB
#undef PG8_MMA
#undef PG8_WAIT_V
#undef PG8_WAIT_L
#undef PG8_BAR
#undef PG8_SCHED
}
}

struct Params {
    const float *x_prompt, *x_sample, *cache_k, *cache_v, *state_conv, *meta, *rel_bias, *w_in, *conv_w, *sinks, *w_out,
        *n_pre_mix, *n_post_mix, *n_pre_ffn, *n_post_ffn, *w_gate, *w_up, *w_down;
    float* out; unsigned char* ws;
};

constexpr int I_IN = (D / 64) * (INDIM / 64), I_OUT = (D / 64) * (D / 64), I_G = (D / 64) * (DFF / 64), I_DN = (DFF / 64) * (D / 64);
constexpr int I_LAYER = I_IN + I_OUT + 2 * I_G + I_DN;
struct ItemDesc { const float* W; const float* gain; bf16_t* WT; int K, N, mode, k0, n0; };
struct ItemRegs { f32x4 v0[8], v1[8]; f32x2 gg[8]; };
__device__ __forceinline__ void item_decode(const Params& p, int l, int it, ItemDesc& d) {
    int r = it;
    if (r < I_IN) { d.W = p.w_in + (size_t)l * D * INDIM; d.K = D; d.N = INDIM; d.WT = (bf16_t*)(p.ws + WS_WIN) + (size_t)l * INDIM * D; d.gain = p.n_pre_mix + l * D; d.mode = 0; }
    else if ((r -= I_IN) < I_OUT) { d.W = p.w_out + (size_t)l * D * D; d.K = D; d.N = D; d.WT = (bf16_t*)(p.ws + WS_WOUT) + (size_t)l * D * D; d.gain = nullptr; d.mode = 0; }
    else if ((r -= I_OUT) < I_G) { d.W = p.w_gate + (size_t)l * D * DFF; d.K = D; d.N = DFF; d.WT = (bf16_t*)(p.ws + WS_WGU) + (size_t)l * NGU * D; d.gain = p.n_pre_ffn + l * D; d.mode = 1; }
    else if ((r -= I_G) < I_G) { d.W = p.w_up + (size_t)l * D * DFF; d.K = D; d.N = DFF; d.WT = (bf16_t*)(p.ws + WS_WGU) + (size_t)l * NGU * D; d.gain = p.n_pre_ffn + l * D; d.mode = 2; }
    else { r -= I_G; d.W = p.w_down + (size_t)l * DFF * D; d.K = DFF; d.N = D; d.WT = (bf16_t*)(p.ws + WS_WDN) + (size_t)l * D * DFF; d.gain = nullptr; d.mode = 0; }
    const int nblk = d.N / 64; d.k0 = 64 * (r / nblk); d.n0 = 64 * (r % nblk);
}
__device__ __forceinline__ void item_load(const ItemDesc& d, int lane, ItemRegs& R) {
    const int c4 = lane & 15, kq = lane >> 4;
#pragma unroll
    for (int i = 0; i < 8; ++i) { const int kp = kq + 4 * i; const float* s = d.W + (size_t)(d.k0 + 2 * kp) * d.N + d.n0 + 4 * c4; R.v0[i] = *(const f32x4*)s; R.v1[i] = *(const f32x4*)(s + d.N); }
#pragma unroll
    for (int i = 0; i < 8; ++i) { const int kp = kq + 4 * i; R.gg[i] = d.gain ? *(const f32x2*)(d.gain + d.k0 + 2 * kp) : (f32x2){1.f, 1.f}; }
}
__device__ __forceinline__ void item_finish(const ItemDesc& d, LAS unsigned* scr, int lane, const ItemRegs& R) {
    const int c4 = lane & 15, kq = lane >> 4;
#pragma unroll
    for (int i = 0; i < 8; ++i) { const int kp = kq + 4 * i; const float g0 = R.gg[i].x, g1 = R.gg[i].y;
        LAS unsigned* q = scr + (4 * c4) * 33 + kp;
        q[0] = cvt_pk_bf16(R.v0[i].x * g0, R.v1[i].x * g1); q[33] = cvt_pk_bf16(R.v0[i].y * g0, R.v1[i].y * g1); q[66] = cvt_pk_bf16(R.v0[i].z * g0, R.v1[i].z * g1); q[99] = cvt_pk_bf16(R.v0[i].w * g0, R.v1[i].w * g1); }
    LDS_WAIT(); __builtin_amdgcn_wave_barrier(); asm volatile("" ::: "memory");
    int rbase = d.n0;
    if (d.mode) rbase = ((d.n0 >> 7) << 8) + (d.n0 & 127) + (d.mode == 2 ? 128 : 0);
    const int kc = lane & 7;
#pragma unroll
    for (int j = 0; j < 8; ++j) { const int n = (lane >> 3) + 8 * j; const LAS unsigned* s = scr + n * 33 + 4 * kc;
        u32x4 o; o.x = s[0]; o.y = s[1]; o.z = s[2]; o.w = s[3];
        *(u32x4*)(d.WT + (size_t)(rbase + n) * d.K + d.k0 + 8 * kc) = o; }
    LDS_WAIT(); __builtin_amdgcn_wave_barrier(); asm volatile("" ::: "memory");
}
__device__ __forceinline__ void convert_items(const Params& p, int l, int it0, int it1, int worker, int nw, LAS unsigned char* lds, int wid, int lane) {
    LAS unsigned* scr = (LAS unsigned*)(lds + wid * 16384);
    int it = it0 + worker;
    if (it >= it1) return;
    ItemDesc dA, dB; ItemRegs A, B;
    item_decode(p, l, it, dA); item_load(dA, lane, A);
    for (;;) {
        const int itB = it + nw; const bool hB = itB < it1;
        if (hB) { item_decode(p, l, itB, dB); item_load(dB, lane, B); }
        item_finish(dA, scr, lane, A);
        if (!hB) break;
        const int itA = itB + nw; const bool hA = itA < it1;
        if (hA) { item_decode(p, l, itA, dA); item_load(dA, lane, A); }
        item_finish(dB, scr, lane, B);
        if (!hA) break;
        it = itA;
    }
}
__device__ __forceinline__ void filler(const Params& p, int l, int it0, int it1, int nwg, LAS unsigned char* lds, int wid, int lane) {
    const int G = gridDim.x, r = nwg % G, c = blockIdx.x;
    if (r == 0) convert_items(p, l, it0, it1, c * 8 + wid, G * 8, lds, wid, lane);
    else if (c >= r) convert_items(p, l, it0, it1, (c - r) * 8 + wid, (G - r) * 8, lds, wid, lane);
}

__device__ __forceinline__ void prologue(const Params& p, LAS unsigned char* lds, int wid, int lane) {
    const int gw = blockIdx.x * 8 + wid, NGW = gridDim.x * 8;
    convert_items(p, 0, 0, I_IN, gw, NGW, lds, wid, lane);
    bf16_t* HB = (bf16_t*)(p.ws + WS_HB); float* RS = (float*)(p.ws + WS_RS);
    for (int m = gw; m < MREAL; m += NGW) {
        const float* src;
        if (m < MPROMPT) { const int b = m / LSEQ, t = m % LSEQ; src = t < NMETA ? p.meta + (size_t)t * D : p.x_prompt + ((size_t)b * SEQ + (t - NMETA)) * D; }
        else src = p.x_sample + (size_t)(m - MPROMPT) * D;
        const f32x4* xr = (const f32x4*)src + lane; u32x2* hb = (u32x2*)(HB + (size_t)m * D) + lane;
        float ss = 0.f; f32x4 v[8];
#pragma unroll
        for (int j = 0; j < 8; ++j) { v[j] = xr[64 * j]; ss += (v[j].x * v[j].x + v[j].y * v[j].y) + (v[j].z * v[j].z + v[j].w * v[j].w); }
        ss = wave_sum(ss);
        const float r = 1.f / sqrtf(ss * (1.f / D) + RMS_EPS);
#pragma unroll
        for (int j = 0; j < 8; ++j) { u32x2 w; w.x = cvt_pk_bf16(v[j].x * r, v[j].y * r); w.y = cvt_pk_bf16(v[j].z * r, v[j].w * r); hb[64 * j] = w; }
        if (lane == 0) RS[m] = r;
    }
}

template <int PP> __device__ __forceinline__ void postnorm_row(const Params& p, const float* __restrict__ g, bool last, int m, int lane, bool dry) {
    bf16_t* HB = (bf16_t*)(p.ws + WS_HB); float* RS = (float*)(p.ws + WS_RS); const bf16_t* MIXB = (const bf16_t*)(p.ws + WS_MIXB); const bf16_t* MIXB1 = (const bf16_t*)(p.ws + WS_MIXB1);
    const u32x2* mr = (const u32x2*)(MIXB + (size_t)m * D) + lane; const u32x2* mr1 = (const u32x2*)(MIXB1 + (size_t)m * D) + lane;
    u32x2* hb = (u32x2*)(HB + (size_t)m * D) + lane; const f32x4* gr = (const f32x4*)g + lane;
    const int pmrow = m >> 8;
    u32x2 w0[8], w1[8], hw[8]; f32x4 gv[8];
#pragma unroll
    for (int j = 0; j < 8; ++j) { w0[j] = mr[64 * j]; w1[j] = mr1[64 * j]; hw[j] = hb[64 * j]; }
#pragma unroll
    for (int j = 0; j < 8; ++j) gv[j] = gr[64 * j];
    f32x4 mv[8]; float ss = 0.f;
#pragma unroll
    for (int j = 0; j < 8; ++j) { mv[j] = (f32x4){bf_lo(w0[j].x), bf_hi(w0[j].x), bf_lo(w0[j].y), bf_hi(w0[j].y)};
        if (pg8::StreamKOrder<PP>::is_split(j * (MP / 256) + pmrow, (int)gridDim.x)) mv[j] += (f32x4){bf_lo(w1[j].x), bf_hi(w1[j].x), bf_lo(w1[j].y), bf_hi(w1[j].y)};
        ss += (mv[j].x * mv[j].x + mv[j].y * mv[j].y) + (mv[j].z * mv[j].z + mv[j].w * mv[j].w); }
    ss = wave_sum(ss);
    const float r = 1.f / sqrtf(ss * (1.f / D) + RMS_EPS);
    float* yrow = nullptr;
    if (last) { if (m < MPROMPT) { const int b = m / LSEQ, t = m % LSEQ; if (t >= NMETA) yrow = p.out + O_YP + ((size_t)b * SEQ + (t - NMETA)) * D; } else yrow = p.out + O_YS + (size_t)(m - MPROMPT) * D; }
    const float rinv = 1.f / RS[m];
    float s2 = 0.f; f32x4 hn[8];
#pragma unroll
    for (int j = 0; j < 8; ++j) {
        const f32x4 hv = (f32x4){bf_lo(hw[j].x), bf_hi(hw[j].x), bf_lo(hw[j].y), bf_hi(hw[j].y)};
        hn[j] = hv * rinv + mv[j] * r * gv[j];
        s2 += (hn[j].x * hn[j].x + hn[j].y * hn[j].y) + (hn[j].z * hn[j].z + hn[j].w * hn[j].w);
        if (yrow) ((f32x4*)yrow)[lane + 64 * j] = hn[j];
    }
    s2 = wave_sum(s2);
    const float rn = 1.f / sqrtf(s2 * (1.f / D) + RMS_EPS);
#pragma unroll
    for (int j = 0; j < 8; ++j) { u32x2 w; w.x = cvt_pk_bf16(hn[j].x * rn, hn[j].y * rn); w.y = cvt_pk_bf16(hn[j].z * rn, hn[j].w * rn); (dry ? (u32x2*)(p.ws + WS_ZACT) + (size_t)m * (D / 4) + lane : hb)[64 * j] = w; }
    if (lane == 0 && !dry) RS[m] = rn;
}
struct Pn2Regs { u32x2 hw[2][8]; f32x4 gv[8]; float rs[2]; };
__device__ __forceinline__ void pn2_load_h(const Params& p, const float* __restrict__ g, int m0, int lane, Pn2Regs& R) {
    const bf16_t* HB = (const bf16_t*)(p.ws + WS_HB); const float* RS = (const float*)(p.ws + WS_RS);
    const f32x4* gr = (const f32x4*)g + lane;
#pragma unroll
    for (int e = 0; e < 2; ++e) { const u32x2* hb = (const u32x2*)(HB + (size_t)(m0 + e) * D) + lane;
#pragma unroll
        for (int j = 0; j < 8; ++j) R.hw[e][j] = hb[64 * j];
        R.rs[e] = RS[m0 + e]; }
#pragma unroll
    for (int j = 0; j < 8; ++j) R.gv[j] = gr[64 * j];
}
template <int PP> __device__ __forceinline__ void pn2_finish(const Params& p, bool last, int m0, int lane, const Pn2Regs& R) {
    bf16_t* HB = (bf16_t*)(p.ws + WS_HB); float* RS = (float*)(p.ws + WS_RS); const bf16_t* MIXB = (const bf16_t*)(p.ws + WS_MIXB); const bf16_t* MIXB1 = (const bf16_t*)(p.ws + WS_MIXB1);
    const int pmrow = m0 >> 8;
    u32x2 w0[2][8], w1[2][8];
#pragma unroll
    for (int e = 0; e < 2; ++e) {
        const u32x2* mr = (const u32x2*)(MIXB + (size_t)(m0 + e) * D) + lane; const u32x2* mr1 = (const u32x2*)(MIXB1 + (size_t)(m0 + e) * D) + lane;
#pragma unroll
        for (int j = 0; j < 8; ++j) { w0[e][j] = mr[64 * j]; w1[e][j] = mr1[64 * j]; }
    }
#pragma unroll
    for (int e = 0; e < 2; ++e) {
        const int m = m0 + e;
        f32x4 mv[8]; float ss = 0.f;
#pragma unroll
        for (int j = 0; j < 8; ++j) { mv[j] = (f32x4){bf_lo(w0[e][j].x), bf_hi(w0[e][j].x), bf_lo(w0[e][j].y), bf_hi(w0[e][j].y)};
            if (pg8::StreamKOrder<PP>::is_split(j * (MP / 256) + pmrow, (int)gridDim.x)) mv[j] += (f32x4){bf_lo(w1[e][j].x), bf_hi(w1[e][j].x), bf_lo(w1[e][j].y), bf_hi(w1[e][j].y)};
            ss += (mv[j].x * mv[j].x + mv[j].y * mv[j].y) + (mv[j].z * mv[j].z + mv[j].w * mv[j].w); }
        ss = wave_sum(ss);
        const float r = 1.f / sqrtf(ss * (1.f / D) + RMS_EPS);
        float* yrow = nullptr;
        if (last) { if (m < MPROMPT) { const int b = m / LSEQ, t = m % LSEQ; if (t >= NMETA) yrow = p.out + O_YP + ((size_t)b * SEQ + (t - NMETA)) * D; } else yrow = p.out + O_YS + (size_t)(m - MPROMPT) * D; }
        u32x2* hbw = (u32x2*)(HB + (size_t)m * D) + lane;
        const float rinv = 1.f / R.rs[e];
        float s2 = 0.f; f32x4 hn[8];
#pragma unroll
        for (int j = 0; j < 8; ++j) {
            const f32x4 hv = (f32x4){bf_lo(R.hw[e][j].x), bf_hi(R.hw[e][j].x), bf_lo(R.hw[e][j].y), bf_hi(R.hw[e][j].y)};
            hn[j] = hv * rinv + mv[j] * r * R.gv[j];
            s2 += (hn[j].x * hn[j].x + hn[j].y * hn[j].y) + (hn[j].z * hn[j].z + hn[j].w * hn[j].w);
            if (yrow) ((f32x4*)yrow)[lane + 64 * j] = hn[j];
        }
        s2 = wave_sum(s2);
        const float rn = 1.f / sqrtf(s2 * (1.f / D) + RMS_EPS);
        if (!last) {
#pragma unroll
            for (int j = 0; j < 8; ++j) { u32x2 w; w.x = cvt_pk_bf16(hn[j].x * rn, hn[j].y * rn); w.y = cvt_pk_bf16(hn[j].z * rn, hn[j].w * rn); hbw[64 * j] = w; }
            if (lane == 0) RS[m] = rn;
        }
    }
}
template <int PP> __device__ __forceinline__ void postnorm(const Params& p, const float* __restrict__ g, bool last, int wid, int lane, bool dry = false) {
    const int gw = blockIdx.x * 8 + wid, NGW = gridDim.x * 8;
    for (int m = gw; m < MREAL; m += NGW) postnorm_row<PP>(p, g, last, m, lane, dry);
}
template <int PP> __device__ __forceinline__ void sk_postnorm(const Params& p, const pg8::StreamKOrder<PP>& S, unsigned* cnt, const float* __restrict__ g, bool last, int vcu, int tid, int wid, int lane, unsigned long long& tacc_, unsigned long long& t0_) {
    const int G = gridDim.x, gwv = vcu * 8 + wid, NGW = G * 8;
    constexpr int NMAIN = 8192 / 32;
    TB(11);
    asm volatile("s_waitcnt vmcnt(0)" ::: "memory");
    __syncthreads();
    TE(11);
    Pn2Regs R0;
    const int mfirst = 32 * (vcu < NMAIN ? vcu : 0) + 4 * wid;
    pn2_load_h(p, g, mfirst, lane, R0);
    TB(12);
    if (tid == 0) {
#if !WT_SK
        __builtin_amdgcn_fence(__ATOMIC_RELEASE, "agent");
        asm volatile("s_waitcnt vmcnt(0)" ::: "memory");
#endif
        pg8::Unit u; for (int i = 0; S.next(i, u); ++i) (void)xb_add(cnt + 16 * u.pm, 1u);
        for (int c = vcu; c < NMAIN + 1; c += G) {
            int pm = c >> 3;
            if (c >= NMAIN) break;
            unsigned want = 0; for (int j = 0; j < 8; ++j) want += 1u + (pg8::StreamKOrder<PP>::is_split(j * (MP / 256) + pm, G) ? 1u : 0u);
            unsigned sp = 0; while (xb_ld(cnt + 16 * pm) < want) { __builtin_amdgcn_s_sleep(1); if (++sp > (1u << 22)) break; }
        }
        if (vcu * 8 < MREAL - 8192) {
            unsigned want = 0; for (int j = 0; j < 8; ++j) want += 1u + (pg8::StreamKOrder<PP>::is_split(j * (MP / 256) + 32, G) ? 1u : 0u);
            unsigned sp = 0; while (xb_ld(cnt + 16 * 32) < want) { __builtin_amdgcn_s_sleep(1); if (++sp > (1u << 22)) break; }
        }
        __builtin_amdgcn_fence(__ATOMIC_ACQUIRE, "agent");
        asm volatile("s_waitcnt vmcnt(0)" ::: "memory");
    }
    __syncthreads();
    TE(12);
    TB(13);
    if (vcu < NMAIN) {
        pn2_finish<PP>(p, last, mfirst, lane, R0);
        { Pn2Regs R1; pn2_load_h(p, g, mfirst + 2, lane, R1); pn2_finish<PP>(p, last, mfirst + 2, lane, R1); }
    }
    for (int c = vcu + G; c < NMAIN; c += G)
        for (int i = 0; i < 4; i += 2) { Pn2Regs R1; pn2_load_h(p, g, 32 * c + 4 * wid + i, lane, R1); pn2_finish<PP>(p, last, 32 * c + 4 * wid + i, lane, R1); }
    for (int i = gwv; i < MREAL - 8192; i += NGW) postnorm_row<PP>(p, g, last, 8192 + i, lane, false);
    TE(13);
}

constexpr int AT_QT = 128, AT_NT = 4, AT_KR = 304, AT_KS = 72, AT_VS = 312, AT_PS = 168;
constexpr int AT_K_OFF = 0, AT_V_OFF = AT_KR * AT_KS * 2  , AT_P_OFF = AT_V_OFF + 64 * AT_VS * 2  , AT_P_WAVE = 16 * AT_PS * 2  ;
static_assert(AT_P_OFF + 8 * AT_P_WAVE <= RING_BYTES && (AT_V_OFF % 16) == 0 && (AT_P_OFF % 16) == 0, "attention LDS map");

__device__ __forceinline__ void attn_prompt_unit(LAS unsigned char* lds, int b, int kvh, int qt, const bf16_t* __restrict__ z, bf16_t* mixin, const float* __restrict__ sinks, int tid, int wid, int lane) {
    LAS bf16_t* Ks = (LAS bf16_t*)(lds + AT_K_OFF);
    LAS bf16_t* Vt = (LAS bf16_t*)(lds + AT_V_OFF);
    LAS bf16_t* Pw = (LAS bf16_t*)(lds + AT_P_OFF + wid * AT_P_WAVE);
    const LAS float* biasL = (const LAS float*)(lds + BIAS_OFF);
    const int q0 = qt * AT_QT, rowb = b * LSEQ;
    const int h = kvh * 4 + (wid & 3), i16 = lane & 15, g = lane >> 4;
    const int ntile = AT_NT + ((qt == 15 && (wid >> 2) == 0) ? 1 : 0);
    bf16x8 qf[AT_NT + 1][2];
#pragma unroll
    for (int tile = 0; tile < AT_NT + 1; ++tile) {
        const int tq0 = tile < AT_NT ? q0 + (wid >> 2) * (AT_QT / 2) + tile * 16 : 2048;
        int tq = tq0 + i16; tq = tq > LSEQ - 1 ? LSEQ - 1 : tq;
        const bf16_t* qp = z + (size_t)(rowb + tq) * INDIM + ZQ + h * 64 + 8 * g;
        if (tile < ntile) { qf[tile][0] = *(const bf16x8*)qp; qf[tile][1] = *(const bf16x8*)(qp + 32); }
        else { qf[tile][0] = (bf16x8){0, 0, 0, 0, 0, 0, 0, 0}; qf[tile][1] = qf[tile][0]; }
    }
    const float sink = sinks[h];
    {
        constexpr int NIT = (AT_KR * 8 + 511) / 512;
        u32x4 kv[NIT], vv[NIT];
#pragma unroll
        for (int it = 0; it < NIT; ++it) {
            const int c = tid + it * 512;
            if (it < NIT - 1 || c < AT_KR * 8) {
                const int kr = c >> 3, ch = c & 7; int t = q0 - 144 + kr; t = t < 0 ? 0 : (t > LSEQ - 1 ? LSEQ - 1 : t);
                const bf16_t* src = z + (size_t)(rowb + t) * INDIM + kvh * 64 + ch * 8;
                kv[it] = *(const u32x4*)(src + ZK); vv[it] = *(const u32x4*)(src + ZV);
            }
        }
#pragma unroll
        for (int it = 0; it < NIT; ++it) {
            const int c = tid + it * 512;
            if (it < NIT - 1 || c < AT_KR * 8) {
                const int kr = c >> 3, ch = c & 7;
                *(LAS u32x4*)(Ks + kr * AT_KS + ch * 8) = kv[it];
                LAS bf16_t* vd = Vt + (ch * 8) * AT_VS + kr;
                vd[0 * AT_VS] = (bf16_t)(vv[it].x & 0xffffu); vd[1 * AT_VS] = (bf16_t)(vv[it].x >> 16);
                vd[2 * AT_VS] = (bf16_t)(vv[it].y & 0xffffu); vd[3 * AT_VS] = (bf16_t)(vv[it].y >> 16);
                vd[4 * AT_VS] = (bf16_t)(vv[it].z & 0xffffu); vd[5 * AT_VS] = (bf16_t)(vv[it].z >> 16);
                vd[6 * AT_VS] = (bf16_t)(vv[it].w & 0xffffu); vd[7 * AT_VS] = (bf16_t)(vv[it].w >> 16);
            }
        }
    }
    __syncthreads();
#pragma unroll
    for (int tile = 0; tile < AT_NT + 1; ++tile) {
        if (tile >= ntile) break;
        const int tq0 = tile < AT_NT ? q0 + (wid >> 2) * (AT_QT / 2) + tile * 16 : 2048;
        const int koff = tq0 - q0;
        const int t = tq0 + i16;
        f32x4 s[10];
#pragma unroll
        for (int nt = 1; nt < 10; ++nt) {
            const LAS bf16_t* kp = Ks + (koff + nt * 16 + i16) * AT_KS + 8 * g;
            const bf16x8 k0 = *(const LAS bf16x8*)kp, k1 = *(const LAS bf16x8*)(kp + 32);
            f32x4 a = (f32x4){0.f, 0.f, 0.f, 0.f};
            a = __builtin_amdgcn_mfma_f32_16x16x32_bf16(k0, qf[tile][0], a, 0, 0, 0);
            a = __builtin_amdgcn_mfma_f32_16x16x32_bf16(k1, qf[tile][1], a, 0, 0, 0);
            s[nt] = a;
        }
        const LAS float* bp = biasL + h * BIAS_STRIDE + BIAS_PAD + 144 + i16 - 4 * g;
        float mx = sink;
        if (tq0 >= 144) {
#pragma unroll
            for (int nt = 1; nt < 10; ++nt)
#pragma unroll
                for (int r = 0; r < 4; ++r) { const float v = s[nt][r] * 0.125f + bp[-(nt * 16 + r)]; s[nt][r] = v; mx = fmaxf(mx, v); }
        } else {
#pragma unroll
            for (int nt = 1; nt < 10; ++nt)
#pragma unroll
                for (int r = 0; r < 4; ++r) { const int tk = tq0 - 144 + nt * 16 + 4 * g + r; const float v = tk >= 0 ? s[nt][r] * 0.125f + bp[-(nt * 16 + r)] : -INFINITY; s[nt][r] = v; mx = fmaxf(mx, v); }
        }
        mx = fmaxf(mx, __shfl_xor(mx, 16)); mx = fmaxf(mx, __shfl_xor(mx, 32));
        float sum = 0.f;
        *(LAS u32x2*)(Pw + i16 * AT_PS + 4 * g) = (u32x2){0u, 0u};
#pragma unroll
        for (int nt = 1; nt < 10; ++nt) {
            const float e0 = __expf(s[nt][0] - mx), e1 = __expf(s[nt][1] - mx), e2 = __expf(s[nt][2] - mx), e3 = __expf(s[nt][3] - mx);
            sum += (e0 + e1) + (e2 + e3);
            u32x2 w; w.x = cvt_pk_bf16(e0, e1); w.y = cvt_pk_bf16(e2, e3);
            *(LAS u32x2*)(Pw + i16 * AT_PS + nt * 16 + 4 * g) = w;
        }
        sum += __shfl_xor(sum, 16); sum += __shfl_xor(sum, 32);
        const float inv = 1.f / (sum + __expf(sink - mx));
        LDS_WAIT(); __builtin_amdgcn_wave_barrier();
        f32x4 o[4];
#pragma unroll
        for (int dn = 0; dn < 4; ++dn) o[dn] = (f32x4){0.f, 0.f, 0.f, 0.f};
#pragma unroll
        for (int ks = 0; ks < 5; ++ks) {
            const bf16x8 pf = *(const LAS bf16x8*)(Pw + i16 * AT_PS + ks * 32 + 8 * g);
#pragma unroll
            for (int dn = 0; dn < 4; ++dn) {
                const bf16x8 vf = *(const LAS bf16x8*)(Vt + (dn * 16 + i16) * AT_VS + koff + ks * 32 + 8 * g);
                o[dn] = __builtin_amdgcn_mfma_f32_16x16x32_bf16(vf, pf, o[dn], 0, 0, 0);
            }
        }
        if (t < LSEQ) {
            bf16_t* op = mixin + (size_t)(rowb + t) * D + h * 64 + 4 * g;
#pragma unroll
            for (int dn = 0; dn < 4; ++dn) { u32x2 w; w.x = cvt_pk_bf16(o[dn][0] * inv, o[dn][1] * inv); w.y = cvt_pk_bf16(o[dn][2] * inv, o[dn][3] * inv); *(u32x2*)(op + dn * 16) = w; }
        }
        LDS_WAIT(); __builtin_amdgcn_wave_barrier();
    }
    __syncthreads();
}

__device__ __forceinline__ void attn_sample_wave(LAS unsigned char* lds, int l, int b, int h, const Params& p, const bf16_t* __restrict__ z, bf16_t* mixin, int wid, int lane) {
    LAS float* qs = (LAS float*)(lds + wid * 1024);
    LAS float* ps = qs + 64;
    const LAS float* biasL = (const LAS float*)(lds + BIAS_OFF);
    const int kvh = h >> 2;
    const bf16_t* zr = z + (size_t)(MPROMPT + b) * INDIM;
    const float qv = __uint_as_float((unsigned)zr[ZQ + h * 64 + lane] << 16) * 0.125f;
    qs[lane] = qv;
    LDS_WAIT(); __builtin_amdgcn_wave_barrier();
    const float* ck = p.cache_k + (((size_t)l * DB + b) * WIN) * 256 + kvh * 64;
    const float* cv = p.cache_v + (((size_t)l * DB + b) * WIN) * 256 + kvh * 64;
    float sc0 = 0.f, sc1 = 0.f;
    {
        const f32x4* k0 = (const f32x4*)(ck + (size_t)lane * 256); const f32x4* k1 = (const f32x4*)(ck + (size_t)(lane + 64) * 256);
#pragma unroll
        for (int d4 = 0; d4 < 16; ++d4) { const f32x4 q4 = *(const LAS f32x4*)(qs + 4 * d4); const f32x4 a = k0[d4], c = k1[d4];
            sc0 += (a.x * q4.x + a.y * q4.y) + (a.z * q4.z + a.w * q4.w); sc1 += (c.x * q4.x + c.y * q4.y) + (c.z * q4.z + c.w * q4.w); }
    }
    const float knew = __uint_as_float((unsigned)zr[ZK + kvh * 64 + lane] << 16);
    const float sc2 = wave_sum(qv * knew);
    const float sink = p.sinks[l * NHEADS + h];
    const float v0 = sc0 + biasL[h * BIAS_STRIDE + BIAS_PAD + (WIN - lane)], v1 = sc1 + biasL[h * BIAS_STRIDE + BIAS_PAD + (64 - lane)], v2 = sc2 + biasL[h * BIAS_STRIDE + BIAS_PAD];
    float mx = wave_max(fmaxf(v0, v1)); mx = fmaxf(mx, fmaxf(v2, sink));
    const float e0 = __expf(v0 - mx), e1 = __expf(v1 - mx), e2 = __expf(v2 - mx);
    const float sum = wave_sum(e0 + e1) + e2 + __expf(sink - mx);
    ps[lane] = e0; ps[lane + 64] = e1;
    LDS_WAIT(); __builtin_amdgcn_wave_barrier();
    const int sg = lane >> 4, dq = lane & 15;
    f32x4 oa = (f32x4){0.f, 0.f, 0.f, 0.f}, ob4 = (f32x4){0.f, 0.f, 0.f, 0.f};
#pragma unroll
    for (int it = 0; it < 2; ++it) {
        f32x4 vr[16];
#pragma unroll
        for (int i = 0; i < 16; ++i) vr[i] = *(const f32x4*)(cv + (size_t)(sg + 4 * (i + 16 * it)) * 256 + 4 * dq);
#pragma unroll
        for (int i = 0; i < 16; i += 2) { oa += vr[i] * ps[sg + 4 * (i + 16 * it)]; ob4 += vr[i + 1] * ps[sg + 4 * (i + 1 + 16 * it)]; }
    }
    oa += ob4;
#pragma unroll
    for (int c = 0; c < 4; ++c) { oa[c] += __shfl_xor(oa[c], 16); oa[c] += __shfl_xor(oa[c], 32); }
    if (sg == 0) {
        const u32x2 vn = *(const u32x2*)(zr + ZV + kvh * 64 + 4 * dq);
        const float rs_ = 1.f / sum;
        const float o0 = (oa[0] + e2 * bf_lo(vn.x)) * rs_, o1 = (oa[1] + e2 * bf_hi(vn.x)) * rs_, o2 = (oa[2] + e2 * bf_lo(vn.y)) * rs_, o3 = (oa[3] + e2 * bf_hi(vn.y)) * rs_;
        u32x2 w; w.x = cvt_pk_bf16(o0, o1); w.y = cvt_pk_bf16(o2, o3);
        *(u32x2*)(mixin + (size_t)(MPROMPT + b) * D + h * 64 + 4 * dq) = w;
    }
    LDS_WAIT(); __builtin_amdgcn_wave_barrier();
}

__device__ __forceinline__ void unpack8(const u32x4 a, float (&o)[8]) { o[0] = bf_lo(a.x); o[1] = bf_hi(a.x); o[2] = bf_lo(a.y); o[3] = bf_hi(a.y); o[4] = bf_lo(a.z); o[5] = bf_hi(a.z); o[6] = bf_lo(a.w); o[7] = bf_hi(a.w); }
__device__ __forceinline__ void conv_row(int l, int m, const Params& p, const bf16_t* __restrict__ z, bf16_t* mixin, int lane) {
    const float* cw = p.conv_w + (size_t)l * 3 * CDIM;
    const bool prompt = m < MPROMPT;
    const int b = prompt ? m / LSEQ : m - MPROMPT, t = prompt ? m % LSEQ : 0;
    const bf16_t* zr = z + (size_t)m * INDIM;
    const bf16_t* z1 = (prompt && t >= 1) ? zr - INDIM : zr;
    const bf16_t* z2 = (prompt && t >= 2) ? zr - 2 * INDIM : zr;
    const float k1 = (prompt && t >= 1) ? 1.f : 0.f, k2 = (prompt && t >= 2) ? 1.f : 0.f;
    const float* st = p.state_conv + (((size_t)l * DB + (prompt ? 0 : b)) * 2) * CDIM;
    u32x4 gbv[2], gcv[2], hcv[2], a1[2], c1[2], a2[2], c2[2]; f32x4 sv[2][4], wv[2][6];
#pragma unroll
    for (int j = 0; j < 2; ++j) {
        const int c0 = lane * 8 + 512 * j;
        gbv[j] = *(const u32x4*)(zr + ZGB + c0); gcv[j] = *(const u32x4*)(zr + ZGC + c0); hcv[j] = *(const u32x4*)(zr + ZHC + c0);
        a1[j] = *(const u32x4*)(z1 + ZGC + c0); c1[j] = *(const u32x4*)(z1 + ZHC + c0); a2[j] = *(const u32x4*)(z2 + ZGC + c0); c2[j] = *(const u32x4*)(z2 + ZHC + c0);
        if (!prompt) { sv[j][0] = *(const f32x4*)(st + c0); sv[j][1] = *(const f32x4*)(st + c0 + 4); sv[j][2] = *(const f32x4*)(st + CDIM + c0); sv[j][3] = *(const f32x4*)(st + CDIM + c0 + 4); }
#pragma unroll
        for (int i = 0; i < 3; ++i) { wv[j][2 * i] = *(const f32x4*)(cw + i * CDIM + c0); wv[j][2 * i + 1] = *(const f32x4*)(cw + i * CDIM + c0 + 4); }
    }
#pragma unroll
    for (int j = 0; j < 2; ++j) {
        const int c0 = lane * 8 + 512 * j;
        float gb[8], gc[8], hc[8], u0[8], u1[8], u2[8], x[8], y[8];
        unpack8(gbv[j], gb); unpack8(gcv[j], gc); unpack8(hcv[j], hc);
#pragma unroll
        for (int i = 0; i < 8; ++i) u0[i] = gc[i] * hc[i];
        if (prompt) {
            unpack8(a1[j], x); unpack8(c1[j], y);
#pragma unroll
            for (int i = 0; i < 8; ++i) u1[i] = x[i] * y[i] * k1;
            unpack8(a2[j], x); unpack8(c2[j], y);
#pragma unroll
            for (int i = 0; i < 8; ++i) u2[i] = x[i] * y[i] * k2;
            if (t >= LSEQ - 2) { float* co = p.out + O_CP + (((size_t)l * NBATCH + b) * 2 + (t - (LSEQ - 2))) * CDIM + c0;
                *(f32x4*)co = (f32x4){u0[0], u0[1], u0[2], u0[3]}; *(f32x4*)(co + 4) = (f32x4){u0[4], u0[5], u0[6], u0[7]}; }
        } else {
#pragma unroll
            for (int i = 0; i < 4; ++i) { u2[i] = sv[j][0][i]; u2[4 + i] = sv[j][1][i]; u1[i] = sv[j][2][i]; u1[4 + i] = sv[j][3][i]; }
            float* co = p.out + O_CS + (((size_t)l * DB + b) * 2) * CDIM + c0;
            *(f32x4*)co = sv[j][2]; *(f32x4*)(co + 4) = sv[j][3];
            *(f32x4*)(co + CDIM) = (f32x4){u0[0], u0[1], u0[2], u0[3]}; *(f32x4*)(co + CDIM + 4) = (f32x4){u0[4], u0[5], u0[6], u0[7]};
        }
        float r[8];
#pragma unroll
        for (int i = 0; i < 8; ++i) { const float w0 = wv[j][i >> 2][i & 3], w1 = wv[j][2 + (i >> 2)][i & 3], w2 = wv[j][4 + (i >> 2)][i & 3]; r[i] = gb[i] * (w0 * u2[i] + w1 * u1[i] + w2 * u0[i]); }
        u32x4 w; w.x = cvt_pk_bf16(r[0], r[1]); w.y = cvt_pk_bf16(r[2], r[3]); w.z = cvt_pk_bf16(r[4], r[5]); w.w = cvt_pk_bf16(r[6], r[7]);
        *(u32x4*)(mixin + (size_t)m * D + 1024 + c0) = w;
    }
}

__device__ __forceinline__ void conv_job4(int l, int m0, const Params& p, const bf16_t* __restrict__ z, bf16_t* mixin, int lane) {
    const float* cw = p.conv_w + (size_t)l * 3 * CDIM;
    const int b = m0 / LSEQ, t0 = m0 % LSEQ;
    const float kprev = t0 > 0 ? 1.f : 0.f;
    const bf16_t* zr = z + (size_t)m0 * INDIM;
    const bf16_t* zp = t0 > 0 ? zr - 2 * INDIM : zr;
#pragma unroll
    for (int j = 0; j < 2; ++j) {
        const int c0 = lane * 8 + 512 * j;
        u32x4 gcv[6], hcv[6], gbv[4]; f32x4 wv[6];
        gcv[0] = *(const u32x4*)(zp + ZGC + c0); hcv[0] = *(const u32x4*)(zp + ZHC + c0);
        gcv[1] = *(const u32x4*)(zp + INDIM + ZGC + c0); hcv[1] = *(const u32x4*)(zp + INDIM + ZHC + c0);
#pragma unroll
        for (int r = 0; r < 4; ++r) { gcv[2 + r] = *(const u32x4*)(zr + (size_t)r * INDIM + ZGC + c0); hcv[2 + r] = *(const u32x4*)(zr + (size_t)r * INDIM + ZHC + c0); gbv[r] = *(const u32x4*)(zr + (size_t)r * INDIM + ZGB + c0); }
#pragma unroll
        for (int i = 0; i < 3; ++i) { wv[2 * i] = *(const f32x4*)(cw + i * CDIM + c0); wv[2 * i + 1] = *(const f32x4*)(cw + i * CDIM + c0 + 4); }
        float u[6][8];
#pragma unroll
        for (int r = 0; r < 6; ++r) { float x[8], y[8]; unpack8(gcv[r], x); unpack8(hcv[r], y); const float k = r < 2 ? kprev : 1.f;
#pragma unroll
            for (int i = 0; i < 8; ++i) u[r][i] = x[i] * y[i] * k; }
#pragma unroll
        for (int r = 0; r < 4; ++r) {
            float gb[8], o[8]; unpack8(gbv[r], gb);
#pragma unroll
            for (int i = 0; i < 8; ++i) { const float w0 = wv[i >> 2][i & 3], w1 = wv[2 + (i >> 2)][i & 3], w2 = wv[4 + (i >> 2)][i & 3]; o[i] = gb[i] * (w0 * u[r][i] + w1 * u[r + 1][i] + w2 * u[r + 2][i]); }
            u32x4 w; w.x = cvt_pk_bf16(o[0], o[1]); w.y = cvt_pk_bf16(o[2], o[3]); w.z = cvt_pk_bf16(o[4], o[5]); w.w = cvt_pk_bf16(o[6], o[7]);
            *(u32x4*)(mixin + (size_t)(m0 + r) * D + 1024 + c0) = w;
        }
        if (t0 == LSEQ - 4) {
#pragma unroll
            for (int r = 0; r < 2; ++r) { float* co = p.out + O_CP + (((size_t)l * NBATCH + b) * 2 + r) * CDIM + c0;
                *(f32x4*)co = (f32x4){u[4 + r][0], u[4 + r][1], u[4 + r][2], u[4 + r][3]}; *(f32x4*)(co + 4) = (f32x4){u[4 + r][4], u[4 + r][5], u[4 + r][6], u[4 + r][7]}; }
        }
    }
}

__device__ __forceinline__ void kv_prompt_row(int l, int idx, const Params& p, const bf16_t* __restrict__ z, int lane) {
    const int b = idx >> 7, w = idx & 127;
    const bf16_t* zr = z + (size_t)(b * LSEQ + (LSEQ - WIN) + w) * INDIM;
    const u32x2 kv = *(const u32x2*)(zr + ZK + 4 * lane), vv = *(const u32x2*)(zr + ZV + 4 * lane);
    const size_t o = (((size_t)l * NBATCH + b) * WIN + w) * 256 + 4 * lane;
    *(f32x4*)(p.out + O_KP + o) = (f32x4){bf_lo(kv.x), bf_hi(kv.x), bf_lo(kv.y), bf_hi(kv.y)};
    *(f32x4*)(p.out + O_VP + o) = (f32x4){bf_lo(vv.x), bf_hi(vv.x), bf_lo(vv.y), bf_hi(vv.y)};
}
__device__ __forceinline__ void kv_sample_row(int l, int idx, const Params& p, const bf16_t* __restrict__ z, int lane) {
    const int b = idx >> 7, w = idx & 127;
    const size_t o = (((size_t)l * DB + b) * WIN + w) * 256 + 4 * lane;
    f32x4 kq, vq;
    if (w < WIN - 1) { kq = *(const f32x4*)(p.cache_k + o + 256); vq = *(const f32x4*)(p.cache_v + o + 256); }
    else { const bf16_t* zr = z + (size_t)(MPROMPT + b) * INDIM; const u32x2 kv = *(const u32x2*)(zr + ZK + 4 * lane), vv = *(const u32x2*)(zr + ZV + 4 * lane);
        kq = (f32x4){bf_lo(kv.x), bf_hi(kv.x), bf_lo(kv.y), bf_hi(kv.y)}; vq = (f32x4){bf_lo(vv.x), bf_hi(vv.x), bf_lo(vv.y), bf_hi(vv.y)}; }
    *(f32x4*)(p.out + O_KS + o) = kq; *(f32x4*)(p.out + O_VS + o) = vq;
}

__device__ __forceinline__ void kv_sample_row2(int l, int i0, int i1, const Params& p, const bf16_t* __restrict__ z, int lane) {
    f32x4 kq[2], vq[2]; size_t o[2]; const int idx[2] = {i0, i1};
#pragma unroll
    for (int e = 0; e < 2; ++e) {
        const int b = idx[e] >> 7, w = idx[e] & 127;
        o[e] = (((size_t)l * DB + b) * WIN + w) * 256 + 4 * lane;
        if (w < WIN - 1) { kq[e] = *(const f32x4*)(p.cache_k + o[e] + 256); vq[e] = *(const f32x4*)(p.cache_v + o[e] + 256); }
        else { const bf16_t* zr = z + (size_t)(MPROMPT + b) * INDIM; const u32x2 kv = *(const u32x2*)(zr + ZK + 4 * lane), vv = *(const u32x2*)(zr + ZV + 4 * lane);
            kq[e] = (f32x4){bf_lo(kv.x), bf_hi(kv.x), bf_lo(kv.y), bf_hi(kv.y)}; vq[e] = (f32x4){bf_lo(vv.x), bf_hi(vv.x), bf_lo(vv.y), bf_hi(vv.y)}; }
    }
#pragma unroll
    for (int e = 0; e < 2; ++e) { *(f32x4*)(p.out + O_KS + o[e]) = kq[e]; *(f32x4*)(p.out + O_VS + o[e]) = vq[e]; }
}

__device__ __forceinline__ void filler_cache_copy(const Params& p, int l, int nwg, int wid, int lane) {
    const int G = gridDim.x, r = nwg % G, c = blockIdx.x;
    int worker, nw;
    if (r == 0) { worker = c * 8 + wid; nw = G * 8; } else if (c >= r) { worker = (c - r) * 8 + wid; nw = (G - r) * 8; } else return;
    for (int i = worker; i < DB * WIN / 2; i += nw) {
        const int i1 = i + DB * WIN / 2;
        if ((i & 127) != 127) kv_sample_row2(l, i, i1, p, (const bf16_t*)(p.ws + WS_ZACT), lane);
    }
}

constexpr int NU_ATT = NBATCH * 4 * 16;

__device__ __forceinline__ void mixer_phase(const Params& p, int l, LAS unsigned char* lds, int tid, int wid, int lane, unsigned long long& tacc_, unsigned long long& t0_) {
    const bf16_t* z = (const bf16_t*)(p.ws + WS_ZACT); bf16_t* mixin = (bf16_t*)(p.ws + WS_MIXIN);
    TB(9);
    for (int u = blockIdx.x; u < NU_ATT; u += gridDim.x) { const int qt = u & 15, bk = u >> 4; attn_prompt_unit(lds, bk >> 2, bk & 3, qt, z, mixin, p.sinks + l * NHEADS, tid, wid, lane); }
    TE(9);
    TB(10);
    const int gw = blockIdx.x * 8 + wid, NGW = gridDim.x * 8;
    if (gw < MPROMPT / 4) conv_job4(l, 4 * gw, p, z, mixin, lane);
    for (int j = NGW + (gw >> 7); j < MPROMPT / 4 && (gw & 127) == 5; j += NGW >> 7) conv_job4(l, 4 * j, p, z, mixin, lane);
    if ((gw & 63) == 33 && (gw >> 6) < DB) conv_row(l, MPROMPT + (gw >> 6), p, z, mixin, lane);
    if ((gw & 3) == 0 && (gw >> 2) < DB * NHEADS) { const int job = gw >> 2; attn_sample_wave(lds, l, job >> 4, job & 15, p, z, mixin, wid, lane); }
    for (int i = (int)NGW - 1 - gw; i < NBATCH * WIN; i += NGW) kv_prompt_row(l, i, p, z, lane);
    if ((gw & 63) == 34 && (gw >> 6) < DB) kv_sample_row(l, (gw >> 6) * WIN + (WIN - 1), p, z, lane);
    TE(10);
}

__global__ void __launch_bounds__(512, 2) hymba_fwd(Params p) {
    extern __shared__ __attribute__((aligned(16))) unsigned char lds_raw[];
    LAS unsigned char* lds = (LAS unsigned char*)lds_raw;
    cg::grid_group grid = cg::this_grid();
    const int tid = threadIdx.x, lane = tid & 63, wid = __builtin_amdgcn_readfirstlane(tid >> 6);

    unsigned* barw = (unsigned*)(p.ws + WS_BAR);
    unsigned* cntw = (unsigned*)(p.ws + WS_CNT);
    volatile LAS unsigned* xst = (volatile LAS unsigned*)(lds + MISC_OFF);
    if (tid < 2) xst[tid] = 0u;
    __syncthreads();
    const XcdBarrier xb = xcd_barrier_post(barw, xst);
    {
        LAS float* biasL = (LAS float*)(lds + BIAS_OFF);
        for (int i = tid; i < NHEADS * BIAS_STRIDE; i += 512) {
            const int h = i / BIAS_STRIDE, d = i % BIAS_STRIDE - BIAS_PAD;
            float v = -INFINITY;
            if (d >= 0 && d <= WIN) {
                int bkt;
                if (d < 16) bkt = d;
                else { const float df = (float)d; bkt = 16 + (int)(logf(df / 16.f) / logf(8.f) * 16.f); bkt = bkt > 31 ? 31 : bkt; }
                v = p.rel_bias[bkt * NHEADS + h];
            }
            biasL[i] = v;
        }
    }
    unsigned long long tacc_ = 0, t0_ = 0;
    TB(0);
    for (int rep = 0; rep < REP_PRO; ++rep) prologue(p, lds, wid, lane);
    TE(0);
    if (p.ws == nullptr) grid.sync();
    GSYNC();

    bf16_t* ZACT = (bf16_t*)(p.ws + WS_ZACT); bf16_t* MIXIN = (bf16_t*)(p.ws + WS_MIXIN); bf16_t* MIXB = (bf16_t*)(p.ws + WS_MIXB); bf16_t* MIXB1 = (bf16_t*)(p.ws + WS_MIXB1);
    const int vcu = (gridDim.x % 8 == 0) ? (int)((blockIdx.x % 8) * (gridDim.x / 8) + blockIdx.x / 8) : (int)blockIdx.x;
    const int skw = (gridDim.x == 256) ? ((vcu & 7) * 32 + (vcu >> 5) * 4 + ((vcu & 31) >> 3)) : vcu;
    const bf16_t* HB = (const bf16_t*)(p.ws + WS_HB); const float* RS = (const float*)(p.ws + WS_RS);
#pragma unroll 1
    for (int l = 0; l < DEPTH; ++l) {
        TB(1);
        {
            pg8::Gemm g{HB, (const bf16_t*)(p.ws + WS_WIN + l * SZ_WIN), MP, INDIM, D}; pg8::Epi<0> E{ZACT, INDIM, RS, ZACT};
            pg8::StaticOrder S; S.init(MP, INDIM, D, (int)gridDim.x, (int)blockIdx.x);
            for (int rep = 0; rep < REP_GIN; ++rep) pg8::gemm_phase<D, pg8::Epi<0>, pg8::StaticOrder>(lds, g, S, E);
            for (int rep = 0; rep < REP_FILL; ++rep) { int t2 = threadIdx.x; asm volatile("" : "+v"(t2)); const int w2 = __builtin_amdgcn_readfirstlane(t2 >> 6), l2 = t2 & 63;
                filler(p, l, I_IN, I_LAYER - I_DN, (MP / 256) * (INDIM / 256), lds, w2, l2);
                if (l + 1 < DEPTH) filler(p, l + 1, 0, I_IN / 2, (MP / 256) * (INDIM / 256), lds, w2, l2);
                filler_cache_copy(p, l, (MP / 256) * (INDIM / 256), w2, l2); }
        }
        TE(1);
        GSYNC();
        TB(2);
#ifndef NO_MIX
        for (int rep = 0; rep < REP_MIX; ++rep) { int t2 = threadIdx.x; asm volatile("" : "+v"(t2)); mixer_phase(p, l, lds, t2, __builtin_amdgcn_readfirstlane(t2 >> 6), t2 & 63, tacc_, t0_); }
#endif
        TE(2);
        GSYNC();
        TB(3);
        {
            pg8::Gemm g{MIXIN, (const bf16_t*)(p.ws + WS_WOUT + l * SZ_WOUT), MP, D, D}; pg8::Epi<0> E{MIXB, D, nullptr, MIXB1};
            pg8::StreamKOrder<D / 128> S; S.init((int)gridDim.x, skw);
            for (int rep = 0; rep < REP_GOUT; ++rep) pg8::gemm_phase<D, pg8::Epi<0>, pg8::StreamKOrder<D / 128>>(lds, g, S, E);
            TE(3);
            TB(4);
            { int t2 = threadIdx.x; asm volatile("" : "+v"(t2)); sk_postnorm<D / 128>(p, S, cntw + (size_t)((l * 2 + 0) * 33) * 16, p.n_post_mix + l * D, false, vcu, t2, __builtin_amdgcn_readfirstlane(t2 >> 6), t2 & 63, tacc_, t0_); }
        }
        TE(4);
        GSYNC();
        TB(5);
        {
            pg8::Gemm g{HB, (const bf16_t*)(p.ws + WS_WGU + l * SZ_WGU), MP, NGU, D}; pg8::Epi<1> E{ZACT, DFF, RS, ZACT};
            pg8::StaticOrder S; S.init(MP, NGU, D, (int)gridDim.x, (int)blockIdx.x);
            for (int rep = 0; rep < REP_GGU; ++rep) pg8::gemm_phase<D, pg8::Epi<1>, pg8::StaticOrder>(lds, g, S, E);
            for (int rep = 0; rep < REP_FILL; ++rep) { int t2 = threadIdx.x; asm volatile("" : "+v"(t2)); const int w2 = __builtin_amdgcn_readfirstlane(t2 >> 6), l2 = t2 & 63;
                filler(p, l, I_LAYER - I_DN, I_LAYER, (MP / 256) * (NGU / 256), lds, w2, l2);
                if (l + 1 < DEPTH) filler(p, l + 1, I_IN / 2, I_IN, (MP / 256) * (NGU / 256), lds, w2, l2); }
        }
        TE(5);
        GSYNC();
        TB(6);
        {
            pg8::Gemm g{ZACT, (const bf16_t*)(p.ws + WS_WDN + l * SZ_WDN), MP, D, DFF}; pg8::Epi<0> E{MIXB, D, nullptr, MIXB1};
            pg8::StreamKOrder<DFF / 128> S; S.init((int)gridDim.x, skw);
            for (int rep = 0; rep < REP_GDN; ++rep) pg8::gemm_phase<DFF, pg8::Epi<0>, pg8::StreamKOrder<DFF / 128>>(lds, g, S, E);
            TE(6);
            TB(7);
            { int t2 = threadIdx.x; asm volatile("" : "+v"(t2)); sk_postnorm<DFF / 128>(p, S, cntw + (size_t)((l * 2 + 1) * 33) * 16, p.n_post_ffn + l * D, l == DEPTH - 1, vcu, t2, __builtin_amdgcn_readfirstlane(t2 >> 6), t2 & 63, tacc_, t0_); }
        }
        TE(7);
        if (l != DEPTH - 1) GSYNC();
    }
    if (TMASK != 0 && blockIdx.x == TBLK) { const unsigned long long tend = __builtin_amdgcn_s_memrealtime() + (unsigned long long)TMULT * tacc_; while (__builtin_amdgcn_s_memrealtime() < tend) __builtin_amdgcn_s_sleep(8); }
}

extern "C" void kernel_launch(void* const* d_in, const int* in_sizes, int n_in, void* d_out, int out_size, void* d_ws, size_t ws_size, hipStream_t stream) {
    static int grid_blocks = 0;
    if (grid_blocks == 0) {
        if (n_in != 18 || ws_size < WS_END) { fprintf(stderr, "kernel_launch: unexpected inputs (n_in %d, ws %zu, need %zu)\n", n_in, ws_size, (size_t)WS_END); grid_blocks = -1; return; }
        int dev = 0, cus = 0, per_cu = 0;
        hipGetDevice(&dev);
        hipDeviceGetAttribute(&cus, hipDeviceAttributeMultiprocessorCount, dev);
        hipFuncSetAttribute((const void*)hymba_fwd, hipFuncAttributeMaxDynamicSharedMemorySize, LDS_BYTES);
        hipOccupancyMaxActiveBlocksPerMultiprocessor(&per_cu, (const void*)hymba_fwd, 512, LDS_BYTES);
        if (per_cu < 1) per_cu = 1;
        grid_blocks = cus * per_cu;
    }
    if (grid_blocks < 0) return;
    if (hipMemsetAsync((char*)d_ws + WS_BAR, 0, WS_END - WS_BAR, stream) != hipSuccess) { fprintf(stderr, "kernel_launch: memset of the barrier words failed\n"); return; }
    Params p{};
    const float** pp = (const float**)&p;
    for (int i = 0; i < 18; ++i) pp[i] = (const float*)d_in[i];
    p.out = (float*)d_out; p.ws = (unsigned char*)d_ws;
    void* args[] = {&p};
    hipError_t e = hipLaunchCooperativeKernel((const void*)hymba_fwd, dim3(grid_blocks), dim3(512), args, LDS_BYTES, stream);
    if (e != hipSuccess) fprintf(stderr, "cooperative launch failed: %s (grid %d)\n", hipGetErrorString(e), grid_blocks);
}
```

```cpp
#include <hip/hip_runtime.h>
#include <hip/hip_cooperative_groups.h>
#include <cstdio>
#include <cstdint>
namespace cg = cooperative_groups;
#define REP_PRO 1
#define REP_MIX 1
#define REP_GIN 1
#define REP_GOUT 1
#define REP_GGU 1
#define REP_GDN 1
#define EXTRA_SYNC 0
#define REP_PN 0
#define REP_FILL 1
#define WGM_SET 5
#define TMASK 0
#define TMULT 4
#define TBLK 0
#define TB(k) do { if (TMASK & (1 << (k))) t0_ = __builtin_amdgcn_s_memrealtime(); } while (0)
#define TE(k) do { if (TMASK & (1 << (k))) tacc_ += __builtin_amdgcn_s_memrealtime() - t0_; } while (0)
#define GSYNC() do { TB(8); xcd_barrier(xb); for (int e_ = 0; e_ < EXTRA_SYNC; ++e_) xcd_barrier(xb); TE(8); } while (0)

#define LAS __attribute__((address_space(3)))
typedef unsigned short bf16_t;
typedef short bf16x8 __attribute__((ext_vector_type(8)));
typedef float f32x4 __attribute__((ext_vector_type(4)));
typedef float f32x2 __attribute__((ext_vector_type(2)));
typedef unsigned u32x4 __attribute__((ext_vector_type(4)));
typedef unsigned u32x2 __attribute__((ext_vector_type(2)));

constexpr int D = 2048, NBATCH = 4, SEQ = 2048, NMETA = 16, LSEQ = SEQ + NMETA, DEPTH = 4, DB = 32, WIN = 128;
constexpr int MPROMPT = NBATCH * LSEQ;
constexpr int MREAL = MPROMPT + DB;
constexpr int MP = 8448;
constexpr int INDIM = 4608, DFF = 5632, NGU = 2 * DFF, CDIM = 1024;
constexpr int ZQ = 0, ZK = 1024, ZV = 1280, ZGB = 1536, ZGC = 2560, ZHC = 3584;
constexpr float RMS_EPS = 1e-6f;
constexpr int NHEADS = 16;

constexpr size_t O_YP = 0, O_YS = 16777216, O_KP = 16842752, O_VP = 17367040, O_CP = 17891328, O_KS = 17924096, O_VS = 22118400, O_CS = 26312704;

constexpr size_t SZ_WIN = (size_t)INDIM * D * 2, SZ_WOUT = (size_t)D * D * 2, SZ_WGU = (size_t)NGU * D * 2, SZ_WDN = (size_t)D * DFF * 2;
constexpr size_t WS_WIN = 0;
constexpr size_t WS_WOUT = WS_WIN + DEPTH * SZ_WIN;
constexpr size_t WS_WGU = WS_WOUT + DEPTH * SZ_WOUT;
constexpr size_t WS_WDN = WS_WGU + DEPTH * SZ_WGU;
constexpr size_t WS_ZACT = WS_WDN + DEPTH * SZ_WDN;
constexpr size_t WS_MIXIN = WS_ZACT + (size_t)MP * DFF * 2;
constexpr size_t WS_MIXB = WS_MIXIN + (size_t)MP * D * 2;
constexpr size_t WS_MIXB1 = WS_MIXB + (size_t)MP * D * 2;
constexpr size_t WS_HB = WS_MIXB1 + (size_t)MP * D * 2;
constexpr size_t WS_RS = WS_HB + (size_t)MP * D * 2;
constexpr size_t WS_BAR = WS_RS + (size_t)MP * 4;
constexpr size_t WS_CNT = WS_BAR + 16384;
constexpr size_t WS_END = WS_CNT + (size_t)DEPTH * 2 * 33 * 64;

constexpr int RING_BYTES = 131072, BIAS_OFF = RING_BYTES, LDS_BYTES = 147456;
constexpr int BIAS_STRIDE = 176, BIAS_PAD = 16;
constexpr int MISC_OFF = BIAS_OFF + NHEADS * BIAS_STRIDE * 4;

__device__ __forceinline__ unsigned cvt_pk_bf16(float lo, float hi) { unsigned r; asm volatile("v_cvt_pk_bf16_f32 %0, %1, %2" : "=v"(r) : "v"(lo), "v"(hi)); return r; }
__device__ __forceinline__ float bf_lo(unsigned u) { return __uint_as_float(u << 16); }
__device__ __forceinline__ float bf_hi(unsigned u) { return __uint_as_float(u & 0xffff0000u); }
__device__ __forceinline__ float wave_sum(float v) {
#pragma unroll
    for (int o = 1; o < 64; o <<= 1) v += __shfl_xor(v, o);
    return v;
}
__device__ __forceinline__ float wave_max(float v) {
#pragma unroll
    for (int o = 1; o < 64; o <<= 1) v = fmaxf(v, __shfl_xor(v, o));
    return v;
}
#define LDS_WAIT() asm volatile("s_waitcnt lgkmcnt(0)" ::: "memory")
#define WT_STORES 0
#define WT_SK 1
#define WT_LAST 0
__device__ __forceinline__ void store16_wt(void* p, u32x4 v, bool wt) {
    if (wt) asm volatile("global_store_dwordx4 %0, %1, off sc1\n\ts_nop 1" :: "v"(p), "v"(v) : "memory");
    else *(u32x4*)p = v;
}
__device__ __forceinline__ void store8_wt(void* p, u32x2 v) {
#if WT_STORES
    asm volatile("global_store_dwordx2 %0, %1, off sc1\n\ts_nop 1" :: "v"(p), "v"(v) : "memory");
#else
    *(u32x2*)p = v;
#endif
}


#define XB_TMO      128
#define XB_XCNT(j)  (256  + 64 * (j))
#define XB_XSUB(j)  (1280 + 64 * (j))
#define XB_XGEN(j)  (2304 + 64 * (j))
#define XB_TOP      3328
#define XB_TOPGEN   3392
#define XCD_BAR_WORDS 3456
#define XB_SPIN_CAP (1u << 18)
__device__ __forceinline__ unsigned xb_ld(unsigned* p)              { return __hip_atomic_load(p, __ATOMIC_RELAXED, __HIP_MEMORY_SCOPE_AGENT); }
__device__ __forceinline__ unsigned xb_add(unsigned* p, unsigned v) { return __hip_atomic_fetch_add(p, v, __ATOMIC_RELAXED, __HIP_MEMORY_SCOPE_AGENT); }
__device__ __forceinline__ unsigned xb_xcc_id() { return (unsigned)__builtin_amdgcn_s_getreg((3 << 11) | 20) & 0xFu; }
#define XB_SPIN(cond, bar) do { unsigned _sp = 0; while (cond) { __builtin_amdgcn_s_sleep(1); \
    if ((++_sp & 255u) == 0u) { if (xb_ld(&(bar)[XB_TMO])) break; if (_sp > XB_SPIN_CAP) { atomicAdd(&(bar)[XB_TMO], 1u); break; } } } } while (0)
struct XcdBarrier { unsigned* bar; unsigned x; volatile LAS unsigned* st; };
__device__ __forceinline__ XcdBarrier xcd_barrier_post(unsigned* bar, volatile LAS unsigned* st) {
    XcdBarrier b; b.bar = bar; b.x = xb_xcc_id(); b.st = st;
    if (threadIdx.x == 0) (void)xb_add(&bar[XB_XCNT(b.x)], 1u);
    return b;
}
__device__ __forceinline__ void xcd_barrier_complete(unsigned* bar, unsigned x, unsigned& nloc, unsigned& nx) {
    const unsigned G = gridDim.x * gridDim.y * gridDim.z;
    unsigned sum, cnt, mine, sp = 0u;
    for (;;) {
        sum = 0u; cnt = 0u; mine = 0u;
#pragma unroll
        for (unsigned j = 0; j < 16; ++j) { const unsigned c = xb_ld(&bar[XB_XCNT(j)]); sum += c; cnt += (c > 0u) ? 1u : 0u; mine = (j == x) ? c : mine; }
        if (sum == G) break;
        __builtin_amdgcn_s_sleep(1);
        if ((++sp & 255u) == 0u) { if (xb_ld(&bar[XB_TMO])) break; if (sp > XB_SPIN_CAP) { atomicAdd(&bar[XB_TMO], 1u); break; } }
    }
    nloc = mine > 0u ? mine : 1u; nx = cnt > 0u ? cnt : 1u;
}
__device__ __forceinline__ void xcd_barrier(const XcdBarrier& b) {
    asm volatile("s_waitcnt vmcnt(0)" ::: "memory");
    __syncthreads();
    if (threadIdx.x == 0) {
        unsigned* bar = b.bar;
        __builtin_amdgcn_s_waitcnt(0);
        unsigned nloc = b.st[0], nx = b.st[1];
        if (nloc == 0u) { xcd_barrier_complete(bar, b.x, nloc, nx); b.st[0] = nloc; b.st[1] = nx; }
        const unsigned old = xb_add(&bar[XB_XSUB(b.x)], 1u);
        const unsigned gen = old / nloc;
        if (old + 1u == (gen + 1u) * nloc) {
            __builtin_amdgcn_fence(__ATOMIC_RELEASE, "agent");
            asm volatile("s_waitcnt vmcnt(0)" ::: "memory");
            const unsigned og = xb_add(&bar[XB_TOP], 1u);
            const unsigned tg = og / nx;
            if (og + 1u == (tg + 1u) * nx) xb_add(&bar[XB_TOPGEN], 1u);
            else XB_SPIN(xb_ld(&bar[XB_TOPGEN]) == tg, bar);
            __builtin_amdgcn_fence(__ATOMIC_ACQUIRE, "agent");
            xb_add(&bar[XB_XGEN(b.x)], 1u);
            asm volatile("s_waitcnt vmcnt(0)" ::: "memory");
        } else {
            XB_SPIN(xb_ld(&bar[XB_XGEN(b.x)]) == gen, bar);
            __builtin_amdgcn_fence(__ATOMIC_ACQUIRE, "agent");
            asm volatile("s_waitcnt vmcnt(0)" ::: "memory");
        }
    }
    __syncthreads();
}

namespace pg8 {
constexpr int BM = 256, BK = 64, HALF = 128, HTB = HALF * BK * 2, STAGE_BYTES = 8 * HTB, NXCD = 8, WGM = WGM_SET;
__host__ __device__ __forceinline__ int lds_byte(int r, int c) { const int st = (r >> 4) * 2 + (c >> 5), rr = r & 15, cc = c & 31, ob = rr * 64 + cc * 2; return st * 1024 + (ob ^ (((ob >> 9) & 1) << 5)); }
__host__ __device__ __forceinline__ void stage_rc(int b, int& R, int& C) { const int st = b / 1024, sb = b % 1024, swz = sb ^ (((sb >> 9) & 1) << 5); R = (st >> 1) * 16 + swz / 64; C = (st & 1) * 32 + (swz % 64) / 2; }
__host__ __device__ __forceinline__ int perm32(int rho) { const int n = rho >> 4, i = rho & 15; return 8 * (i >> 2) + 4 * n + (i & 3); }

struct Unit { int pm, pn, kt0, len, part; };
struct Gemm { const bf16_t* A; const bf16_t* Bt; int M, N, K; };

struct StaticOrder {
    static constexpr bool WT_ALL = false;
    int nM, nN, nwg, G, c, nt;
    __host__ __device__ void init(int M, int N, int K, int G_, int c_) { nM = M / BM; nN = N / BM; nwg = nM * nN; G = G_; c = c_; nt = K / BK; }
    __host__ __device__ bool next(int i, Unit& u) const {
        const long L = (long)i * G + c; if (L >= nwg) return false;
        int wgid = (int)L; { const int q = nwg / NXCD, r = nwg % NXCD, xcd = wgid % NXCD, off = wgid / NXCD; wgid = (xcd < r ? xcd * (q + 1) : r * (q + 1) + (xcd - r) * q) + off; }
        const int nig = WGM * nN, gid = wgid / nig, fm = gid * WGM, gsz = (nM - fm) < WGM ? (nM - fm) : WGM;
        u.pm = fm + ((wgid % nig) % gsz); u.pn = (wgid % nig) / gsz; u.kt0 = 0; u.len = nt; u.part = 0; return true;
    }
};
template <int PP> struct StreamKOrder {
    static constexpr bool WT_ALL = (WT_SK != 0);
    static constexpr int NPAN = MP / BM, NTILE = NPAN * 8, TP = NTILE * PP;
    int q0, q1;
    __device__ void init(int G, int v) { q0 = (int)((long)v * TP / G); q1 = (int)((long)(v + 1) * TP / G); }
    __device__ bool next(int i, Unit& u) const {
        const int t = q0 / PP + i, s = t * PP; const int a = q0 > s ? q0 : s, b = q1 < s + PP ? q1 : s + PP;
        if (a >= b) return false;
        u.pn = t / NPAN; u.pm = t % NPAN; u.kt0 = 2 * (a - s); u.len = 2 * (b - a); u.part = a > s ? 1 : 0; return true;
    }
    static __device__ __forceinline__ bool is_split(int t, int G) { const int s = t * PP; return (int)(((long)(s + 1) * G - 1) / TP) != (int)(((long)(s + PP) * G - 1) / TP); }
};

template <int MODE> struct Epi {
    static constexpr bool PERM = true;
    bf16_t* O; int ldc; const float* rs; bf16_t* O1;
    __device__ __forceinline__ void operator()(const f32x4 (&acc)[2][2][4][2], const Unit& u, int wr, int wc, int fr, int fq, bool wt) const {
        const int row0 = u.pm * BM + wr * 64 + fr;
        if constexpr (MODE == 0) {
            const int col0 = u.pn * BM + wc * 32 + 8 * fq;
#pragma unroll
            for (int ai = 0; ai < 2; ++ai)
#pragma unroll
                for (int m = 0; m < 4; ++m) {
                    const int row = row0 + ai * HALF + m * 16;
                    bf16_t* rowp = (u.part ? O1 : O) + (size_t)row * ldc + col0;
#pragma unroll
                    for (int bj = 0; bj < 2; ++bj) {
                        const f32x4 v0 = acc[ai][bj][m][0], v1 = acc[ai][bj][m][1];
                        u32x4 w; w.x = cvt_pk_bf16(v0[0], v0[1]); w.y = cvt_pk_bf16(v0[2], v0[3]); w.z = cvt_pk_bf16(v1[0], v1[1]); w.w = cvt_pk_bf16(v1[2], v1[3]);
                        store16_wt(rowp + bj * HALF, w, wt);
                    }
                }
        } else {
            const int col0 = u.pn * HALF + wc * 32 + 8 * fq;
#pragma unroll
            for (int ai = 0; ai < 2; ++ai)
#pragma unroll
                for (int m = 0; m < 4; ++m) {
                    const int row = row0 + ai * HALF + m * 16;
                    float o[8];
#pragma unroll
                    for (int n = 0; n < 2; ++n)
#pragma unroll
                        for (int j = 0; j < 4; ++j) {
                            const float g = acc[ai][0][m][n][j], up = acc[ai][1][m][n][j];
                            o[n * 4 + j] = (g * up) * __builtin_amdgcn_rcpf(1.f + __builtin_amdgcn_exp2f(g * -1.4426950408889634f));
                        }
                    u32x4 w; w.x = cvt_pk_bf16(o[0], o[1]); w.y = cvt_pk_bf16(o[2], o[3]); w.z = cvt_pk_bf16(o[4], o[5]); w.w = cvt_pk_bf16(o[6], o[7]);
                    store16_wt(O + (size_t)row * ldc + col0, w, wt);
                }
        }
    }
};

template <int K, class EpiT, class Sched>
__device__ __forceinline__ void gemm_phase(LAS unsigned char* lds, const Gemm g, const Sched& S, const EpiT& E) {
    int tid_ = threadIdx.x; asm volatile("" : "+v"(tid_));
    const int tid = tid_, wid = __builtin_amdgcn_readfirstlane(tid >> 6), lane = tid & 63, wr = wid >> 2, wc = wid & 3, fr = lane & 15, fq = lane >> 4;
    unsigned voffA[2], voffB[2];
#pragma unroll
    for (int i = 0; i < 2; ++i) { int R, C; stage_rc(tid * 16 + i * 8192, R, C); const int Rb = EpiT::PERM ? ((R & ~31) + perm32(R & 31)) : R;
        voffA[i] = (unsigned)(R * K + C) * 2u; voffB[i] = (unsigned)(Rb * K + C) * 2u; }
    const size_t kstep = (size_t)(BK * 2);
    const size_t hstep = (size_t)HALF * K * 2;
    const size_t tstep = 2 * hstep;
    const unsigned ldsw = (unsigned)wid * 1024u;
    const int aoff = lds_byte(wr * 64 + fr, fq * 8), boff = lds_byte(wc * 32 + fr, fq * 8);
#define PG8_SA(b, h) (((b) * 2 + (h)) * HTB)
#define PG8_SB(b, h) ((4 + (b) * 2 + (h)) * HTB)
#define PG8_STAGE(bufoff, gbase, voff) do { _Pragma("unroll") for (int _i = 0; _i < 2; ++_i) \
        __builtin_amdgcn_global_load_lds((const unsigned*)((const char*)(gbase) + (voff)[_i]), (LAS unsigned*)(lds + (bufoff) + ldsw + _i * 8192), 16, 0, 0); } while (0)
#define PG8_LDA(dst, b, h) do { _Pragma("unroll") for (int m = 0; m < 4; ++m) _Pragma("unroll") for (int k = 0; k < 2; ++k) dst[m][k] = *(const LAS bf16x8*)(lds + PG8_SA(b, h) + aoff + m * 2048 + k * 1024); } while (0)
#define PG8_LDB(dst, b, h) do { _Pragma("unroll") for (int n = 0; n < 2; ++n) _Pragma("unroll") for (int k = 0; k < 2; ++k) dst[n][k] = *(const LAS bf16x8*)(lds + PG8_SB(b, h) + boff + n * 2048 + k * 1024); } while (0)
#define PG8_MMA(ai, bj, At, Bt) do { __builtin_amdgcn_s_setprio(1); _Pragma("unroll") for (int m = 0; m < 4; ++m) _Pragma("unroll") for (int n = 0; n < 2; ++n) _Pragma("unroll") for (int k = 0; k < 2; ++k) \
        acc[ai][bj][m][n] = __builtin_amdgcn_mfma_f32_16x16x32_bf16(Bt[n][k], At[m][k], acc[ai][bj][m][n], 0, 0, 0); __builtin_amdgcn_s_setprio(0); } while (0)
#define PG8_WAIT_V(n) asm volatile("s_waitcnt vmcnt(" #n ")" ::: "memory")
#define PG8_WAIT_L(n) asm volatile("s_waitcnt lgkmcnt(" #n ")" ::: "memory")
#define PG8_BAR __builtin_amdgcn_s_barrier()
#define PG8_SCHED __builtin_amdgcn_sched_barrier(0)
    Unit cur, nxt; int ui = 0;
    if (!S.next(0, cur)) return;
    f32x4 acc[2][2][4][2];
#pragma unroll
    for (int a = 0; a < 2; ++a)
#pragma unroll
        for (int b = 0; b < 2; ++b)
#pragma unroll
            for (int m = 0; m < 4; ++m)
#pragma unroll
                for (int n = 0; n < 2; ++n) acc[a][b][m][n] = (f32x4){0.f, 0.f, 0.f, 0.f};
    bf16x8 At[4][2], B0[2][2], B1[2][2];
    const char* cA = (const char*)g.A + (size_t)cur.pm * tstep + (size_t)cur.kt0 * kstep; const char* cB = (const char*)g.Bt + (size_t)cur.pn * tstep + (size_t)cur.kt0 * kstep;
    PG8_STAGE(PG8_SB(0, 0), cB, voffB); PG8_STAGE(PG8_SB(0, 1), cB + hstep, voffB); PG8_STAGE(PG8_SA(0, 0), cA, voffA); PG8_STAGE(PG8_SA(0, 1), cA + hstep, voffA);
    if (wr == 1) PG8_BAR;
    PG8_WAIT_V(2); PG8_BAR;
    PG8_STAGE(PG8_SB(1, 0), cB + kstep, voffB); PG8_STAGE(PG8_SA(1, 0), cA + kstep, voffA); PG8_STAGE(PG8_SB(1, 1), cB + hstep + kstep, voffB);
    PG8_WAIT_V(6); PG8_BAR;
    for (;;) {
        const bool has_next = S.next(ui + 1, nxt);
        const char* nA = has_next ? (const char*)g.A + (size_t)nxt.pm * tstep + (size_t)nxt.kt0 * kstep : cA; const char* nB = has_next ? (const char*)g.Bt + (size_t)nxt.pn * tstep + (size_t)nxt.kt0 * kstep : cB;
        const int nt = cur.len;
        for (int t = 0; t < nt; t += 2) {
            const bool last = (t == nt - 2);
            const char* a1 = cA + (size_t)(t + 1) * kstep;
            const char* a2 = last ? nA : cA + (size_t)(t + 2) * kstep; const char* b2 = last ? nB : cB + (size_t)(t + 2) * kstep;
            const char* a3 = a2 + kstep; const char* b3 = b2 + kstep;
            PG8_LDB(B0, 0, 0); PG8_LDB(B1, 0, 1); PG8_SCHED; PG8_LDA(At, 0, 0); PG8_STAGE(PG8_SA(1, 1), a1 + hstep, voffA);
            PG8_WAIT_V(8); PG8_WAIT_L(0); PG8_BAR; PG8_MMA(0, 0, At, B0); PG8_MMA(0, 1, At, B1); PG8_BAR; PG8_SCHED;
            PG8_LDA(At, 0, 1); PG8_STAGE(PG8_SB(0, 0), b2, voffB); PG8_STAGE(PG8_SB(0, 1), b2 + hstep, voffB); PG8_STAGE(PG8_SA(0, 0), a2, voffA);
            PG8_WAIT_V(8); PG8_WAIT_L(0); PG8_BAR; PG8_MMA(1, 0, At, B0); PG8_MMA(1, 1, At, B1); PG8_BAR; PG8_SCHED;
            PG8_LDB(B0, 1, 0); PG8_LDB(B1, 1, 1); PG8_SCHED; PG8_LDA(At, 1, 0); PG8_STAGE(PG8_SA(0, 1), a2 + hstep, voffA);
            PG8_WAIT_V(8); PG8_WAIT_L(0); PG8_BAR; PG8_MMA(0, 0, At, B0); PG8_MMA(0, 1, At, B1); PG8_BAR; PG8_SCHED;
            PG8_LDA(At, 1, 1); PG8_STAGE(PG8_SB(1, 0), b3, voffB); PG8_STAGE(PG8_SB(1, 1), b3 + hstep, voffB); PG8_STAGE(PG8_SA(1, 0), a3, voffA);
            PG8_WAIT_V(8); PG8_WAIT_L(0); PG8_BAR; PG8_MMA(1, 0, At, B0); PG8_MMA(1, 1, At, B1); PG8_BAR; PG8_SCHED;
        }
        if (wr == 0) PG8_BAR;
        E(acc, cur, wr, wc, fr, fq, Sched::WT_ALL ? true : (WT_LAST != 0 && !has_next));
        if (!has_next) break;
#pragma unroll
        for (int a = 0; a < 2; ++a)
#pragma unroll
            for (int b = 0; b < 2; ++b)
#pragma unroll
                for (int m = 0; m < 4; ++m)
#pragma unroll
                    for (int n = 0; n < 2; ++n) acc[a][b][m][n] = (f32x4){0.f, 0.f, 0.f, 0.f};
        cur = nxt; cA = nA; cB = nB; ++ui;
        if (wr == 1) PG8_BAR;
    }
    PG8_WAIT_V(0);
    PG8_BAR;
#undef PG8_SA
#undef PG8_SB
#undef PG8_STAGE
#undef PG8_LDA
#undef PG8_LDB
#undef PG8_MMA
#undef PG8_WAIT_V
#undef PG8_WAIT_L
#undef PG8_BAR
#undef PG8_SCHED
}
}

struct Params {
    const float *x_prompt, *x_sample, *cache_k, *cache_v, *state_conv, *meta, *rel_bias, *w_in, *conv_w, *sinks, *w_out,
        *n_pre_mix, *n_post_mix, *n_pre_ffn, *n_post_ffn, *w_gate, *w_up, *w_down;
    float* out; unsigned char* ws;
};

constexpr int I_IN = (D / 64) * (INDIM / 64), I_OUT = (D / 64) * (D / 64), I_G = (D / 64) * (DFF / 64), I_DN = (DFF / 64) * (D / 64);
constexpr int I_LAYER = I_IN + I_OUT + 2 * I_G + I_DN;
struct ItemDesc { const float* W; const float* gain; bf16_t* WT; int K, N, mode, k0, n0; };
struct ItemRegs { f32x4 v0[8], v1[8]; f32x2 gg[8]; };
__device__ __forceinline__ void item_decode(const Params& p, int l, int it, ItemDesc& d) {
    int r = it;
    if (r < I_IN) { d.W = p.w_in + (size_t)l * D * INDIM; d.K = D; d.N = INDIM; d.WT = (bf16_t*)(p.ws + WS_WIN) + (size_t)l * INDIM * D; d.gain = p.n_pre_mix + l * D; d.mode = 0; }
    else if ((r -= I_IN) < I_OUT) { d.W = p.w_out + (size_t)l * D * D; d.K = D; d.N = D; d.WT = (bf16_t*)(p.ws + WS_WOUT) + (size_t)l * D * D; d.gain = nullptr; d.mode = 0; }
    else if ((r -= I_OUT) < I_G) { d.W = p.w_gate + (size_t)l * D * DFF; d.K = D; d.N = DFF; d.WT = (bf16_t*)(p.ws + WS_WGU) + (size_t)l * NGU * D; d.gain = p.n_pre_ffn + l * D; d.mode = 1; }
    else if ((r -= I_G) < I_G) { d.W = p.w_up + (size_t)l * D * DFF; d.K = D; d.N = DFF; d.WT = (bf16_t*)(p.ws + WS_WGU) + (size_t)l * NGU * D; d.gain = p.n_pre_ffn + l * D; d.mode = 2; }
    else { r -= I_G; d.W = p.w_down + (size_t)l * DFF * D; d.K = DFF; d.N = D; d.WT = (bf16_t*)(p.ws + WS_WDN) + (size_t)l * D * DFF; d.gain = nullptr; d.mode = 0; }
    const int nblk = d.N / 64; d.k0 = 64 * (r / nblk); d.n0 = 64 * (r % nblk);
}
__device__ __forceinline__ void item_load(const ItemDesc& d, int lane, ItemRegs& R) {
    const int c4 = lane & 15, kq = lane >> 4;
#pragma unroll
    for (int i = 0; i < 8; ++i) { const int kp = kq + 4 * i; const float* s = d.W + (size_t)(d.k0 + 2 * kp) * d.N + d.n0 + 4 * c4; R.v0[i] = __builtin_nontemporal_load((const f32x4*)s); R.v1[i] = __builtin_nontemporal_load((const f32x4*)(s + d.N)); }
#pragma unroll
    for (int i = 0; i < 8; ++i) { const int kp = kq + 4 * i; R.gg[i] = d.gain ? *(const f32x2*)(d.gain + d.k0 + 2 * kp) : (f32x2){1.f, 1.f}; }
}
__device__ __forceinline__ void item_finish(const ItemDesc& d, LAS unsigned* scr, int lane, const ItemRegs& R) {
    const int c4 = lane & 15, kq = lane >> 4;
#pragma unroll
    for (int i = 0; i < 8; ++i) { const int kp = kq + 4 * i; const float g0 = R.gg[i].x, g1 = R.gg[i].y;
        LAS unsigned* q = scr + (4 * c4) * 33 + kp;
        q[0] = cvt_pk_bf16(R.v0[i].x * g0, R.v1[i].x * g1); q[33] = cvt_pk_bf16(R.v0[i].y * g0, R.v1[i].y * g1); q[66] = cvt_pk_bf16(R.v0[i].z * g0, R.v1[i].z * g1); q[99] = cvt_pk_bf16(R.v0[i].w * g0, R.v1[i].w * g1); }
    LDS_WAIT(); __builtin_amdgcn_wave_barrier(); asm volatile("" ::: "memory");
    int rbase = d.n0;
    if (d.mode) rbase = ((d.n0 >> 7) << 8) + (d.n0 & 127) + (d.mode == 2 ? 128 : 0);
    const int kc = lane & 7;
#pragma unroll
    for (int j = 0; j < 8; ++j) { const int n = (lane >> 3) + 8 * j; const LAS unsigned* s = scr + n * 33 + 4 * kc;
        u32x4 o; o.x = s[0]; o.y = s[1]; o.z = s[2]; o.w = s[3];
        __builtin_nontemporal_store(o, (u32x4*)(d.WT + (size_t)(rbase + n) * d.K + d.k0 + 8 * kc)); }
    LDS_WAIT(); __builtin_amdgcn_wave_barrier(); asm volatile("" ::: "memory");
}
__device__ __forceinline__ void convert_items(const Params& p, int l, int it0, int it1, int worker, int nw, LAS unsigned char* lds, int wid, int lane) {
    LAS unsigned* scr = (LAS unsigned*)(lds + wid * 16384);
    int it = it0 + worker;
    if (it >= it1) return;
    ItemDesc dA, dB; ItemRegs A, B;
    item_decode(p, l, it, dA); item_load(dA, lane, A);
    for (;;) {
        const int itB = it + nw; const bool hB = itB < it1;
        if (hB) { item_decode(p, l, itB, dB); item_load(dB, lane, B); }
        item_finish(dA, scr, lane, A);
        if (!hB) break;
        const int itA = itB + nw; const bool hA = itA < it1;
        if (hA) { item_decode(p, l, itA, dA); item_load(dA, lane, A); }
        item_finish(dB, scr, lane, B);
        if (!hA) break;
        it = itA;
    }
}
__device__ __forceinline__ void filler(const Params& p, int l, int it0, int it1, int nwg, LAS unsigned char* lds, int wid, int lane) {
    const int G = gridDim.x, r = nwg % G, c = blockIdx.x;
    if (r == 0) convert_items(p, l, it0, it1, c * 8 + wid, G * 8, lds, wid, lane);
    else if (c >= r) convert_items(p, l, it0, it1, (c - r) * 8 + wid, (G - r) * 8, lds, wid, lane);
}

__device__ __forceinline__ void prologue(const Params& p, LAS unsigned char* lds, int wid, int lane) {
    const int gw = blockIdx.x * 8 + wid, NGW = gridDim.x * 8;
    convert_items(p, 0, 0, I_IN, gw, NGW, lds, wid, lane);
    bf16_t* HB = (bf16_t*)(p.ws + WS_HB); float* RS = (float*)(p.ws + WS_RS);
    for (int m = gw; m < MREAL; m += NGW) {
        const float* src;
        if (m < MPROMPT) { const int b = m / LSEQ, t = m % LSEQ; src = t < NMETA ? p.meta + (size_t)t * D : p.x_prompt + ((size_t)b * SEQ + (t - NMETA)) * D; }
        else src = p.x_sample + (size_t)(m - MPROMPT) * D;
        const f32x4* xr = (const f32x4*)src + lane; u32x2* hb = (u32x2*)(HB + (size_t)m * D) + lane;
        float ss = 0.f; f32x4 v[8];
#pragma unroll
        for (int j = 0; j < 8; ++j) { v[j] = xr[64 * j]; ss += (v[j].x * v[j].x + v[j].y * v[j].y) + (v[j].z * v[j].z + v[j].w * v[j].w); }
        ss = wave_sum(ss);
        const float r = 1.f / sqrtf(ss * (1.f / D) + RMS_EPS);
#pragma unroll
        for (int j = 0; j < 8; ++j) { u32x2 w; w.x = cvt_pk_bf16(v[j].x * r, v[j].y * r); w.y = cvt_pk_bf16(v[j].z * r, v[j].w * r); hb[64 * j] = w; }
        if (lane == 0) RS[m] = r;
    }
}

template <int PP> __device__ __forceinline__ void postnorm_row(const Params& p, const float* __restrict__ g, bool last, int m, int lane, bool dry) {
    bf16_t* HB = (bf16_t*)(p.ws + WS_HB); float* RS = (float*)(p.ws + WS_RS); const bf16_t* MIXB = (const bf16_t*)(p.ws + WS_MIXB); const bf16_t* MIXB1 = (const bf16_t*)(p.ws + WS_MIXB1);
    const u32x2* mr = (const u32x2*)(MIXB + (size_t)m * D) + lane; const u32x2* mr1 = (const u32x2*)(MIXB1 + (size_t)m * D) + lane;
    u32x2* hb = (u32x2*)(HB + (size_t)m * D) + lane; const f32x4* gr = (const f32x4*)g + lane;
    const int pmrow = m >> 8;
    u32x2 w0[8], w1[8], hw[8]; f32x4 gv[8];
#pragma unroll
    for (int j = 0; j < 8; ++j) { w0[j] = mr[64 * j]; w1[j] = mr1[64 * j]; hw[j] = hb[64 * j]; }
#pragma unroll
    for (int j = 0; j < 8; ++j) gv[j] = gr[64 * j];
    f32x4 mv[8]; float ss = 0.f;
#pragma unroll
    for (int j = 0; j < 8; ++j) { mv[j] = (f32x4){bf_lo(w0[j].x), bf_hi(w0[j].x), bf_lo(w0[j].y), bf_hi(w0[j].y)};
        if (pg8::StreamKOrder<PP>::is_split(j * (MP / 256) + pmrow, (int)gridDim.x)) mv[j] += (f32x4){bf_lo(w1[j].x), bf_hi(w1[j].x), bf_lo(w1[j].y), bf_hi(w1[j].y)};
        ss += (mv[j].x * mv[j].x + mv[j].y * mv[j].y) + (mv[j].z * mv[j].z + mv[j].w * mv[j].w); }
    ss = wave_sum(ss);
    const float r = 1.f / sqrtf(ss * (1.f / D) + RMS_EPS);
    float* yrow = nullptr;
    if (last) { if (m < MPROMPT) { const int b = m / LSEQ, t = m % LSEQ; if (t >= NMETA) yrow = p.out + O_YP + ((size_t)b * SEQ + (t - NMETA)) * D; } else yrow = p.out + O_YS + (size_t)(m - MPROMPT) * D; }
    const float rinv = 1.f / RS[m];
    float s2 = 0.f; f32x4 hn[8];
#pragma unroll
    for (int j = 0; j < 8; ++j) {
        const f32x4 hv = (f32x4){bf_lo(hw[j].x), bf_hi(hw[j].x), bf_lo(hw[j].y), bf_hi(hw[j].y)};
        hn[j] = hv * rinv + mv[j] * r * gv[j];
        s2 += (hn[j].x * hn[j].x + hn[j].y * hn[j].y) + (hn[j].z * hn[j].z + hn[j].w * hn[j].w);
        if (yrow) ((f32x4*)yrow)[lane + 64 * j] = hn[j];
    }
    s2 = wave_sum(s2);
    const float rn = 1.f / sqrtf(s2 * (1.f / D) + RMS_EPS);
#pragma unroll
    for (int j = 0; j < 8; ++j) { u32x2 w; w.x = cvt_pk_bf16(hn[j].x * rn, hn[j].y * rn); w.y = cvt_pk_bf16(hn[j].z * rn, hn[j].w * rn); (dry ? (u32x2*)(p.ws + WS_ZACT) + (size_t)m * (D / 4) + lane : hb)[64 * j] = w; }
    if (lane == 0 && !dry) RS[m] = rn;
}
struct Pn2Regs { u32x2 hw[2][8]; f32x4 gv[8]; float rs[2]; };
__device__ __forceinline__ void pn2_load_h(const Params& p, const float* __restrict__ g, int m0, int lane, Pn2Regs& R) {
    const bf16_t* HB = (const bf16_t*)(p.ws + WS_HB); const float* RS = (const float*)(p.ws + WS_RS);
    const f32x4* gr = (const f32x4*)g + lane;
#pragma unroll
    for (int e = 0; e < 2; ++e) { const u32x2* hb = (const u32x2*)(HB + (size_t)(m0 + e) * D) + lane;
#pragma unroll
        for (int j = 0; j < 8; ++j) R.hw[e][j] = hb[64 * j];
        R.rs[e] = RS[m0 + e]; }
#pragma unroll
    for (int j = 0; j < 8; ++j) R.gv[j] = gr[64 * j];
}
template <int PP> __device__ __forceinline__ void pn2_finish(const Params& p, bool last, int m0, int lane, const Pn2Regs& R) {
    bf16_t* HB = (bf16_t*)(p.ws + WS_HB); float* RS = (float*)(p.ws + WS_RS); const bf16_t* MIXB = (const bf16_t*)(p.ws + WS_MIXB); const bf16_t* MIXB1 = (const bf16_t*)(p.ws + WS_MIXB1);
    const int pmrow = m0 >> 8;
    u32x2 w0[2][8], w1[2][8];
#pragma unroll
    for (int e = 0; e < 2; ++e) {
        const u32x2* mr = (const u32x2*)(MIXB + (size_t)(m0 + e) * D) + lane; const u32x2* mr1 = (const u32x2*)(MIXB1 + (size_t)(m0 + e) * D) + lane;
#pragma unroll
        for (int j = 0; j < 8; ++j) { w0[e][j] = mr[64 * j]; w1[e][j] = mr1[64 * j]; }
    }
#pragma unroll
    for (int e = 0; e < 2; ++e) {
        const int m = m0 + e;
        f32x4 mv[8]; float ss = 0.f;
#pragma unroll
        for (int j = 0; j < 8; ++j) { mv[j] = (f32x4){bf_lo(w0[e][j].x), bf_hi(w0[e][j].x), bf_lo(w0[e][j].y), bf_hi(w0[e][j].y)};
            if (pg8::StreamKOrder<PP>::is_split(j * (MP / 256) + pmrow, (int)gridDim.x)) mv[j] += (f32x4){bf_lo(w1[e][j].x), bf_hi(w1[e][j].x), bf_lo(w1[e][j].y), bf_hi(w1[e][j].y)};
            ss += (mv[j].x * mv[j].x + mv[j].y * mv[j].y) + (mv[j].z * mv[j].z + mv[j].w * mv[j].w); }
        ss = wave_sum(ss);
        const float r = 1.f / sqrtf(ss * (1.f / D) + RMS_EPS);
        float* yrow = nullptr;
        if (last) { if (m < MPROMPT) { const int b = m / LSEQ, t = m % LSEQ; if (t >= NMETA) yrow = p.out + O_YP + ((size_t)b * SEQ + (t - NMETA)) * D; } else yrow = p.out + O_YS + (size_t)(m - MPROMPT) * D; }
        u32x2* hbw = (u32x2*)(HB + (size_t)m * D) + lane;
        const float rinv = 1.f / R.rs[e];
        float s2 = 0.f; f32x4 hn[8];
#pragma unroll
        for (int j = 0; j < 8; ++j) {
            const f32x4 hv = (f32x4){bf_lo(R.hw[e][j].x), bf_hi(R.hw[e][j].x), bf_lo(R.hw[e][j].y), bf_hi(R.hw[e][j].y)};
            hn[j] = hv * rinv + mv[j] * r * R.gv[j];
            s2 += (hn[j].x * hn[j].x + hn[j].y * hn[j].y) + (hn[j].z * hn[j].z + hn[j].w * hn[j].w);
            if (yrow) ((f32x4*)yrow)[lane + 64 * j] = hn[j];
        }
        s2 = wave_sum(s2);
        const float rn = 1.f / sqrtf(s2 * (1.f / D) + RMS_EPS);
        if (!last) {
#pragma unroll
            for (int j = 0; j < 8; ++j) { u32x2 w; w.x = cvt_pk_bf16(hn[j].x * rn, hn[j].y * rn); w.y = cvt_pk_bf16(hn[j].z * rn, hn[j].w * rn); hbw[64 * j] = w; }
            if (lane == 0) RS[m] = rn;
        }
    }
}
template <int PP> __device__ __forceinline__ void postnorm(const Params& p, const float* __restrict__ g, bool last, int wid, int lane, bool dry = false) {
    const int gw = blockIdx.x * 8 + wid, NGW = gridDim.x * 8;
    for (int m = gw; m < MREAL; m += NGW) postnorm_row<PP>(p, g, last, m, lane, dry);
}
template <int PP> __device__ __forceinline__ void sk_postnorm(const Params& p, const pg8::StreamKOrder<PP>& S, unsigned* cnt, const float* __restrict__ g, bool last, int vcu, int tid, int wid, int lane, unsigned long long& tacc_, unsigned long long& t0_) {
    const int G = gridDim.x, gwv = vcu * 8 + wid, NGW = G * 8;
    constexpr int NMAIN = 8192 / 32;
    TB(11);
    asm volatile("s_waitcnt vmcnt(0)" ::: "memory");
    __syncthreads();
    TE(11);
    Pn2Regs R0;
    const int mfirst = 32 * (vcu < NMAIN ? vcu : 0) + 4 * wid;
    pn2_load_h(p, g, mfirst, lane, R0);
    TB(12);
    if (tid == 0) {
#if !WT_SK
        __builtin_amdgcn_fence(__ATOMIC_RELEASE, "agent");
        asm volatile("s_waitcnt vmcnt(0)" ::: "memory");
#endif
        pg8::Unit u; for (int i = 0; S.next(i, u); ++i) (void)xb_add(cnt + 16 * u.pm, 1u);
        for (int c = vcu; c < NMAIN + 1; c += G) {
            int pm = c >> 3;
            if (c >= NMAIN) break;
            unsigned want = 0; for (int j = 0; j < 8; ++j) want += 1u + (pg8::StreamKOrder<PP>::is_split(j * (MP / 256) + pm, G) ? 1u : 0u);
            unsigned sp = 0; while (xb_ld(cnt + 16 * pm) < want) { __builtin_amdgcn_s_sleep(1); if (++sp > (1u << 22)) break; }
        }
        if (vcu * 8 < MREAL - 8192) {
            unsigned want = 0; for (int j = 0; j < 8; ++j) want += 1u + (pg8::StreamKOrder<PP>::is_split(j * (MP / 256) + 32, G) ? 1u : 0u);
            unsigned sp = 0; while (xb_ld(cnt + 16 * 32) < want) { __builtin_amdgcn_s_sleep(1); if (++sp > (1u << 22)) break; }
        }
        __builtin_amdgcn_fence(__ATOMIC_ACQUIRE, "agent");
        asm volatile("s_waitcnt vmcnt(0)" ::: "memory");
    }
    __syncthreads();
    TE(12);
    TB(13);
    if (vcu < NMAIN) {
        pn2_finish<PP>(p, last, mfirst, lane, R0);
        { Pn2Regs R1; pn2_load_h(p, g, mfirst + 2, lane, R1); pn2_finish<PP>(p, last, mfirst + 2, lane, R1); }
    }
    for (int c = vcu + G; c < NMAIN; c += G)
        for (int i = 0; i < 4; i += 2) { Pn2Regs R1; pn2_load_h(p, g, 32 * c + 4 * wid + i, lane, R1); pn2_finish<PP>(p, last, 32 * c + 4 * wid + i, lane, R1); }
    for (int i = gwv; i < MREAL - 8192; i += NGW) postnorm_row<PP>(p, g, last, 8192 + i, lane, false);
    TE(13);
}

constexpr int AT_QT = 128, AT_NT = 4, AT_KR = 304, AT_KS = 72, AT_VS = 312, AT_PS = 168;
constexpr int AT_K_OFF = 0, AT_V_OFF = AT_KR * AT_KS * 2  , AT_P_OFF = AT_V_OFF + 64 * AT_VS * 2  , AT_P_WAVE = 16 * AT_PS * 2  ;
static_assert(AT_P_OFF + 8 * AT_P_WAVE <= RING_BYTES && (AT_V_OFF % 16) == 0 && (AT_P_OFF % 16) == 0, "attention LDS map");

__device__ __forceinline__ void attn_prompt_unit(LAS unsigned char* lds, int b, int kvh, int qt, const bf16_t* __restrict__ z, bf16_t* mixin, const float* __restrict__ sinks, int tid, int wid, int lane) {
    LAS bf16_t* Ks = (LAS bf16_t*)(lds + AT_K_OFF);
    LAS bf16_t* Vt = (LAS bf16_t*)(lds + AT_V_OFF);
    LAS bf16_t* Pw = (LAS bf16_t*)(lds + AT_P_OFF + wid * AT_P_WAVE);
    const LAS float* biasL = (const LAS float*)(lds + BIAS_OFF);
    const int q0 = qt * AT_QT, rowb = b * LSEQ;
    const int h = kvh * 4 + (wid & 3), i16 = lane & 15, g = lane >> 4;
    const int ntile = AT_NT + ((qt == 15 && (wid >> 2) == 0) ? 1 : 0);
    bf16x8 qf[AT_NT + 1][2];
#pragma unroll
    for (int tile = 0; tile < AT_NT + 1; ++tile) {
        const int tq0 = tile < AT_NT ? q0 + (wid >> 2) * (AT_QT / 2) + tile * 16 : 2048;
        int tq = tq0 + i16; tq = tq > LSEQ - 1 ? LSEQ - 1 : tq;
        const bf16_t* qp = z + (size_t)(rowb + tq) * INDIM + ZQ + h * 64 + 8 * g;
        if (tile < ntile) { qf[tile][0] = *(const bf16x8*)qp; qf[tile][1] = *(const bf16x8*)(qp + 32); }
        else { qf[tile][0] = (bf16x8){0, 0, 0, 0, 0, 0, 0, 0}; qf[tile][1] = qf[tile][0]; }
    }
    const float sink = sinks[h];
    {
        constexpr int NIT = (AT_KR * 8 + 511) / 512;
        u32x4 kv[NIT], vv[NIT];
#pragma unroll
        for (int it = 0; it < NIT; ++it) {
            const int c = tid + it * 512;
            if (it < NIT - 1 || c < AT_KR * 8) {
                const int kr = c >> 3, ch = c & 7; int t = q0 - 144 + kr; t = t < 0 ? 0 : (t > LSEQ - 1 ? LSEQ - 1 : t);
                const bf16_t* src = z + (size_t)(rowb + t) * INDIM + kvh * 64 + ch * 8;
                kv[it] = *(const u32x4*)(src + ZK); vv[it] = *(const u32x4*)(src + ZV);
            }
        }
#pragma unroll
        for (int it = 0; it < NIT; ++it) {
            const int c = tid + it * 512;
            if (it < NIT - 1 || c < AT_KR * 8) {
                const int kr = c >> 3, ch = c & 7;
                *(LAS u32x4*)(Ks + kr * AT_KS + ch * 8) = kv[it];
                LAS bf16_t* vd = Vt + (ch * 8) * AT_VS + kr;
                vd[0 * AT_VS] = (bf16_t)(vv[it].x & 0xffffu); vd[1 * AT_VS] = (bf16_t)(vv[it].x >> 16);
                vd[2 * AT_VS] = (bf16_t)(vv[it].y & 0xffffu); vd[3 * AT_VS] = (bf16_t)(vv[it].y >> 16);
                vd[4 * AT_VS] = (bf16_t)(vv[it].z & 0xffffu); vd[5 * AT_VS] = (bf16_t)(vv[it].z >> 16);
                vd[6 * AT_VS] = (bf16_t)(vv[it].w & 0xffffu); vd[7 * AT_VS] = (bf16_t)(vv[it].w >> 16);
            }
        }
    }
    __syncthreads();
#pragma unroll
    for (int tile = 0; tile < AT_NT + 1; ++tile) {
        if (tile >= ntile) break;
        const int tq0 = tile < AT_NT ? q0 + (wid >> 2) * (AT_QT / 2) + tile * 16 : 2048;
        const int koff = tq0 - q0;
        const int t = tq0 + i16;
        f32x4 s[10];
#pragma unroll
        for (int nt = 1; nt < 10; ++nt) {
            const LAS bf16_t* kp = Ks + (koff + nt * 16 + i16) * AT_KS + 8 * g;
            const bf16x8 k0 = *(const LAS bf16x8*)kp, k1 = *(const LAS bf16x8*)(kp + 32);
            f32x4 a = (f32x4){0.f, 0.f, 0.f, 0.f};
            a = __builtin_amdgcn_mfma_f32_16x16x32_bf16(k0, qf[tile][0], a, 0, 0, 0);
            a = __builtin_amdgcn_mfma_f32_16x16x32_bf16(k1, qf[tile][1], a, 0, 0, 0);
            s[nt] = a;
        }
        const LAS float* bp = biasL + h * BIAS_STRIDE + BIAS_PAD + 144 + i16 - 4 * g;
        float mx = sink;
        if (tq0 >= 144) {
#pragma unroll
            for (int nt = 1; nt < 10; ++nt)
#pragma unroll
                for (int r = 0; r < 4; ++r) { const float v = s[nt][r] * 0.125f + bp[-(nt * 16 + r)]; s[nt][r] = v; mx = fmaxf(mx, v); }
        } else {
#pragma unroll
            for (int nt = 1; nt < 10; ++nt)
#pragma unroll
                for (int r = 0; r < 4; ++r) { const int tk = tq0 - 144 + nt * 16 + 4 * g + r; const float v = tk >= 0 ? s[nt][r] * 0.125f + bp[-(nt * 16 + r)] : -INFINITY; s[nt][r] = v; mx = fmaxf(mx, v); }
        }
        mx = fmaxf(mx, __shfl_xor(mx, 16)); mx = fmaxf(mx, __shfl_xor(mx, 32));
        float sum = 0.f;
        *(LAS u32x2*)(Pw + i16 * AT_PS + 4 * g) = (u32x2){0u, 0u};
#pragma unroll
        for (int nt = 1; nt < 10; ++nt) {
            const float e0 = __expf(s[nt][0] - mx), e1 = __expf(s[nt][1] - mx), e2 = __expf(s[nt][2] - mx), e3 = __expf(s[nt][3] - mx);
            sum += (e0 + e1) + (e2 + e3);
            u32x2 w; w.x = cvt_pk_bf16(e0, e1); w.y = cvt_pk_bf16(e2, e3);
            *(LAS u32x2*)(Pw + i16 * AT_PS + nt * 16 + 4 * g) = w;
        }
        sum += __shfl_xor(sum, 16); sum += __shfl_xor(sum, 32);
        const float inv = 1.f / (sum + __expf(sink - mx));
        LDS_WAIT(); __builtin_amdgcn_wave_barrier();
        f32x4 o[4];
#pragma unroll
        for (int dn = 0; dn < 4; ++dn) o[dn] = (f32x4){0.f, 0.f, 0.f, 0.f};
#pragma unroll
        for (int ks = 0; ks < 5; ++ks) {
            const bf16x8 pf = *(const LAS bf16x8*)(Pw + i16 * AT_PS + ks * 32 + 8 * g);
#pragma unroll
            for (int dn = 0; dn < 4; ++dn) {
                const bf16x8 vf = *(const LAS bf16x8*)(Vt + (dn * 16 + i16) * AT_VS + koff + ks * 32 + 8 * g);
                o[dn] = __builtin_amdgcn_mfma_f32_16x16x32_bf16(vf, pf, o[dn], 0, 0, 0);
            }
        }
        if (t < LSEQ) {
            bf16_t* op = mixin + (size_t)(rowb + t) * D + h * 64 + 4 * g;
#pragma unroll
            for (int dn = 0; dn < 4; ++dn) { u32x2 w; w.x = cvt_pk_bf16(o[dn][0] * inv, o[dn][1] * inv); w.y = cvt_pk_bf16(o[dn][2] * inv, o[dn][3] * inv); *(u32x2*)(op + dn * 16) = w; }
        }
        LDS_WAIT(); __builtin_amdgcn_wave_barrier();
    }
    __syncthreads();
}

__device__ __forceinline__ void attn_sample_wave(LAS unsigned char* lds, int l, int b, int h, const Params& p, const bf16_t* __restrict__ z, bf16_t* mixin, int wid, int lane) {
    LAS float* qs = (LAS float*)(lds + wid * 1024);
    LAS float* ps = qs + 64;
    const LAS float* biasL = (const LAS float*)(lds + BIAS_OFF);
    const int kvh = h >> 2;
    const bf16_t* zr = z + (size_t)(MPROMPT + b) * INDIM;
    const float qv = __uint_as_float((unsigned)zr[ZQ + h * 64 + lane] << 16) * 0.125f;
    qs[lane] = qv;
    LDS_WAIT(); __builtin_amdgcn_wave_barrier();
    const float* ck = p.cache_k + (((size_t)l * DB + b) * WIN) * 256 + kvh * 64;
    const float* cv = p.cache_v + (((size_t)l * DB + b) * WIN) * 256 + kvh * 64;
    float sc0 = 0.f, sc1 = 0.f;
    {
        const f32x4* k0 = (const f32x4*)(ck + (size_t)lane * 256); const f32x4* k1 = (const f32x4*)(ck + (size_t)(lane + 64) * 256);
#pragma unroll
        for (int d4 = 0; d4 < 16; ++d4) { const f32x4 q4 = *(const LAS f32x4*)(qs + 4 * d4); const f32x4 a = k0[d4], c = k1[d4];
            sc0 += (a.x * q4.x + a.y * q4.y) + (a.z * q4.z + a.w * q4.w); sc1 += (c.x * q4.x + c.y * q4.y) + (c.z * q4.z + c.w * q4.w); }
    }
    const float knew = __uint_as_float((unsigned)zr[ZK + kvh * 64 + lane] << 16);
    const float sc2 = wave_sum(qv * knew);
    const float sink = p.sinks[l * NHEADS + h];
    const float v0 = sc0 + biasL[h * BIAS_STRIDE + BIAS_PAD + (WIN - lane)], v1 = sc1 + biasL[h * BIAS_STRIDE + BIAS_PAD + (64 - lane)], v2 = sc2 + biasL[h * BIAS_STRIDE + BIAS_PAD];
    float mx = wave_max(fmaxf(v0, v1)); mx = fmaxf(mx, fmaxf(v2, sink));
    const float e0 = __expf(v0 - mx), e1 = __expf(v1 - mx), e2 = __expf(v2 - mx);
    const float sum = wave_sum(e0 + e1) + e2 + __expf(sink - mx);
    ps[lane] = e0; ps[lane + 64] = e1;
    LDS_WAIT(); __builtin_amdgcn_wave_barrier();
    const int sg = lane >> 4, dq = lane & 15;
    f32x4 oa = (f32x4){0.f, 0.f, 0.f, 0.f}, ob4 = (f32x4){0.f, 0.f, 0.f, 0.f};
#pragma unroll
    for (int it = 0; it < 2; ++it) {
        f32x4 vr[16];
#pragma unroll
        for (int i = 0; i < 16; ++i) vr[i] = *(const f32x4*)(cv + (size_t)(sg + 4 * (i + 16 * it)) * 256 + 4 * dq);
#pragma unroll
        for (int i = 0; i < 16; i += 2) { oa += vr[i] * ps[sg + 4 * (i + 16 * it)]; ob4 += vr[i + 1] * ps[sg + 4 * (i + 1 + 16 * it)]; }
    }
    oa += ob4;
#pragma unroll
    for (int c = 0; c < 4; ++c) { oa[c] += __shfl_xor(oa[c], 16); oa[c] += __shfl_xor(oa[c], 32); }
    if (sg == 0) {
        const u32x2 vn = *(const u32x2*)(zr + ZV + kvh * 64 + 4 * dq);
        const float rs_ = 1.f / sum;
        const float o0 = (oa[0] + e2 * bf_lo(vn.x)) * rs_, o1 = (oa[1] + e2 * bf_hi(vn.x)) * rs_, o2 = (oa[2] + e2 * bf_lo(vn.y)) * rs_, o3 = (oa[3] + e2 * bf_hi(vn.y)) * rs_;
        u32x2 w; w.x = cvt_pk_bf16(o0, o1); w.y = cvt_pk_bf16(o2, o3);
        *(u32x2*)(mixin + (size_t)(MPROMPT + b) * D + h * 64 + 4 * dq) = w;
    }
    LDS_WAIT(); __builtin_amdgcn_wave_barrier();
}

__device__ __forceinline__ void unpack8(const u32x4 a, float (&o)[8]) { o[0] = bf_lo(a.x); o[1] = bf_hi(a.x); o[2] = bf_lo(a.y); o[3] = bf_hi(a.y); o[4] = bf_lo(a.z); o[5] = bf_hi(a.z); o[6] = bf_lo(a.w); o[7] = bf_hi(a.w); }
__device__ __forceinline__ void conv_row(int l, int m, const Params& p, const bf16_t* __restrict__ z, bf16_t* mixin, int lane) {
    const float* cw = p.conv_w + (size_t)l * 3 * CDIM;
    const bool prompt = m < MPROMPT;
    const int b = prompt ? m / LSEQ : m - MPROMPT, t = prompt ? m % LSEQ : 0;
    const bf16_t* zr = z + (size_t)m * INDIM;
    const bf16_t* z1 = (prompt && t >= 1) ? zr - INDIM : zr;
    const bf16_t* z2 = (prompt && t >= 2) ? zr - 2 * INDIM : zr;
    const float k1 = (prompt && t >= 1) ? 1.f : 0.f, k2 = (prompt && t >= 2) ? 1.f : 0.f;
    const float* st = p.state_conv + (((size_t)l * DB + (prompt ? 0 : b)) * 2) * CDIM;
    u32x4 gbv[2], gcv[2], hcv[2], a1[2], c1[2], a2[2], c2[2]; f32x4 sv[2][4], wv[2][6];
#pragma unroll
    for (int j = 0; j < 2; ++j) {
        const int c0 = lane * 8 + 512 * j;
        gbv[j] = *(const u32x4*)(zr + ZGB + c0); gcv[j] = *(const u32x4*)(zr + ZGC + c0); hcv[j] = *(const u32x4*)(zr + ZHC + c0);
        a1[j] = *(const u32x4*)(z1 + ZGC + c0); c1[j] = *(const u32x4*)(z1 + ZHC + c0); a2[j] = *(const u32x4*)(z2 + ZGC + c0); c2[j] = *(const u32x4*)(z2 + ZHC + c0);
        if (!prompt) { sv[j][0] = *(const f32x4*)(st + c0); sv[j][1] = *(const f32x4*)(st + c0 + 4); sv[j][2] = *(const f32x4*)(st + CDIM + c0); sv[j][3] = *(const f32x4*)(st + CDIM + c0 + 4); }
#pragma unroll
        for (int i = 0; i < 3; ++i) { wv[j][2 * i] = *(const f32x4*)(cw + i * CDIM + c0); wv[j][2 * i + 1] = *(const f32x4*)(cw + i * CDIM + c0 + 4); }
    }
#pragma unroll
    for (int j = 0; j < 2; ++j) {
        const int c0 = lane * 8 + 512 * j;
        float gb[8], gc[8], hc[8], u0[8], u1[8], u2[8], x[8], y[8];
        unpack8(gbv[j], gb); unpack8(gcv[j], gc); unpack8(hcv[j], hc);
#pragma unroll
        for (int i = 0; i < 8; ++i) u0[i] = gc[i] * hc[i];
        if (prompt) {
            unpack8(a1[j], x); unpack8(c1[j], y);
#pragma unroll
            for (int i = 0; i < 8; ++i) u1[i] = x[i] * y[i] * k1;
            unpack8(a2[j], x); unpack8(c2[j], y);
#pragma unroll
            for (int i = 0; i < 8; ++i) u2[i] = x[i] * y[i] * k2;
            if (t >= LSEQ - 2) { float* co = p.out + O_CP + (((size_t)l * NBATCH + b) * 2 + (t - (LSEQ - 2))) * CDIM + c0;
                *(f32x4*)co = (f32x4){u0[0], u0[1], u0[2], u0[3]}; *(f32x4*)(co + 4) = (f32x4){u0[4], u0[5], u0[6], u0[7]}; }
        } else {
#pragma unroll
            for (int i = 0; i < 4; ++i) { u2[i] = sv[j][0][i]; u2[4 + i] = sv[j][1][i]; u1[i] = sv[j][2][i]; u1[4 + i] = sv[j][3][i]; }
            float* co = p.out + O_CS + (((size_t)l * DB + b) * 2) * CDIM + c0;
            *(f32x4*)co = sv[j][2]; *(f32x4*)(co + 4) = sv[j][3];
            *(f32x4*)(co + CDIM) = (f32x4){u0[0], u0[1], u0[2], u0[3]}; *(f32x4*)(co + CDIM + 4) = (f32x4){u0[4], u0[5], u0[6], u0[7]};
        }
        float r[8];
#pragma unroll
        for (int i = 0; i < 8; ++i) { const float w0 = wv[j][i >> 2][i & 3], w1 = wv[j][2 + (i >> 2)][i & 3], w2 = wv[j][4 + (i >> 2)][i & 3]; r[i] = gb[i] * (w0 * u2[i] + w1 * u1[i] + w2 * u0[i]); }
        u32x4 w; w.x = cvt_pk_bf16(r[0], r[1]); w.y = cvt_pk_bf16(r[2], r[3]); w.z = cvt_pk_bf16(r[4], r[5]); w.w = cvt_pk_bf16(r[6], r[7]);
        *(u32x4*)(mixin + (size_t)m * D + 1024 + c0) = w;
    }
}

__device__ __forceinline__ void conv_job4(int l, int m0, const Params& p, const bf16_t* __restrict__ z, bf16_t* mixin, int lane) {
    const float* cw = p.conv_w + (size_t)l * 3 * CDIM;
    const int b = m0 / LSEQ, t0 = m0 % LSEQ;
    const float kprev = t0 > 0 ? 1.f : 0.f;
    const bf16_t* zr = z + (size_t)m0 * INDIM;
    const bf16_t* zp = t0 > 0 ? zr - 2 * INDIM : zr;
#pragma unroll
    for (int j = 0; j < 2; ++j) {
        const int c0 = lane * 8 + 512 * j;
        u32x4 gcv[6], hcv[6], gbv[4]; f32x4 wv[6];
        gcv[0] = *(const u32x4*)(zp + ZGC + c0); hcv[0] = *(const u32x4*)(zp + ZHC + c0);
        gcv[1] = *(const u32x4*)(zp + INDIM + ZGC + c0); hcv[1] = *(const u32x4*)(zp + INDIM + ZHC + c0);
#pragma unroll
        for (int r = 0; r < 4; ++r) { gcv[2 + r] = *(const u32x4*)(zr + (size_t)r * INDIM + ZGC + c0); hcv[2 + r] = *(const u32x4*)(zr + (size_t)r * INDIM + ZHC + c0); gbv[r] = *(const u32x4*)(zr + (size_t)r * INDIM + ZGB + c0); }
#pragma unroll
        for (int i = 0; i < 3; ++i) { wv[2 * i] = *(const f32x4*)(cw + i * CDIM + c0); wv[2 * i + 1] = *(const f32x4*)(cw + i * CDIM + c0 + 4); }
        float u[6][8];
#pragma unroll
        for (int r = 0; r < 6; ++r) { float x[8], y[8]; unpack8(gcv[r], x); unpack8(hcv[r], y); const float k = r < 2 ? kprev : 1.f;
#pragma unroll
            for (int i = 0; i < 8; ++i) u[r][i] = x[i] * y[i] * k; }
#pragma unroll
        for (int r = 0; r < 4; ++r) {
            float gb[8], o[8]; unpack8(gbv[r], gb);
#pragma unroll
            for (int i = 0; i < 8; ++i) { const float w0 = wv[i >> 2][i & 3], w1 = wv[2 + (i >> 2)][i & 3], w2 = wv[4 + (i >> 2)][i & 3]; o[i] = gb[i] * (w0 * u[r][i] + w1 * u[r + 1][i] + w2 * u[r + 2][i]); }
            u32x4 w; w.x = cvt_pk_bf16(o[0], o[1]); w.y = cvt_pk_bf16(o[2], o[3]); w.z = cvt_pk_bf16(o[4], o[5]); w.w = cvt_pk_bf16(o[6], o[7]);
            *(u32x4*)(mixin + (size_t)(m0 + r) * D + 1024 + c0) = w;
        }
        if (t0 == LSEQ - 4) {
#pragma unroll
            for (int r = 0; r < 2; ++r) { float* co = p.out + O_CP + (((size_t)l * NBATCH + b) * 2 + r) * CDIM + c0;
                *(f32x4*)co = (f32x4){u[4 + r][0], u[4 + r][1], u[4 + r][2], u[4 + r][3]}; *(f32x4*)(co + 4) = (f32x4){u[4 + r][4], u[4 + r][5], u[4 + r][6], u[4 + r][7]}; }
        }
    }
}

__device__ __forceinline__ void kv_prompt_row(int l, int idx, const Params& p, const bf16_t* __restrict__ z, int lane) {
    const int b = idx >> 7, w = idx & 127;
    const bf16_t* zr = z + (size_t)(b * LSEQ + (LSEQ - WIN) + w) * INDIM;
    const u32x2 kv = *(const u32x2*)(zr + ZK + 4 * lane), vv = *(const u32x2*)(zr + ZV + 4 * lane);
    const size_t o = (((size_t)l * NBATCH + b) * WIN + w) * 256 + 4 * lane;
    *(f32x4*)(p.out + O_KP + o) = (f32x4){bf_lo(kv.x), bf_hi(kv.x), bf_lo(kv.y), bf_hi(kv.y)};
    *(f32x4*)(p.out + O_VP + o) = (f32x4){bf_lo(vv.x), bf_hi(vv.x), bf_lo(vv.y), bf_hi(vv.y)};
}
__device__ __forceinline__ void kv_sample_row(int l, int idx, const Params& p, const bf16_t* __restrict__ z, int lane) {
    const int b = idx >> 7, w = idx & 127;
    const size_t o = (((size_t)l * DB + b) * WIN + w) * 256 + 4 * lane;
    f32x4 kq, vq;
    if (w < WIN - 1) { kq = *(const f32x4*)(p.cache_k + o + 256); vq = *(const f32x4*)(p.cache_v + o + 256); }
    else { const bf16_t* zr = z + (size_t)(MPROMPT + b) * INDIM; const u32x2 kv = *(const u32x2*)(zr + ZK + 4 * lane), vv = *(const u32x2*)(zr + ZV + 4 * lane);
        kq = (f32x4){bf_lo(kv.x), bf_hi(kv.x), bf_lo(kv.y), bf_hi(kv.y)}; vq = (f32x4){bf_lo(vv.x), bf_hi(vv.x), bf_lo(vv.y), bf_hi(vv.y)}; }
    *(f32x4*)(p.out + O_KS + o) = kq; *(f32x4*)(p.out + O_VS + o) = vq;
}

__device__ __forceinline__ void kv_sample_row2(int l, int i0, int i1, const Params& p, const bf16_t* __restrict__ z, int lane) {
    f32x4 kq[2], vq[2]; size_t o[2]; const int idx[2] = {i0, i1};
#pragma unroll
    for (int e = 0; e < 2; ++e) {
        const int b = idx[e] >> 7, w = idx[e] & 127;
        o[e] = (((size_t)l * DB + b) * WIN + w) * 256 + 4 * lane;
        if (w < WIN - 1) { kq[e] = *(const f32x4*)(p.cache_k + o[e] + 256); vq[e] = *(const f32x4*)(p.cache_v + o[e] + 256); }
        else { const bf16_t* zr = z + (size_t)(MPROMPT + b) * INDIM; const u32x2 kv = *(const u32x2*)(zr + ZK + 4 * lane), vv = *(const u32x2*)(zr + ZV + 4 * lane);
            kq[e] = (f32x4){bf_lo(kv.x), bf_hi(kv.x), bf_lo(kv.y), bf_hi(kv.y)}; vq[e] = (f32x4){bf_lo(vv.x), bf_hi(vv.x), bf_lo(vv.y), bf_hi(vv.y)}; }
    }
#pragma unroll
    for (int e = 0; e < 2; ++e) { *(f32x4*)(p.out + O_KS + o[e]) = kq[e]; *(f32x4*)(p.out + O_VS + o[e]) = vq[e]; }
}

__device__ __forceinline__ void filler_cache_copy(const Params& p, int l, int nwg, int wid, int lane) {
    const int G = gridDim.x, r = nwg % G, c = blockIdx.x;
    int worker, nw;
    if (r == 0) { worker = c * 8 + wid; nw = G * 8; } else if (c >= r) { worker = (c - r) * 8 + wid; nw = (G - r) * 8; } else return;
    for (int i = worker; i < DB * WIN / 2; i += nw) {
        const int i1 = i + DB * WIN / 2;
        if ((i & 127) != 127) kv_sample_row2(l, i, i1, p, (const bf16_t*)(p.ws + WS_ZACT), lane);
    }
}

constexpr int NU_ATT = NBATCH * 4 * 16;

__device__ __forceinline__ void mixer_phase(const Params& p, int l, LAS unsigned char* lds, int tid, int wid, int lane, unsigned long long& tacc_, unsigned long long& t0_) {
    const bf16_t* z = (const bf16_t*)(p.ws + WS_ZACT); bf16_t* mixin = (bf16_t*)(p.ws + WS_MIXIN);
    TB(9);
    for (int u = blockIdx.x; u < NU_ATT; u += gridDim.x) { const int qt = u & 15, bk = u >> 4; attn_prompt_unit(lds, bk >> 2, bk & 3, qt, z, mixin, p.sinks + l * NHEADS, tid, wid, lane); }
    TE(9);
    TB(10);
    const int gw = blockIdx.x * 8 + wid, NGW = gridDim.x * 8;
    if (gw < MPROMPT / 4) conv_job4(l, 4 * gw, p, z, mixin, lane);
    for (int j = NGW + (gw >> 7); j < MPROMPT / 4 && (gw & 127) == 5; j += NGW >> 7) conv_job4(l, 4 * j, p, z, mixin, lane);
    if ((gw & 63) == 33 && (gw >> 6) < DB) conv_row(l, MPROMPT + (gw >> 6), p, z, mixin, lane);
    if ((gw & 3) == 0 && (gw >> 2) < DB * NHEADS) { const int job = gw >> 2; attn_sample_wave(lds, l, job >> 4, job & 15, p, z, mixin, wid, lane); }
    for (int i = (int)NGW - 1 - gw; i < NBATCH * WIN; i += NGW) kv_prompt_row(l, i, p, z, lane);
    if ((gw & 63) == 34 && (gw >> 6) < DB) kv_sample_row(l, (gw >> 6) * WIN + (WIN - 1), p, z, lane);
    TE(10);
}

__global__ void __launch_bounds__(512, 2) hymba_fwd(Params p) {
    extern __shared__ __attribute__((aligned(16))) unsigned char lds_raw[];
    LAS unsigned char* lds = (LAS unsigned char*)lds_raw;
    cg::grid_group grid = cg::this_grid();
    const int tid = threadIdx.x, lane = tid & 63, wid = __builtin_amdgcn_readfirstlane(tid >> 6);

    unsigned* barw = (unsigned*)(p.ws + WS_BAR);
    unsigned* cntw = (unsigned*)(p.ws + WS_CNT);
    volatile LAS unsigned* xst = (volatile LAS unsigned*)(lds + MISC_OFF);
    if (tid < 2) xst[tid] = 0u;
    __syncthreads();
    const XcdBarrier xb = xcd_barrier_post(barw, xst);
    {
        LAS float* biasL = (LAS float*)(lds + BIAS_OFF);
        for (int i = tid; i < NHEADS * BIAS_STRIDE; i += 512) {
            const int h = i / BIAS_STRIDE, d = i % BIAS_STRIDE - BIAS_PAD;
            float v = -INFINITY;
            if (d >= 0 && d <= WIN) {
                int bkt;
                if (d < 16) bkt = d;
                else { const float df = (float)d; bkt = 16 + (int)(logf(df / 16.f) / logf(8.f) * 16.f); bkt = bkt > 31 ? 31 : bkt; }
                v = p.rel_bias[bkt * NHEADS + h];
            }
            biasL[i] = v;
        }
    }
    unsigned long long tacc_ = 0, t0_ = 0;
    TB(0);
    for (int rep = 0; rep < REP_PRO; ++rep) prologue(p, lds, wid, lane);
    TE(0);
    if (p.ws == nullptr) grid.sync();
    GSYNC();

    bf16_t* ZACT = (bf16_t*)(p.ws + WS_ZACT); bf16_t* MIXIN = (bf16_t*)(p.ws + WS_MIXIN); bf16_t* MIXB = (bf16_t*)(p.ws + WS_MIXB); bf16_t* MIXB1 = (bf16_t*)(p.ws + WS_MIXB1);
    const int vcu = (gridDim.x % 8 == 0) ? (int)((blockIdx.x % 8) * (gridDim.x / 8) + blockIdx.x / 8) : (int)blockIdx.x;
    const int skw = (gridDim.x == 256) ? ((vcu & 7) * 32 + (vcu >> 5) * 4 + ((vcu & 31) >> 3)) : vcu;
    const bf16_t* HB = (const bf16_t*)(p.ws + WS_HB); const float* RS = (const float*)(p.ws + WS_RS);
#pragma unroll 1
    for (int l = 0; l < DEPTH; ++l) {
        TB(1);
        {
            pg8::Gemm g{HB, (const bf16_t*)(p.ws + WS_WIN + l * SZ_WIN), MP, INDIM, D}; pg8::Epi<0> E{ZACT, INDIM, RS, ZACT};
            pg8::StaticOrder S; S.init(MP, INDIM, D, (int)gridDim.x, (int)blockIdx.x);
            for (int rep = 0; rep < REP_GIN; ++rep) pg8::gemm_phase<D, pg8::Epi<0>, pg8::StaticOrder>(lds, g, S, E);
            for (int rep = 0; rep < REP_FILL; ++rep) { int t2 = threadIdx.x; asm volatile("" : "+v"(t2)); const int w2 = __builtin_amdgcn_readfirstlane(t2 >> 6), l2 = t2 & 63;
                filler(p, l, I_IN, I_LAYER - I_DN, (MP / 256) * (INDIM / 256), lds, w2, l2);
                if (l + 1 < DEPTH) filler(p, l + 1, 0, I_IN / 2, (MP / 256) * (INDIM / 256), lds, w2, l2);
                filler_cache_copy(p, l, (MP / 256) * (INDIM / 256), w2, l2); }
        }
        TE(1);
        GSYNC();
        TB(2);
#ifndef NO_MIX
        for (int rep = 0; rep < REP_MIX; ++rep) { int t2 = threadIdx.x; asm volatile("" : "+v"(t2)); mixer_phase(p, l, lds, t2, __builtin_amdgcn_readfirstlane(t2 >> 6), t2 & 63, tacc_, t0_); }
#endif
        TE(2);
        GSYNC();
        TB(3);
        {
            pg8::Gemm g{MIXIN, (const bf16_t*)(p.ws + WS_WOUT + l * SZ_WOUT), MP, D, D}; pg8::Epi<0> E{MIXB, D, nullptr, MIXB1};
            pg8::StreamKOrder<D / 128> S; S.init((int)gridDim.x, skw);
            for (int rep = 0; rep < REP_GOUT; ++rep) pg8::gemm_phase<D, pg8::Epi<0>, pg8::StreamKOrder<D / 128>>(lds, g, S, E);
            TE(3);
            TB(4);
            { int t2 = threadIdx.x; asm volatile("" : "+v"(t2)); sk_postnorm<D / 128>(p, S, cntw + (size_t)((l * 2 + 0) * 33) * 16, p.n_post_mix + l * D, false, vcu, t2, __builtin_amdgcn_readfirstlane(t2 >> 6), t2 & 63, tacc_, t0_); }
        }
        TE(4);
        GSYNC();
        TB(5);
        {
            pg8::Gemm g{HB, (const bf16_t*)(p.ws + WS_WGU + l * SZ_WGU), MP, NGU, D}; pg8::Epi<1> E{ZACT, DFF, RS, ZACT};
            pg8::StaticOrder S; S.init(MP, NGU, D, (int)gridDim.x, (int)blockIdx.x);
            for (int rep = 0; rep < REP_GGU; ++rep) pg8::gemm_phase<D, pg8::Epi<1>, pg8::StaticOrder>(lds, g, S, E);
            for (int rep = 0; rep < REP_FILL; ++rep) { int t2 = threadIdx.x; asm volatile("" : "+v"(t2)); const int w2 = __builtin_amdgcn_readfirstlane(t2 >> 6), l2 = t2 & 63;
                filler(p, l, I_LAYER - I_DN, I_LAYER, (MP / 256) * (NGU / 256), lds, w2, l2);
                if (l + 1 < DEPTH) filler(p, l + 1, I_IN / 2, I_IN, (MP / 256) * (NGU / 256), lds, w2, l2); }
        }
        TE(5);
        GSYNC();
        TB(6);
        {
            pg8::Gemm g{ZACT, (const bf16_t*)(p.ws + WS_WDN + l * SZ_WDN), MP, D, DFF}; pg8::Epi<0> E{MIXB, D, nullptr, MIXB1};
            pg8::StreamKOrder<DFF / 128> S; S.init((int)gridDim.x, skw);
            for (int rep = 0; rep < REP_GDN; ++rep) pg8::gemm_phase<DFF, pg8::Epi<0>, pg8::StreamKOrder<DFF / 128>>(lds, g, S, E);
            TE(6);
            TB(7);
            { int t2 = threadIdx.x; asm volatile("" : "+v"(t2)); sk_postnorm<DFF / 128>(p, S, cntw + (size_t)((l * 2 + 1) * 33) * 16, p.n_post_ffn + l * D, l == DEPTH - 1, vcu, t2, __builtin_amdgcn_readfirstlane(t2 >> 6), t2 & 63, tacc_, t0_); }
        }
        TE(7);
        if (l != DEPTH - 1) GSYNC();
    }
    if (TMASK != 0 && blockIdx.x == TBLK) { const unsigned long long tend = __builtin_amdgcn_s_memrealtime() + (unsigned long long)TMULT * tacc_; while (__builtin_amdgcn_s_memrealtime() < tend) __builtin_amdgcn_s_sleep(8); }
}

extern "C" void kernel_launch(void* const* d_in, const int* in_sizes, int n_in, void* d_out, int out_size, void* d_ws, size_t ws_size, hipStream_t stream) {
    static int grid_blocks = 0;
    if (grid_blocks == 0) {
        if (n_in != 18 || ws_size < WS_END) { fprintf(stderr, "kernel_launch: unexpected inputs (n_in %d, ws %zu, need %zu)\n", n_in, ws_size, (size_t)WS_END); grid_blocks = -1; return; }
        int dev = 0, cus = 0, per_cu = 0;
        hipGetDevice(&dev);
        hipDeviceGetAttribute(&cus, hipDeviceAttributeMultiprocessorCount, dev);
        hipFuncSetAttribute((const void*)hymba_fwd, hipFuncAttributeMaxDynamicSharedMemorySize, LDS_BYTES);
        hipOccupancyMaxActiveBlocksPerMultiprocessor(&per_cu, (const void*)hymba_fwd, 512, LDS_BYTES);
        if (per_cu < 1) per_cu = 1;
        grid_blocks = cus * per_cu;
    }
    if (grid_blocks < 0) return;
    if (hipMemsetAsync((char*)d_ws + WS_BAR, 0, WS_END - WS_BAR, stream) != hipSuccess) { fprintf(stderr, "kernel_launch: memset of the barrier words failed\n"); return; }
    Params p{};
    const float** pp = (const float**)&p;
    for (int i = 0; i < 18; ++i) pp[i] = (const float*)d_in[i];
    p.out = (float*)d_out; p.ws = (unsigned char*)d_ws;
    void* args[] = {&p};
    hipError_t e = hipLaunchCooperativeKernel((const void*)hymba_fwd, dim3(grid_blocks), dim3(512), args, LDS_BYTES, stream);
    if (e != hipSuccess) fprintf(stderr, "cooperative launch failed: %s (grid %d)\n", hipGetErrorString(e), grid_blocks);
}
```

```cpp
#include <hip/hip_runtime.h>
#include <hip/hip_cooperative_groups.h>
#include <cstdio>
#include <cstdint>
namespace cg = cooperative_groups;
#define REP_PRO 1
#define REP_MIX 1
#define REP_GIN 1
#define REP_GOUT 1
#define REP_GGU 1
#define REP_GDN 1
#define EXTRA_SYNC 0
#define REP_PN 0
#define REP_FILL 1
#define WGM_SET 5
#define TMASK 0
#define TMULT 4
#define TBLK 0
#define TB(k) do { if (TMASK & (1 << (k))) t0_ = __builtin_amdgcn_s_memrealtime(); } while (0)
#define TE(k) do { if (TMASK & (1 << (k))) tacc_ += __builtin_amdgcn_s_memrealtime() - t0_; } while (0)
#define GSYNC() do { TB(8); xcd_barrier(xb); for (int e_ = 0; e_ < EXTRA_SYNC; ++e_) xcd_barrier(xb); TE(8); } while (0)

#define LAS __attribute__((address_space(3)))
typedef unsigned short bf16_t;
typedef short bf16x8 __attribute__((ext_vector_type(8)));
typedef float f32x4 __attribute__((ext_vector_type(4)));
typedef float f32x2 __attribute__((ext_vector_type(2)));
typedef unsigned u32x4 __attribute__((ext_vector_type(4)));
typedef unsigned u32x2 __attribute__((ext_vector_type(2)));

constexpr int D = 2048, NBATCH = 4, SEQ = 2048, NMETA = 16, LSEQ = SEQ + NMETA, DEPTH = 4, DB = 32, WIN = 128;
constexpr int MPROMPT = NBATCH * LSEQ;
constexpr int MREAL = MPROMPT + DB;
constexpr int MP = 8448;
constexpr int INDIM = 4608, DFF = 5632, NGU = 2 * DFF, CDIM = 1024;
constexpr int ZQ = 0, ZK = 1024, ZV = 1280, ZGB = 1536, ZGC = 2560, ZHC = 3584;
constexpr float RMS_EPS = 1e-6f;
constexpr int NHEADS = 16;

constexpr size_t O_YP = 0, O_YS = 16777216, O_KP = 16842752, O_VP = 17367040, O_CP = 17891328, O_KS = 17924096, O_VS = 22118400, O_CS = 26312704;

constexpr size_t SZ_WIN = (size_t)INDIM * D * 2, SZ_WOUT = (size_t)D * D * 2, SZ_WGU = (size_t)NGU * D * 2, SZ_WDN = (size_t)D * DFF * 2;
constexpr size_t WS_WIN = 0;
constexpr size_t WS_WOUT = WS_WIN + DEPTH * SZ_WIN;
constexpr size_t WS_WGU = WS_WOUT + DEPTH * SZ_WOUT;
constexpr size_t WS_WDN = WS_WGU + DEPTH * SZ_WGU;
constexpr size_t WS_ZACT = WS_WDN + DEPTH * SZ_WDN;
constexpr size_t WS_MIXIN = WS_ZACT + (size_t)MP * DFF * 2;
constexpr size_t WS_MIXB = WS_MIXIN + (size_t)MP * D * 2;
constexpr size_t WS_MIXB1 = WS_MIXB + (size_t)MP * D * 2;
constexpr size_t WS_HB = WS_MIXB1 + (size_t)MP * D * 2;
constexpr size_t WS_RS = WS_HB + (size_t)MP * D * 2;
constexpr size_t WS_BAR = WS_RS + (size_t)MP * 4;
constexpr size_t WS_CNT = WS_BAR + 16384;
constexpr size_t WS_END = WS_CNT + (size_t)DEPTH * 2 * 33 * 64;

constexpr int RING_BYTES = 131072, BIAS_OFF = RING_BYTES, LDS_BYTES = 147456;
constexpr int BIAS_STRIDE = 176, BIAS_PAD = 16;
constexpr int MISC_OFF = BIAS_OFF + NHEADS * BIAS_STRIDE * 4;

__device__ __forceinline__ unsigned cvt_pk_bf16(float lo, float hi) { unsigned r; asm volatile("v_cvt_pk_bf16_f32 %0, %1, %2" : "=v"(r) : "v"(lo), "v"(hi)); return r; }
__device__ __forceinline__ float bf_lo(unsigned u) { return __uint_as_float(u << 16); }
__device__ __forceinline__ float bf_hi(unsigned u) { return __uint_as_float(u & 0xffff0000u); }
__device__ __forceinline__ float wave_sum(float v) {
#pragma unroll
    for (int o = 1; o < 64; o <<= 1) v += __shfl_xor(v, o);
    return v;
}
__device__ __forceinline__ float wave_max(float v) {
#pragma unroll
    for (int o = 1; o < 64; o <<= 1) v = fmaxf(v, __shfl_xor(v, o));
    return v;
}
#define LDS_WAIT() asm volatile("s_waitcnt lgkmcnt(0)" ::: "memory")
#define WT_STORES 0
#define WT_SK 1
#define WT_LAST 0
__device__ __forceinline__ void store16_wt(void* p, u32x4 v, bool wt) {
    if (wt) asm volatile("global_store_dwordx4 %0, %1, off sc1\n\ts_nop 1" :: "v"(p), "v"(v) : "memory");
    else *(u32x4*)p = v;
}
__device__ __forceinline__ void store8_wt(void* p, u32x2 v) {
#if WT_STORES
    asm volatile("global_store_dwordx2 %0, %1, off sc1\n\ts_nop 1" :: "v"(p), "v"(v) : "memory");
#else
    *(u32x2*)p = v;
#endif
}


#define XB_TMO      128
#define XB_XCNT(j)  (256  + 64 * (j))
#define XB_XSUB(j)  (1280 + 64 * (j))
#define XB_XGEN(j)  (2304 + 64 * (j))
#define XB_TOP      3328
#define XB_TOPGEN   3392
#define XCD_BAR_WORDS 3456
#define XB_SPIN_CAP (1u << 18)
__device__ __forceinline__ unsigned xb_ld(unsigned* p)              { return __hip_atomic_load(p, __ATOMIC_RELAXED, __HIP_MEMORY_SCOPE_AGENT); }
__device__ __forceinline__ unsigned xb_add(unsigned* p, unsigned v) { return __hip_atomic_fetch_add(p, v, __ATOMIC_RELAXED, __HIP_MEMORY_SCOPE_AGENT); }
__device__ __forceinline__ unsigned xb_xcc_id() { return (unsigned)__builtin_amdgcn_s_getreg((3 << 11) | 20) & 0xFu; }
#define XB_SPIN(cond, bar) do { unsigned _sp = 0; while (cond) { __builtin_amdgcn_s_sleep(1); \
    if ((++_sp & 255u) == 0u) { if (xb_ld(&(bar)[XB_TMO])) break; if (_sp > XB_SPIN_CAP) { atomicAdd(&(bar)[XB_TMO], 1u); break; } } } } while (0)
struct XcdBarrier { unsigned* bar; unsigned x; volatile LAS unsigned* st; };
__device__ __forceinline__ XcdBarrier xcd_barrier_post(unsigned* bar, volatile LAS unsigned* st) {
    XcdBarrier b; b.bar = bar; b.x = xb_xcc_id(); b.st = st;
    if (threadIdx.x == 0) (void)xb_add(&bar[XB_XCNT(b.x)], 1u);
    return b;
}
__device__ __forceinline__ void xcd_barrier_complete(unsigned* bar, unsigned x, unsigned& nloc, unsigned& nx) {
    const unsigned G = gridDim.x * gridDim.y * gridDim.z;
    unsigned sum, cnt, mine, sp = 0u;
    for (;;) {
        sum = 0u; cnt = 0u; mine = 0u;
#pragma unroll
        for (unsigned j = 0; j < 16; ++j) { const unsigned c = xb_ld(&bar[XB_XCNT(j)]); sum += c; cnt += (c > 0u) ? 1u : 0u; mine = (j == x) ? c : mine; }
        if (sum == G) break;
        __builtin_amdgcn_s_sleep(1);
        if ((++sp & 255u) == 0u) { if (xb_ld(&bar[XB_TMO])) break; if (sp > XB_SPIN_CAP) { atomicAdd(&bar[XB_TMO], 1u); break; } }
    }
    nloc = mine > 0u ? mine : 1u; nx = cnt > 0u ? cnt : 1u;
}
__device__ __forceinline__ void xcd_barrier(const XcdBarrier& b) {
    asm volatile("s_waitcnt vmcnt(0)" ::: "memory");
    __syncthreads();
    if (threadIdx.x == 0) {
        unsigned* bar = b.bar;
        __builtin_amdgcn_s_waitcnt(0);
        unsigned nloc = b.st[0], nx = b.st[1];
        if (nloc == 0u) { xcd_barrier_complete(bar, b.x, nloc, nx); b.st[0] = nloc; b.st[1] = nx; }
        const unsigned old = xb_add(&bar[XB_XSUB(b.x)], 1u);
        const unsigned gen = old / nloc;
        if (old + 1u == (gen + 1u) * nloc) {
            __builtin_amdgcn_fence(__ATOMIC_RELEASE, "agent");
            asm volatile("s_waitcnt vmcnt(0)" ::: "memory");
            const unsigned og = xb_add(&bar[XB_TOP], 1u);
            const unsigned tg = og / nx;
            if (og + 1u == (tg + 1u) * nx) xb_add(&bar[XB_TOPGEN], 1u);
            else XB_SPIN(xb_ld(&bar[XB_TOPGEN]) == tg, bar);
            __builtin_amdgcn_fence(__ATOMIC_ACQUIRE, "agent");
            xb_add(&bar[XB_XGEN(b.x)], 1u);
            asm volatile("s_waitcnt vmcnt(0)" ::: "memory");
        } else {
            XB_SPIN(xb_ld(&bar[XB_XGEN(b.x)]) == gen, bar);
            __builtin_amdgcn_fence(__ATOMIC_ACQUIRE, "agent");
            asm volatile("s_waitcnt vmcnt(0)" ::: "memory");
        }
    }
    __syncthreads();
}

namespace pg8 {
constexpr int BM = 256, BK = 64, HALF = 128, HTB = HALF * BK * 2, STAGE_BYTES = 8 * HTB, NXCD = 8, WGM = WGM_SET;
__host__ __device__ __forceinline__ int lds_byte(int r, int c) { const int st = (r >> 4) * 2 + (c >> 5), rr = r & 15, cc = c & 31, ob = rr * 64 + cc * 2; return st * 1024 + (ob ^ (((ob >> 9) & 1) << 5)); }
__host__ __device__ __forceinline__ void stage_rc(int b, int& R, int& C) { const int st = b / 1024, sb = b % 1024, swz = sb ^ (((sb >> 9) & 1) << 5); R = (st >> 1) * 16 + swz / 64; C = (st & 1) * 32 + (swz % 64) / 2; }
__host__ __device__ __forceinline__ int perm32(int rho) { const int n = rho >> 4, i = rho & 15; return 8 * (i >> 2) + 4 * n + (i & 3); }

struct Unit { int pm, pn, kt0, len, part; };
struct Gemm { const bf16_t* A; const bf16_t* Bt; int M, N, K; };

struct StaticOrder {
    static constexpr bool WT_ALL = false;
    int nM, nN, nwg, G, c, nt;
    __host__ __device__ void init(int M, int N, int K, int G_, int c_) { nM = M / BM; nN = N / BM; nwg = nM * nN; G = G_; c = c_; nt = K / BK; }
    __host__ __device__ bool next(int i, Unit& u) const {
        const long L = (long)i * G + c; if (L >= nwg) return false;
        int wgid = (int)L; { const int q = nwg / NXCD, r = nwg % NXCD, xcd = wgid % NXCD, off = wgid / NXCD; wgid = (xcd < r ? xcd * (q + 1) : r * (q + 1) + (xcd - r) * q) + off; }
        const int nig = WGM * nN, gid = wgid / nig, fm = gid * WGM, gsz = (nM - fm) < WGM ? (nM - fm) : WGM;
        u.pm = fm + ((wgid % nig) % gsz); u.pn = (wgid % nig) / gsz; u.kt0 = 0; u.len = nt; u.part = 0; return true;
    }
};
template <int PP> struct StreamKOrder {
    static constexpr bool WT_ALL = (WT_SK != 0);
    static constexpr int NPAN = MP / BM, NTILE = NPAN * 8, TP = NTILE * PP;
    int q0, q1;
    __device__ void init(int G, int v) { q0 = (int)((long)v * TP / G); q1 = (int)((long)(v + 1) * TP / G); }
    __device__ bool next(int i, Unit& u) const {
        const int t = q0 / PP + i, s = t * PP; const int a = q0 > s ? q0 : s, b = q1 < s + PP ? q1 : s + PP;
        if (a >= b) return false;
        u.pn = t / NPAN; u.pm = t % NPAN; u.kt0 = 2 * (a - s); u.len = 2 * (b - a); u.part = a > s ? 1 : 0; return true;
    }
    static __device__ __forceinline__ bool is_split(int t, int G) { const int s = t * PP; return (int)(((long)(s + 1) * G - 1) / TP) != (int)(((long)(s + PP) * G - 1) / TP); }
};

template <int MODE> struct Epi {
    static constexpr bool PERM = true;
    bf16_t* O; int ldc; const float* rs; bf16_t* O1;
    __device__ __forceinline__ void operator()(const f32x4 (&acc)[2][2][4][2], const Unit& u, int wr, int wc, int fr, int fq, bool wt) const {
        const int row0 = u.pm * BM + wr * 64 + fr;
        if constexpr (MODE == 0) {
            const int col0 = u.pn * BM + wc * 32 + 8 * fq;
#pragma unroll
            for (int ai = 0; ai < 2; ++ai)
#pragma unroll
                for (int m = 0; m < 4; ++m) {
                    const int row = row0 + ai * HALF + m * 16;
                    bf16_t* rowp = (u.part ? O1 : O) + (size_t)row * ldc + col0;
#pragma unroll
                    for (int bj = 0; bj < 2; ++bj) {
                        const f32x4 v0 = acc[ai][bj][m][0], v1 = acc[ai][bj][m][1];
                        u32x4 w; w.x = cvt_pk_bf16(v0[0], v0[1]); w.y = cvt_pk_bf16(v0[2], v0[3]); w.z = cvt_pk_bf16(v1[0], v1[1]); w.w = cvt_pk_bf16(v1[2], v1[3]);
                        store16_wt(rowp + bj * HALF, w, wt);
                    }
                }
        } else {
            const int col0 = u.pn * HALF + wc * 32 + 8 * fq;
#pragma unroll
            for (int ai = 0; ai < 2; ++ai)
#pragma unroll
                for (int m = 0; m < 4; ++m) {
                    const int row = row0 + ai * HALF + m * 16;
                    float o[8];
#pragma unroll
                    for (int n = 0; n < 2; ++n)
#pragma unroll
                        for (int j = 0; j < 4; ++j) {
                            const float g = acc[ai][0][m][n][j], up = acc[ai][1][m][n][j];
                            o[n * 4 + j] = (g * up) * __builtin_amdgcn_rcpf(1.f + __builtin_amdgcn_exp2f(g * -1.4426950408889634f));
                        }
                    u32x4 w; w.x = cvt_pk_bf16(o[0], o[1]); w.y = cvt_pk_bf16(o[2], o[3]); w.z = cvt_pk_bf16(o[4], o[5]); w.w = cvt_pk_bf16(o[6], o[7]);
                    store16_wt(O + (size_t)row * ldc + col0, w, wt);
                }
        }
    }
};

template <int K, class EpiT, class Sched>
__device__ __forceinline__ void gemm_phase(LAS unsigned char* lds, const Gemm g, const Sched& S, const EpiT& E) {
    int tid_ = threadIdx.x; asm volatile("" : "+v"(tid_));
    const int tid = tid_, wid = __builtin_amdgcn_readfirstlane(tid >> 6), lane = tid & 63, wr = wid >> 2, wc = wid & 3, fr = lane & 15, fq = lane >> 4;
    unsigned voffA[2], voffB[2];
#pragma unroll
    for (int i = 0; i < 2; ++i) { int R, C; stage_rc(tid * 16 + i * 8192, R, C); const int Rb = EpiT::PERM ? ((R & ~31) + perm32(R & 31)) : R;
        voffA[i] = (unsigned)(R * K + C) * 2u; voffB[i] = (unsigned)(Rb * K + C) * 2u; }
    const size_t kstep = (size_t)(BK * 2);
    const size_t hstep = (size_t)HALF * K * 2;
    const size_t tstep = 2 * hstep;
    const unsigned ldsw = (unsigned)wid * 1024u;
    const int aoff = lds_byte(wr * 64 + fr, fq * 8), boff = lds_byte(wc * 32 + fr, fq * 8);
#define PG8_SA(b, h) (((b) * 2 + (h)) * HTB)
#define PG8_SB(b, h) ((4 + (b) * 2 + (h)) * HTB)
#define PG8_STAGE(bufoff, gbase, voff) do { _Pragma("unroll") for (int _i = 0; _i < 2; ++_i) \
        __builtin_amdgcn_global_load_lds((const unsigned*)((const char*)(gbase) + (voff)[_i]), (LAS unsigned*)(lds + (bufoff) + ldsw + _i * 8192), 16, 0, 0); } while (0)
#define PG8_LDA(dst, b, h) do { _Pragma("unroll") for (int m = 0; m < 4; ++m) _Pragma("unroll") for (int k = 0; k < 2; ++k) dst[m][k] = *(const LAS bf16x8*)(lds + PG8_SA(b, h) + aoff + m * 2048 + k * 1024); } while (0)
#define PG8_LDB(dst, b, h) do { _Pragma("unroll") for (int n = 0; n < 2; ++n) _Pragma("unroll") for (int k = 0; k < 2; ++k) dst[n][k] = *(const LAS bf16x8*)(lds + PG8_SB(b, h) + boff + n * 2048 + k * 1024); } while (0)
#define PG8_MMA(ai, bj, At, Bt) do { __builtin_amdgcn_s_setprio(1); _Pragma("unroll") for (int m = 0; m < 4; ++m) _Pragma("unroll") for (int n = 0; n < 2; ++n) _Pragma("unroll") for (int k = 0; k < 2; ++k) \
        acc[ai][bj][m][n] = __builtin_amdgcn_mfma_f32_16x16x32_bf16(Bt[n][k], At[m][k], acc[ai][bj][m][n], 0, 0, 0); __builtin_amdgcn_s_setprio(0); } while (0)
#define PG8_WAIT_V(n) asm volatile("s_waitcnt vmcnt(" #n ")" ::: "memory")
#define PG8_WAIT_L(n) asm volatile("s_waitcnt lgkmcnt(" #n ")" ::: "memory")
#define PG8_BAR __builtin_amdgcn_s_barrier()
#define PG8_SCHED __builtin_amdgcn_sched_barrier(0)
    Unit cur, nxt; int ui = 0;
    if (!S.next(0, cur)) return;
    f32x4 acc[2][2][4][2];
#pragma unroll
    for (int a = 0; a < 2; ++a)
#pragma unroll
        for (int b = 0; b < 2; ++b)
#pragma unroll
            for (int m = 0; m < 4; ++m)
#pragma unroll
                for (int n = 0; n < 2; ++n) acc[a][b][m][n] = (f32x4){0.f, 0.f, 0.f, 0.f};
    bf16x8 At[4][2], B0[2][2], B1[2][2];
    const char* cA = (const char*)g.A + (size_t)cur.pm * tstep + (size_t)cur.kt0 * kstep; const char* cB = (const char*)g.Bt + (size_t)cur.pn * tstep + (size_t)cur.kt0 * kstep;
    PG8_STAGE(PG8_SB(0, 0), cB, voffB); PG8_STAGE(PG8_SB(0, 1), cB + hstep, voffB); PG8_STAGE(PG8_SA(0, 0), cA, voffA); PG8_STAGE(PG8_SA(0, 1), cA + hstep, voffA);
    if (wr == 1) PG8_BAR;
    PG8_WAIT_V(2); PG8_BAR;
    PG8_STAGE(PG8_SB(1, 0), cB + kstep, voffB); PG8_STAGE(PG8_SA(1, 0), cA + kstep, voffA); PG8_STAGE(PG8_SB(1, 1), cB + hstep + kstep, voffB);
    PG8_WAIT_V(6); PG8_BAR;
    for (;;) {
        const bool has_next = S.next(ui + 1, nxt);
        const char* nA = has_next ? (const char*)g.A + (size_t)nxt.pm * tstep + (size_t)nxt.kt0 * kstep : cA; const char* nB = has_next ? (const char*)g.Bt + (size_t)nxt.pn * tstep + (size_t)nxt.kt0 * kstep : cB;
        const int nt = cur.len;
        for (int t = 0; t < nt; t += 2) {
            const bool last = (t == nt - 2);
            const char* a1 = cA + (size_t)(t + 1) * kstep;
            const char* a2 = last ? nA : cA + (size_t)(t + 2) * kstep; const char* b2 = last ? nB : cB + (size_t)(t + 2) * kstep;
            const char* a3 = a2 + kstep; const char* b3 = b2 + kstep;
            PG8_LDB(B0, 0, 0); PG8_LDB(B1, 0, 1); PG8_SCHED; PG8_LDA(At, 0, 0); PG8_STAGE(PG8_SA(1, 1), a1 + hstep, voffA);
            PG8_WAIT_V(8); PG8_WAIT_L(0); PG8_BAR; PG8_MMA(0, 0, At, B0); PG8_MMA(0, 1, At, B1); PG8_BAR; PG8_SCHED;
            PG8_LDA(At, 0, 1); PG8_STAGE(PG8_SB(0, 0), b2, voffB); PG8_STAGE(PG8_SB(0, 1), b2 + hstep, voffB); PG8_STAGE(PG8_SA(0, 0), a2, voffA);
            PG8_WAIT_V(8); PG8_WAIT_L(0); PG8_BAR; PG8_MMA(1, 0, At, B0); PG8_MMA(1, 1, At, B1); PG8_BAR; PG8_SCHED;
            PG8_LDB(B0, 1, 0); PG8_LDB(B1, 1, 1); PG8_SCHED; PG8_LDA(At, 1, 0); PG8_STAGE(PG8_SA(0, 1), a2 + hstep, voffA);
            PG8_WAIT_V(8); PG8_WAIT_L(0); PG8_BAR; PG8_MMA(0, 0, At, B0); PG8_MMA(0, 1, At, B1); PG8_BAR; PG8_SCHED;
            PG8_LDA(At, 1, 1); PG8_STAGE(PG8_SB(1, 0), b3, voffB); PG8_STAGE(PG8_SB(1, 1), b3 + hstep, voffB); PG8_STAGE(PG8_SA(1, 0), a3, voffA);
            PG8_WAIT_V(8); PG8_WAIT_L(0); PG8_BAR; PG8_MMA(1, 0, At, B0); PG8_MMA(1, 1, At, B1); PG8_BAR; PG8_SCHED;
        }
        if (wr == 0) PG8_BAR;
        E(acc, cur, wr, wc, fr, fq, Sched::WT_ALL ? true : (WT_LAST != 0 && !has_next));
        if (!has_next) break;
#pragma unroll
        for (int a = 0; a < 2; ++a)
#pragma unroll
            for (int b = 0; b < 2; ++b)
#pragma unroll
                for (int m = 0; m < 4; ++m)
#pragma unroll
                    for (int n = 0; n < 2; ++n) acc[a][b][m][n] = (f32x4){0.f, 0.f, 0.f, 0.f};
        cur = nxt; cA = nA; cB = nB; ++ui;
        if (wr == 1) PG8_BAR;
    }
    PG8_WAIT_V(0);
    PG8_BAR;
#undef PG8_SA
#undef PG8_SB
#undef PG8_STAGE
#undef PG8_LDA
#undef PG8_LDB
#undef PG8_MMA
#undef PG8_WAIT_V
#undef PG8_WAIT_L
#undef PG8_BAR
#undef PG8_SCHED
}
}

struct Params {
    const float *x_prompt, *x_sample, *cache_k, *cache_v, *state_conv, *meta, *rel_bias, *w_in, *conv_w, *sinks, *w_out,
        *n_pre_mix, *n_post_mix, *n_pre_ffn, *n_post_ffn, *w_gate, *w_up, *w_down;
    float* out; unsigned char* ws;
};

constexpr int I_IN = (D / 64) * (INDIM / 64), I_OUT = (D / 64) * (D / 64), I_G = (D / 64) * (DFF / 64), I_DN = (DFF / 64) * (D / 64);
constexpr int I_LAYER = I_IN + I_OUT + 2 * I_G + I_DN;
struct ItemDesc { const float* W; const float* gain; bf16_t* WT; int K, N, mode, k0, n0; };
struct ItemRegs { f32x4 v0[8], v1[8]; f32x2 gg[8]; };
__device__ __forceinline__ void item_decode(const Params& p, int l, int it, ItemDesc& d) {
    int r = it;
    if (r < I_IN) { d.W = p.w_in + (size_t)l * D * INDIM; d.K = D; d.N = INDIM; d.WT = (bf16_t*)(p.ws + WS_WIN) + (size_t)l * INDIM * D; d.gain = p.n_pre_mix + l * D; d.mode = 0; }
    else if ((r -= I_IN) < I_OUT) { d.W = p.w_out + (size_t)l * D * D; d.K = D; d.N = D; d.WT = (bf16_t*)(p.ws + WS_WOUT) + (size_t)l * D * D; d.gain = nullptr; d.mode = 0; }
    else if ((r -= I_OUT) < I_G) { d.W = p.w_gate + (size_t)l * D * DFF; d.K = D; d.N = DFF; d.WT = (bf16_t*)(p.ws + WS_WGU) + (size_t)l * NGU * D; d.gain = p.n_pre_ffn + l * D; d.mode = 1; }
    else if ((r -= I_G) < I_G) { d.W = p.w_up + (size_t)l * D * DFF; d.K = D; d.N = DFF; d.WT = (bf16_t*)(p.ws + WS_WGU) + (size_t)l * NGU * D; d.gain = p.n_pre_ffn + l * D; d.mode = 2; }
    else { r -= I_G; d.W = p.w_down + (size_t)l * DFF * D; d.K = DFF; d.N = D; d.WT = (bf16_t*)(p.ws + WS_WDN) + (size_t)l * D * DFF; d.gain = nullptr; d.mode = 0; }
    const int nblk = d.N / 64; d.k0 = 64 * (r / nblk); d.n0 = 64 * (r % nblk);
}
__device__ __forceinline__ void item_load(const ItemDesc& d, int lane, ItemRegs& R) {
    const int c4 = lane & 15, kq = lane >> 4;
#pragma unroll
    for (int i = 0; i < 8; ++i) { const int kp = kq + 4 * i; const float* s = d.W + (size_t)(d.k0 + 2 * kp) * d.N + d.n0 + 4 * c4; R.v0[i] = __builtin_nontemporal_load((const f32x4*)s); R.v1[i] = __builtin_nontemporal_load((const f32x4*)(s + d.N)); }
#pragma unroll
    for (int i = 0; i < 8; ++i) { const int kp = kq + 4 * i; R.gg[i] = d.gain ? *(const f32x2*)(d.gain + d.k0 + 2 * kp) : (f32x2){1.f, 1.f}; }
}
__device__ __forceinline__ void item_finish(const ItemDesc& d, LAS unsigned* scr, int lane, const ItemRegs& R) {
    const int c4 = lane & 15, kq = lane >> 4;
#pragma unroll
    for (int i = 0; i < 8; ++i) { const int kp = kq + 4 * i; const float g0 = R.gg[i].x, g1 = R.gg[i].y;
        LAS unsigned* q = scr + (4 * c4) * 33 + kp;
        q[0] = cvt_pk_bf16(R.v0[i].x * g0, R.v1[i].x * g1); q[33] = cvt_pk_bf16(R.v0[i].y * g0, R.v1[i].y * g1); q[66] = cvt_pk_bf16(R.v0[i].z * g0, R.v1[i].z * g1); q[99] = cvt_pk_bf16(R.v0[i].w * g0, R.v1[i].w * g1); }
    LDS_WAIT(); __builtin_amdgcn_wave_barrier(); asm volatile("" ::: "memory");
    int rbase = d.n0;
    if (d.mode) rbase = ((d.n0 >> 7) << 8) + (d.n0 & 127) + (d.mode == 2 ? 128 : 0);
    const int kc = lane & 7;
#pragma unroll
    for (int j = 0; j < 8; ++j) { const int n = (lane >> 3) + 8 * j; const LAS unsigned* s = scr + n * 33 + 4 * kc;
        u32x4 o; o.x = s[0]; o.y = s[1]; o.z = s[2]; o.w = s[3];
        __builtin_nontemporal_store(o, (u32x4*)(d.WT + (size_t)(rbase + n) * d.K + d.k0 + 8 * kc)); }
    LDS_WAIT(); __builtin_amdgcn_wave_barrier(); asm volatile("" ::: "memory");
}
__device__ __forceinline__ void convert_items(const Params& p, int l, int it0, int it1, int worker, int nw, LAS unsigned char* lds, int wid, int lane) {
    LAS unsigned* scr = (LAS unsigned*)(lds + wid * 16384);
    int it = it0 + worker;
    if (it >= it1) return;
    ItemDesc dA, dB; ItemRegs A, B;
    item_decode(p, l, it, dA); item_load(dA, lane, A);
    for (;;) {
        const int itB = it + nw; const bool hB = itB < it1;
        if (hB) { item_decode(p, l, itB, dB); item_load(dB, lane, B); }
        item_finish(dA, scr, lane, A);
        if (!hB) break;
        const int itA = itB + nw; const bool hA = itA < it1;
        if (hA) { item_decode(p, l, itA, dA); item_load(dA, lane, A); }
        item_finish(dB, scr, lane, B);
        if (!hA) break;
        it = itA;
    }
}
__device__ __forceinline__ void filler(const Params& p, int l, int it0, int it1, int nwg, LAS unsigned char* lds, int wid, int lane) {
    const int G = gridDim.x, r = nwg % G, c = blockIdx.x;
    if (r == 0) convert_items(p, l, it0, it1, c * 8 + wid, G * 8, lds, wid, lane);
    else if (c >= r) convert_items(p, l, it0, it1, (c - r) * 8 + wid, (G - r) * 8, lds, wid, lane);
}

__device__ __forceinline__ void prologue(const Params& p, LAS unsigned char* lds, int wid, int lane) {
    const int gw = blockIdx.x * 8 + wid, NGW = gridDim.x * 8;
    convert_items(p, 0, 0, I_IN, gw, NGW, lds, wid, lane);
    bf16_t* HB = (bf16_t*)(p.ws + WS_HB); float* RS = (float*)(p.ws + WS_RS);
    for (int m = gw; m < MREAL; m += NGW) {
        const float* src;
        if (m < MPROMPT) { const int b = m / LSEQ, t = m % LSEQ; src = t < NMETA ? p.meta + (size_t)t * D : p.x_prompt + ((size_t)b * SEQ + (t - NMETA)) * D; }
        else src = p.x_sample + (size_t)(m - MPROMPT) * D;
        const f32x4* xr = (const f32x4*)src + lane; u32x2* hb = (u32x2*)(HB + (size_t)m * D) + lane;
        float ss = 0.f; f32x4 v[8];
#pragma unroll
        for (int j = 0; j < 8; ++j) { v[j] = xr[64 * j]; ss += (v[j].x * v[j].x + v[j].y * v[j].y) + (v[j].z * v[j].z + v[j].w * v[j].w); }
        ss = wave_sum(ss);
        const float r = 1.f / sqrtf(ss * (1.f / D) + RMS_EPS);
#pragma unroll
        for (int j = 0; j < 8; ++j) { u32x2 w; w.x = cvt_pk_bf16(v[j].x * r, v[j].y * r); w.y = cvt_pk_bf16(v[j].z * r, v[j].w * r); hb[64 * j] = w; }
        if (lane == 0) RS[m] = r;
    }
}

template <int PP> __device__ __forceinline__ void postnorm_row(const Params& p, const float* __restrict__ g, bool last, int m, int lane, bool dry) {
    bf16_t* HB = (bf16_t*)(p.ws + WS_HB); float* RS = (float*)(p.ws + WS_RS); const bf16_t* MIXB = (const bf16_t*)(p.ws + WS_MIXB); const bf16_t* MIXB1 = (const bf16_t*)(p.ws + WS_MIXB1);
    const u32x2* mr = (const u32x2*)(MIXB + (size_t)m * D) + lane; const u32x2* mr1 = (const u32x2*)(MIXB1 + (size_t)m * D) + lane;
    u32x2* hb = (u32x2*)(HB + (size_t)m * D) + lane; const f32x4* gr = (const f32x4*)g + lane;
    const int pmrow = m >> 8;
    u32x2 w0[8], w1[8], hw[8]; f32x4 gv[8];
#pragma unroll
    for (int j = 0; j < 8; ++j) { w0[j] = mr[64 * j]; w1[j] = mr1[64 * j]; hw[j] = hb[64 * j]; }
#pragma unroll
    for (int j = 0; j < 8; ++j) gv[j] = gr[64 * j];
    f32x4 mv[8]; float ss = 0.f;
#pragma unroll
    for (int j = 0; j < 8; ++j) { mv[j] = (f32x4){bf_lo(w0[j].x), bf_hi(w0[j].x), bf_lo(w0[j].y), bf_hi(w0[j].y)};
        if (pg8::StreamKOrder<PP>::is_split(j * (MP / 256) + pmrow, (int)gridDim.x)) mv[j] += (f32x4){bf_lo(w1[j].x), bf_hi(w1[j].x), bf_lo(w1[j].y), bf_hi(w1[j].y)};
        ss += (mv[j].x * mv[j].x + mv[j].y * mv[j].y) + (mv[j].z * mv[j].z + mv[j].w * mv[j].w); }
    ss = wave_sum(ss);
    const float r = 1.f / sqrtf(ss * (1.f / D) + RMS_EPS);
    float* yrow = nullptr;
    if (last) { if (m < MPROMPT) { const int b = m / LSEQ, t = m % LSEQ; if (t >= NMETA) yrow = p.out + O_YP + ((size_t)b * SEQ + (t - NMETA)) * D; } else yrow = p.out + O_YS + (size_t)(m - MPROMPT) * D; }
    const float rinv = 1.f / RS[m];
    float s2 = 0.f; f32x4 hn[8];
#pragma unroll
    for (int j = 0; j < 8; ++j) {
        const f32x4 hv = (f32x4){bf_lo(hw[j].x), bf_hi(hw[j].x), bf_lo(hw[j].y), bf_hi(hw[j].y)};
        hn[j] = hv * rinv + mv[j] * r * gv[j];
        s2 += (hn[j].x * hn[j].x + hn[j].y * hn[j].y) + (hn[j].z * hn[j].z + hn[j].w * hn[j].w);
        if (yrow) ((f32x4*)yrow)[lane + 64 * j] = hn[j];
    }
    s2 = wave_sum(s2);
    const float rn = 1.f / sqrtf(s2 * (1.f / D) + RMS_EPS);
#pragma unroll
    for (int j = 0; j < 8; ++j) { u32x2 w; w.x = cvt_pk_bf16(hn[j].x * rn, hn[j].y * rn); w.y = cvt_pk_bf16(hn[j].z * rn, hn[j].w * rn); (dry ? (u32x2*)(p.ws + WS_ZACT) + (size_t)m * (D / 4) + lane : hb)[64 * j] = w; }
    if (lane == 0 && !dry) RS[m] = rn;
}
struct Pn2Regs { u32x2 hw[2][8]; f32x4 gv[8]; float rs[2]; };
__device__ __forceinline__ void pn2_load_h(const Params& p, const float* __restrict__ g, int m0, int lane, Pn2Regs& R) {
    const bf16_t* HB = (const bf16_t*)(p.ws + WS_HB); const float* RS = (const float*)(p.ws + WS_RS);
    const f32x4* gr = (const f32x4*)g + lane;
#pragma unroll
    for (int e = 0; e < 2; ++e) { const u32x2* hb = (const u32x2*)(HB + (size_t)(m0 + e) * D) + lane;
#pragma unroll
        for (int j = 0; j < 8; ++j) R.hw[e][j] = hb[64 * j];
        R.rs[e] = RS[m0 + e]; }
#pragma unroll
    for (int j = 0; j < 8; ++j) R.gv[j] = gr[64 * j];
}
template <int PP> __device__ __forceinline__ void pn2_finish(const Params& p, bool last, int m0, int lane, const Pn2Regs& R) {
    bf16_t* HB = (bf16_t*)(p.ws + WS_HB); float* RS = (float*)(p.ws + WS_RS); const bf16_t* MIXB = (const bf16_t*)(p.ws + WS_MIXB); const bf16_t* MIXB1 = (const bf16_t*)(p.ws + WS_MIXB1);
    const int pmrow = m0 >> 8;
    u32x2 w0[2][8], w1[2][8];
#pragma unroll
    for (int e = 0; e < 2; ++e) {
        const u32x2* mr = (const u32x2*)(MIXB + (size_t)(m0 + e) * D) + lane; const u32x2* mr1 = (const u32x2*)(MIXB1 + (size_t)(m0 + e) * D) + lane;
#pragma unroll
        for (int j = 0; j < 8; ++j) { w0[e][j] = mr[64 * j]; w1[e][j] = mr1[64 * j]; }
    }
#pragma unroll
    for (int e = 0; e < 2; ++e) {
        const int m = m0 + e;
        f32x4 mv[8]; float ss = 0.f;
#pragma unroll
        for (int j = 0; j < 8; ++j) { mv[j] = (f32x4){bf_lo(w0[e][j].x), bf_hi(w0[e][j].x), bf_lo(w0[e][j].y), bf_hi(w0[e][j].y)};
            if (pg8::StreamKOrder<PP>::is_split(j * (MP / 256) + pmrow, (int)gridDim.x)) mv[j] += (f32x4){bf_lo(w1[e][j].x), bf_hi(w1[e][j].x), bf_lo(w1[e][j].y), bf_hi(w1[e][j].y)};
            ss += (mv[j].x * mv[j].x + mv[j].y * mv[j].y) + (mv[j].z * mv[j].z + mv[j].w * mv[j].w); }
        ss = wave_sum(ss);
        const float r = 1.f / sqrtf(ss * (1.f / D) + RMS_EPS);
        float* yrow = nullptr;
        if (last) { if (m < MPROMPT) { const int b = m / LSEQ, t = m % LSEQ; if (t >= NMETA) yrow = p.out + O_YP + ((size_t)b * SEQ + (t - NMETA)) * D; } else yrow = p.out + O_YS + (size_t)(m - MPROMPT) * D; }
        u32x2* hbw = (u32x2*)(HB + (size_t)m * D) + lane;
        const float rinv = 1.f / R.rs[e];
        float s2 = 0.f; f32x4 hn[8];
#pragma unroll
        for (int j = 0; j < 8; ++j) {
            const f32x4 hv = (f32x4){bf_lo(R.hw[e][j].x), bf_hi(R.hw[e][j].x), bf_lo(R.hw[e][j].y), bf_hi(R.hw[e][j].y)};
            hn[j] = hv * rinv + mv[j] * r * R.gv[j];
            s2 += (hn[j].x * hn[j].x + hn[j].y * hn[j].y) + (hn[j].z * hn[j].z + hn[j].w * hn[j].w);
            if (yrow) ((f32x4*)yrow)[lane + 64 * j] = hn[j];
        }
        s2 = wave_sum(s2);
        const float rn = 1.f / sqrtf(s2 * (1.f / D) + RMS_EPS);
        if (!last) {
#pragma unroll
            for (int j = 0; j < 8; ++j) { u32x2 w; w.x = cvt_pk_bf16(hn[j].x * rn, hn[j].y * rn); w.y = cvt_pk_bf16(hn[j].z * rn, hn[j].w * rn); hbw[64 * j] = w; }
            if (lane == 0) RS[m] = rn;
        }
    }
}
template <int PP> __device__ __forceinline__ void postnorm(const Params& p, const float* __restrict__ g, bool last, int wid, int lane, bool dry = false) {
    const int gw = blockIdx.x * 8 + wid, NGW = gridDim.x * 8;
    for (int m = gw; m < MREAL; m += NGW) postnorm_row<PP>(p, g, last, m, lane, dry);
}
template <int PP> __device__ __forceinline__ void sk_postnorm(const Params& p, const pg8::StreamKOrder<PP>& S, unsigned* cnt, const float* __restrict__ g, bool last, int vcu, int tid, int wid, int lane, unsigned long long& tacc_, unsigned long long& t0_) {
    const int G = gridDim.x, gwv = vcu * 8 + wid, NGW = G * 8;
    constexpr int NMAIN = 8192 / 32;
    TB(11);
    asm volatile("s_waitcnt vmcnt(0)" ::: "memory");
    __syncthreads();
    TE(11);
    Pn2Regs R0;
    const int mfirst = 32 * (vcu < NMAIN ? vcu : 0) + 4 * wid;
    pn2_load_h(p, g, mfirst, lane, R0);
    TB(12);
    if (tid == 0) {
#if !WT_SK
        __builtin_amdgcn_fence(__ATOMIC_RELEASE, "agent");
        asm volatile("s_waitcnt vmcnt(0)" ::: "memory");
#endif
        pg8::Unit u; for (int i = 0; S.next(i, u); ++i) (void)xb_add(cnt + 16 * u.pm, 1u);
        for (int c = vcu; c < NMAIN + 1; c += G) {
            int pm = c >> 3;
            if (c >= NMAIN) break;
            unsigned want = 0; for (int j = 0; j < 8; ++j) want += 1u + (pg8::StreamKOrder<PP>::is_split(j * (MP / 256) + pm, G) ? 1u : 0u);
            unsigned sp = 0; while (xb_ld(cnt + 16 * pm) < want) { __builtin_amdgcn_s_sleep(1); if (++sp > (1u << 22)) break; }
        }
        if (vcu * 8 < MREAL - 8192) {
            unsigned want = 0; for (int j = 0; j < 8; ++j) want += 1u + (pg8::StreamKOrder<PP>::is_split(j * (MP / 256) + 32, G) ? 1u : 0u);
            unsigned sp = 0; while (xb_ld(cnt + 16 * 32) < want) { __builtin_amdgcn_s_sleep(1); if (++sp > (1u << 22)) break; }
        }
        __builtin_amdgcn_fence(__ATOMIC_ACQUIRE, "agent");
        asm volatile("s_waitcnt vmcnt(0)" ::: "memory");
    }
    __syncthreads();
    TE(12);
    TB(13);
    if (vcu < NMAIN) {
        pn2_finish<PP>(p, last, mfirst, lane, R0);
        { Pn2Regs R1; pn2_load_h(p, g, mfirst + 2, lane, R1); pn2_finish<PP>(p, last, mfirst + 2, lane, R1); }
    }
    for (int c = vcu + G; c < NMAIN; c += G)
        for (int i = 0; i < 4; i += 2) { Pn2Regs R1; pn2_load_h(p, g, 32 * c + 4 * wid + i, lane, R1); pn2_finish<PP>(p, last, 32 * c + 4 * wid + i, lane, R1); }
    for (int i = gwv; i < MREAL - 8192; i += NGW) postnorm_row<PP>(p, g, last, 8192 + i, lane, false);
    TE(13);
}

constexpr int AT_QT = 128, AT_NT = 4, AT_KR = 304, AT_KS = 72, AT_VS = 312, AT_PS = 168;
constexpr int AT_K_OFF = 0, AT_V_OFF = AT_KR * AT_KS * 2  , AT_P_OFF = AT_V_OFF + 64 * AT_VS * 2  , AT_P_WAVE = 16 * AT_PS * 2  ;
static_assert(AT_P_OFF + 8 * AT_P_WAVE <= RING_BYTES && (AT_V_OFF % 16) == 0 && (AT_P_OFF % 16) == 0, "attention LDS map");

__device__ __forceinline__ void attn_prompt_unit(LAS unsigned char* lds, int b, int kvh, int qt, const bf16_t* __restrict__ z, bf16_t* mixin, const float* __restrict__ sinks, int tid, int wid, int lane) {
    LAS bf16_t* Ks = (LAS bf16_t*)(lds + AT_K_OFF);
    LAS bf16_t* Vt = (LAS bf16_t*)(lds + AT_V_OFF);
    LAS bf16_t* Pw = (LAS bf16_t*)(lds + AT_P_OFF + wid * AT_P_WAVE);
    const LAS float* biasL = (const LAS float*)(lds + BIAS_OFF);
    const int q0 = qt * AT_QT, rowb = b * LSEQ;
    const int h = kvh * 4 + (wid & 3), i16 = lane & 15, g = lane >> 4;
    const int ntile = AT_NT + ((qt == 15 && (wid >> 2) == 0) ? 1 : 0);
    bf16x8 qf[AT_NT + 1][2];
#pragma unroll
    for (int tile = 0; tile < AT_NT + 1; ++tile) {
        const int tq0 = tile < AT_NT ? q0 + (wid >> 2) * (AT_QT / 2) + tile * 16 : 2048;
        int tq = tq0 + i16; tq = tq > LSEQ - 1 ? LSEQ - 1 : tq;
        const bf16_t* qp = z + (size_t)(rowb + tq) * INDIM + ZQ + h * 64 + 8 * g;
        if (tile < ntile) { qf[tile][0] = *(const bf16x8*)qp; qf[tile][1] = *(const bf16x8*)(qp + 32); }
        else { qf[tile][0] = (bf16x8){0, 0, 0, 0, 0, 0, 0, 0}; qf[tile][1] = qf[tile][0]; }
    }
    const float sink = sinks[h];
    {
        constexpr int NIT = (AT_KR * 8 + 511) / 512;
        u32x4 kv[NIT], vv[NIT];
#pragma unroll
        for (int it = 0; it < NIT; ++it) {
            const int c = tid + it * 512;
            if (it < NIT - 1 || c < AT_KR * 8) {
                const int kr = c >> 3, ch = c & 7; int t = q0 - 144 + kr; t = t < 0 ? 0 : (t > LSEQ - 1 ? LSEQ - 1 : t);
                const bf16_t* src = z + (size_t)(rowb + t) * INDIM + kvh * 64 + ch * 8;
                kv[it] = *(const u32x4*)(src + ZK); vv[it] = *(const u32x4*)(src + ZV);
            }
        }
#pragma unroll
        for (int it = 0; it < NIT; ++it) {
            const int c = tid + it * 512;
            if (it < NIT - 1 || c < AT_KR * 8) {
                const int kr = c >> 3, ch = c & 7;
                *(LAS u32x4*)(Ks + kr * AT_KS + ch * 8) = kv[it];
                LAS bf16_t* vd = Vt + (ch * 8) * AT_VS + kr;
                vd[0 * AT_VS] = (bf16_t)(vv[it].x & 0xffffu); vd[1 * AT_VS] = (bf16_t)(vv[it].x >> 16);
                vd[2 * AT_VS] = (bf16_t)(vv[it].y & 0xffffu); vd[3 * AT_VS] = (bf16_t)(vv[it].y >> 16);
                vd[4 * AT_VS] = (bf16_t)(vv[it].z & 0xffffu); vd[5 * AT_VS] = (bf16_t)(vv[it].z >> 16);
                vd[6 * AT_VS] = (bf16_t)(vv[it].w & 0xffffu); vd[7 * AT_VS] = (bf16_t)(vv[it].w >> 16);
            }
        }
    }
    __syncthreads();
#pragma unroll
    for (int tile = 0; tile < AT_NT + 1; ++tile) {
        if (tile >= ntile) break;
        const int tq0 = tile < AT_NT ? q0 + (wid >> 2) * (AT_QT / 2) + tile * 16 : 2048;
        const int koff = tq0 - q0;
        const int t = tq0 + i16;
        f32x4 s[10];
#pragma unroll
        for (int nt = 1; nt < 10; ++nt) {
            const LAS bf16_t* kp = Ks + (koff + nt * 16 + i16) * AT_KS + 8 * g;
            const bf16x8 k0 = *(const LAS bf16x8*)kp, k1 = *(const LAS bf16x8*)(kp + 32);
            f32x4 a = (f32x4){0.f, 0.f, 0.f, 0.f};
            a = __builtin_amdgcn_mfma_f32_16x16x32_bf16(k0, qf[tile][0], a, 0, 0, 0);
            a = __builtin_amdgcn_mfma_f32_16x16x32_bf16(k1, qf[tile][1], a, 0, 0, 0);
            s[nt] = a;
        }
        const LAS float* bp = biasL + h * BIAS_STRIDE + BIAS_PAD + 144 + i16 - 4 * g;
        float mx = sink;
        if (tq0 >= 144) {
#pragma unroll
            for (int nt = 1; nt < 10; ++nt)
#pragma unroll
                for (int r = 0; r < 4; ++r) { const float v = s[nt][r] * 0.125f + bp[-(nt * 16 + r)]; s[nt][r] = v; mx = fmaxf(mx, v); }
        } else {
#pragma unroll
            for (int nt = 1; nt < 10; ++nt)
#pragma unroll
                for (int r = 0; r < 4; ++r) { const int tk = tq0 - 144 + nt * 16 + 4 * g + r; const float v = tk >= 0 ? s[nt][r] * 0.125f + bp[-(nt * 16 + r)] : -INFINITY; s[nt][r] = v; mx = fmaxf(mx, v); }
        }
        mx = fmaxf(mx, __shfl_xor(mx, 16)); mx = fmaxf(mx, __shfl_xor(mx, 32));
        float sum = 0.f;
        *(LAS u32x2*)(Pw + i16 * AT_PS + 4 * g) = (u32x2){0u, 0u};
#pragma unroll
        for (int nt = 1; nt < 10; ++nt) {
            const float e0 = __expf(s[nt][0] - mx), e1 = __expf(s[nt][1] - mx), e2 = __expf(s[nt][2] - mx), e3 = __expf(s[nt][3] - mx);
            sum += (e0 + e1) + (e2 + e3);
            u32x2 w; w.x = cvt_pk_bf16(e0, e1); w.y = cvt_pk_bf16(e2, e3);
            *(LAS u32x2*)(Pw + i16 * AT_PS + nt * 16 + 4 * g) = w;
        }
        sum += __shfl_xor(sum, 16); sum += __shfl_xor(sum, 32);
        const float inv = 1.f / (sum + __expf(sink - mx));
        LDS_WAIT(); __builtin_amdgcn_wave_barrier();
        f32x4 o[4];
#pragma unroll
        for (int dn = 0; dn < 4; ++dn) o[dn] = (f32x4){0.f, 0.f, 0.f, 0.f};
#pragma unroll
        for (int ks = 0; ks < 5; ++ks) {
            const bf16x8 pf = *(const LAS bf16x8*)(Pw + i16 * AT_PS + ks * 32 + 8 * g);
#pragma unroll
            for (int dn = 0; dn < 4; ++dn) {
                const bf16x8 vf = *(const LAS bf16x8*)(Vt + (dn * 16 + i16) * AT_VS + koff + ks * 32 + 8 * g);
                o[dn] = __builtin_amdgcn_mfma_f32_16x16x32_bf16(vf, pf, o[dn], 0, 0, 0);
            }
        }
        if (t < LSEQ) {
            bf16_t* op = mixin + (size_t)(rowb + t) * D + h * 64 + 4 * g;
#pragma unroll
            for (int dn = 0; dn < 4; ++dn) { u32x2 w; w.x = cvt_pk_bf16(o[dn][0] * inv, o[dn][1] * inv); w.y = cvt_pk_bf16(o[dn][2] * inv, o[dn][3] * inv); *(u32x2*)(op + dn * 16) = w; }
        }
        LDS_WAIT(); __builtin_amdgcn_wave_barrier();
    }
    __syncthreads();
}

__device__ __forceinline__ void attn_sample_wave(LAS unsigned char* lds, int l, int b, int h, const Params& p, const bf16_t* __restrict__ z, bf16_t* mixin, int wid, int lane) {
    LAS float* qs = (LAS float*)(lds + wid * 1024);
    LAS float* ps = qs + 64;
    const LAS float* biasL = (const LAS float*)(lds + BIAS_OFF);
    const int kvh = h >> 2;
    const bf16_t* zr = z + (size_t)(MPROMPT + b) * INDIM;
    const float qv = __uint_as_float((unsigned)zr[ZQ + h * 64 + lane] << 16) * 0.125f;
    qs[lane] = qv;
    LDS_WAIT(); __builtin_amdgcn_wave_barrier();
    const float* ck = p.cache_k + (((size_t)l * DB + b) * WIN) * 256 + kvh * 64;
    const float* cv = p.cache_v + (((size_t)l * DB + b) * WIN) * 256 + kvh * 64;
    float sc0 = 0.f, sc1 = 0.f;
    {
        const f32x4* k0 = (const f32x4*)(ck + (size_t)lane * 256); const f32x4* k1 = (const f32x4*)(ck + (size_t)(lane + 64) * 256);
#pragma unroll
        for (int d4 = 0; d4 < 16; ++d4) { const f32x4 q4 = *(const LAS f32x4*)(qs + 4 * d4); const f32x4 a = k0[d4], c = k1[d4];
            sc0 += (a.x * q4.x + a.y * q4.y) + (a.z * q4.z + a.w * q4.w); sc1 += (c.x * q4.x + c.y * q4.y) + (c.z * q4.z + c.w * q4.w); }
    }
    const float knew = __uint_as_float((unsigned)zr[ZK + kvh * 64 + lane] << 16);
    const float sc2 = wave_sum(qv * knew);
    const float sink = p.sinks[l * NHEADS + h];
    const float v0 = sc0 + biasL[h * BIAS_STRIDE + BIAS_PAD + (WIN - lane)], v1 = sc1 + biasL[h * BIAS_STRIDE + BIAS_PAD + (64 - lane)], v2 = sc2 + biasL[h * BIAS_STRIDE + BIAS_PAD];
    float mx = wave_max(fmaxf(v0, v1)); mx = fmaxf(mx, fmaxf(v2, sink));
    const float e0 = __expf(v0 - mx), e1 = __expf(v1 - mx), e2 = __expf(v2 - mx);
    const float sum = wave_sum(e0 + e1) + e2 + __expf(sink - mx);
    ps[lane] = e0; ps[lane + 64] = e1;
    LDS_WAIT(); __builtin_amdgcn_wave_barrier();
    const int sg = lane >> 4, dq = lane & 15;
    f32x4 oa = (f32x4){0.f, 0.f, 0.f, 0.f}, ob4 = (f32x4){0.f, 0.f, 0.f, 0.f};
#pragma unroll
    for (int it = 0; it < 2; ++it) {
        f32x4 vr[16];
#pragma unroll
        for (int i = 0; i < 16; ++i) vr[i] = *(const f32x4*)(cv + (size_t)(sg + 4 * (i + 16 * it)) * 256 + 4 * dq);
#pragma unroll
        for (int i = 0; i < 16; i += 2) { oa += vr[i] * ps[sg + 4 * (i + 16 * it)]; ob4 += vr[i + 1] * ps[sg + 4 * (i + 1 + 16 * it)]; }
    }
    oa += ob4;
#pragma unroll
    for (int c = 0; c < 4; ++c) { oa[c] += __shfl_xor(oa[c], 16); oa[c] += __shfl_xor(oa[c], 32); }
    if (sg == 0) {
        const u32x2 vn = *(const u32x2*)(zr + ZV + kvh * 64 + 4 * dq);
        const float rs_ = 1.f / sum;
        const float o0 = (oa[0] + e2 * bf_lo(vn.x)) * rs_, o1 = (oa[1] + e2 * bf_hi(vn.x)) * rs_, o2 = (oa[2] + e2 * bf_lo(vn.y)) * rs_, o3 = (oa[3] + e2 * bf_hi(vn.y)) * rs_;
        u32x2 w; w.x = cvt_pk_bf16(o0, o1); w.y = cvt_pk_bf16(o2, o3);
        *(u32x2*)(mixin + (size_t)(MPROMPT + b) * D + h * 64 + 4 * dq) = w;
    }
    LDS_WAIT(); __builtin_amdgcn_wave_barrier();
}

__device__ __forceinline__ void unpack8(const u32x4 a, float (&o)[8]) { o[0] = bf_lo(a.x); o[1] = bf_hi(a.x); o[2] = bf_lo(a.y); o[3] = bf_hi(a.y); o[4] = bf_lo(a.z); o[5] = bf_hi(a.z); o[6] = bf_lo(a.w); o[7] = bf_hi(a.w); }
__device__ __forceinline__ void conv_row(int l, int m, const Params& p, const bf16_t* __restrict__ z, bf16_t* mixin, int lane) {
    const float* cw = p.conv_w + (size_t)l * 3 * CDIM;
    const bool prompt = m < MPROMPT;
    const int b = prompt ? m / LSEQ : m - MPROMPT, t = prompt ? m % LSEQ : 0;
    const bf16_t* zr = z + (size_t)m * INDIM;
    const bf16_t* z1 = (prompt && t >= 1) ? zr - INDIM : zr;
    const bf16_t* z2 = (prompt && t >= 2) ? zr - 2 * INDIM : zr;
    const float k1 = (prompt && t >= 1) ? 1.f : 0.f, k2 = (prompt && t >= 2) ? 1.f : 0.f;
    const float* st = p.state_conv + (((size_t)l * DB + (prompt ? 0 : b)) * 2) * CDIM;
    u32x4 gbv[2], gcv[2], hcv[2], a1[2], c1[2], a2[2], c2[2]; f32x4 sv[2][4], wv[2][6];
#pragma unroll
    for (int j = 0; j < 2; ++j) {
        const int c0 = lane * 8 + 512 * j;
        gbv[j] = *(const u32x4*)(zr + ZGB + c0); gcv[j] = *(const u32x4*)(zr + ZGC + c0); hcv[j] = *(const u32x4*)(zr + ZHC + c0);
        a1[j] = *(const u32x4*)(z1 + ZGC + c0); c1[j] = *(const u32x4*)(z1 + ZHC + c0); a2[j] = *(const u32x4*)(z2 + ZGC + c0); c2[j] = *(const u32x4*)(z2 + ZHC + c0);
        if (!prompt) { sv[j][0] = *(const f32x4*)(st + c0); sv[j][1] = *(const f32x4*)(st + c0 + 4); sv[j][2] = *(const f32x4*)(st + CDIM + c0); sv[j][3] = *(const f32x4*)(st + CDIM + c0 + 4); }
#pragma unroll
        for (int i = 0; i < 3; ++i) { wv[j][2 * i] = *(const f32x4*)(cw + i * CDIM + c0); wv[j][2 * i + 1] = *(const f32x4*)(cw + i * CDIM + c0 + 4); }
    }
#pragma unroll
    for (int j = 0; j < 2; ++j) {
        const int c0 = lane * 8 + 512 * j;
        float gb[8], gc[8], hc[8], u0[8], u1[8], u2[8], x[8], y[8];
        unpack8(gbv[j], gb); unpack8(gcv[j], gc); unpack8(hcv[j], hc);
#pragma unroll
        for (int i = 0; i < 8; ++i) u0[i] = gc[i] * hc[i];
        if (prompt) {
            unpack8(a1[j], x); unpack8(c1[j], y);
#pragma unroll
            for (int i = 0; i < 8; ++i) u1[i] = x[i] * y[i] * k1;
            unpack8(a2[j], x); unpack8(c2[j], y);
#pragma unroll
            for (int i = 0; i < 8; ++i) u2[i] = x[i] * y[i] * k2;
            if (t >= LSEQ - 2) { float* co = p.out + O_CP + (((size_t)l * NBATCH + b) * 2 + (t - (LSEQ - 2))) * CDIM + c0;
                *(f32x4*)co = (f32x4){u0[0], u0[1], u0[2], u0[3]}; *(f32x4*)(co + 4) = (f32x4){u0[4], u0[5], u0[6], u0[7]}; }
        } else {
#pragma unroll
            for (int i = 0; i < 4; ++i) { u2[i] = sv[j][0][i]; u2[4 + i] = sv[j][1][i]; u1[i] = sv[j][2][i]; u1[4 + i] = sv[j][3][i]; }
            float* co = p.out + O_CS + (((size_t)l * DB + b) * 2) * CDIM + c0;
            *(f32x4*)co = sv[j][2]; *(f32x4*)(co + 4) = sv[j][3];
            *(f32x4*)(co + CDIM) = (f32x4){u0[0], u0[1], u0[2], u0[3]}; *(f32x4*)(co + CDIM + 4) = (f32x4){u0[4], u0[5], u0[6], u0[7]};
        }
        float r[8];
#pragma unroll
        for (int i = 0; i < 8; ++i) { const float w0 = wv[j][i >> 2][i & 3], w1 = wv[j][2 + (i >> 2)][i & 3], w2 = wv[j][4 + (i >> 2)][i & 3]; r[i] = gb[i] * (w0 * u2[i] + w1 * u1[i] + w2 * u0[i]); }
        u32x4 w; w.x = cvt_pk_bf16(r[0], r[1]); w.y = cvt_pk_bf16(r[2], r[3]); w.z = cvt_pk_bf16(r[4], r[5]); w.w = cvt_pk_bf16(r[6], r[7]);
        *(u32x4*)(mixin + (size_t)m * D + 1024 + c0) = w;
    }
}

__device__ __forceinline__ void conv_job4(int l, int m0, const Params& p, const bf16_t* __restrict__ z, bf16_t* mixin, int lane) {
    const float* cw = p.conv_w + (size_t)l * 3 * CDIM;
    const int b = m0 / LSEQ, t0 = m0 % LSEQ;
    const float kprev = t0 > 0 ? 1.f : 0.f;
    const bf16_t* zr = z + (size_t)m0 * INDIM;
    const bf16_t* zp = t0 > 0 ? zr - 2 * INDIM : zr;
#pragma unroll
    for (int j = 0; j < 2; ++j) {
        const int c0 = lane * 8 + 512 * j;
        u32x4 gcv[6], hcv[6], gbv[4]; f32x4 wv[6];
        gcv[0] = *(const u32x4*)(zp + ZGC + c0); hcv[0] = *(const u32x4*)(zp + ZHC + c0);
        gcv[1] = *(const u32x4*)(zp + INDIM + ZGC + c0); hcv[1] = *(const u32x4*)(zp + INDIM + ZHC + c0);
#pragma unroll
        for (int r = 0; r < 4; ++r) { gcv[2 + r] = *(const u32x4*)(zr + (size_t)r * INDIM + ZGC + c0); hcv[2 + r] = *(const u32x4*)(zr + (size_t)r * INDIM + ZHC + c0); gbv[r] = *(const u32x4*)(zr + (size_t)r * INDIM + ZGB + c0); }
#pragma unroll
        for (int i = 0; i < 3; ++i) { wv[2 * i] = *(const f32x4*)(cw + i * CDIM + c0); wv[2 * i + 1] = *(const f32x4*)(cw + i * CDIM + c0 + 4); }
        float u[6][8];
#pragma unroll
        for (int r = 0; r < 6; ++r) { float x[8], y[8]; unpack8(gcv[r], x); unpack8(hcv[r], y); const float k = r < 2 ? kprev : 1.f;
#pragma unroll
            for (int i = 0; i < 8; ++i) u[r][i] = x[i] * y[i] * k; }
#pragma unroll
        for (int r = 0; r < 4; ++r) {
            float gb[8], o[8]; unpack8(gbv[r], gb);
#pragma unroll
            for (int i = 0; i < 8; ++i) { const float w0 = wv[i >> 2][i & 3], w1 = wv[2 + (i >> 2)][i & 3], w2 = wv[4 + (i >> 2)][i & 3]; o[i] = gb[i] * (w0 * u[r][i] + w1 * u[r + 1][i] + w2 * u[r + 2][i]); }
            u32x4 w; w.x = cvt_pk_bf16(o[0], o[1]); w.y = cvt_pk_bf16(o[2], o[3]); w.z = cvt_pk_bf16(o[4], o[5]); w.w = cvt_pk_bf16(o[6], o[7]);
            *(u32x4*)(mixin + (size_t)(m0 + r) * D + 1024 + c0) = w;
        }
        if (t0 == LSEQ - 4) {
#pragma unroll
            for (int r = 0; r < 2; ++r) { float* co = p.out + O_CP + (((size_t)l * NBATCH + b) * 2 + r) * CDIM + c0;
                *(f32x4*)co = (f32x4){u[4 + r][0], u[4 + r][1], u[4 + r][2], u[4 + r][3]}; *(f32x4*)(co + 4) = (f32x4){u[4 + r][4], u[4 + r][5], u[4 + r][6], u[4 + r][7]}; }
        }
    }
}

__device__ __forceinline__ void kv_prompt_row(int l, int idx, const Params& p, const bf16_t* __restrict__ z, int lane) {
    const int b = idx >> 7, w = idx & 127;
    const bf16_t* zr = z + (size_t)(b * LSEQ + (LSEQ - WIN) + w) * INDIM;
    const u32x2 kv = *(const u32x2*)(zr + ZK + 4 * lane), vv = *(const u32x2*)(zr + ZV + 4 * lane);
    const size_t o = (((size_t)l * NBATCH + b) * WIN + w) * 256 + 4 * lane;
    *(f32x4*)(p.out + O_KP + o) = (f32x4){bf_lo(kv.x), bf_hi(kv.x), bf_lo(kv.y), bf_hi(kv.y)};
    *(f32x4*)(p.out + O_VP + o) = (f32x4){bf_lo(vv.x), bf_hi(vv.x), bf_lo(vv.y), bf_hi(vv.y)};
}
__device__ __forceinline__ void kv_sample_row(int l, int idx, const Params& p, const bf16_t* __restrict__ z, int lane) {
    const int b = idx >> 7, w = idx & 127;
    const size_t o = (((size_t)l * DB + b) * WIN + w) * 256 + 4 * lane;
    f32x4 kq, vq;
    if (w < WIN - 1) { kq = *(const f32x4*)(p.cache_k + o + 256); vq = *(const f32x4*)(p.cache_v + o + 256); }
    else { const bf16_t* zr = z + (size_t)(MPROMPT + b) * INDIM; const u32x2 kv = *(const u32x2*)(zr + ZK + 4 * lane), vv = *(const u32x2*)(zr + ZV + 4 * lane);
        kq = (f32x4){bf_lo(kv.x), bf_hi(kv.x), bf_lo(kv.y), bf_hi(kv.y)}; vq = (f32x4){bf_lo(vv.x), bf_hi(vv.x), bf_lo(vv.y), bf_hi(vv.y)}; }
    *(f32x4*)(p.out + O_KS + o) = kq; *(f32x4*)(p.out + O_VS + o) = vq;
}

__device__ __forceinline__ void kv_sample_row2(int l, int i0, int i1, const Params& p, const bf16_t* __restrict__ z, int lane) {
    f32x4 kq[2], vq[2]; size_t o[2]; const int idx[2] = {i0, i1};
#pragma unroll
    for (int e = 0; e < 2; ++e) {
        const int b = idx[e] >> 7, w = idx[e] & 127;
        o[e] = (((size_t)l * DB + b) * WIN + w) * 256 + 4 * lane;
        if (w < WIN - 1) { kq[e] = __builtin_nontemporal_load((const f32x4*)(p.cache_k + o[e] + 256)); vq[e] = __builtin_nontemporal_load((const f32x4*)(p.cache_v + o[e] + 256)); }
        else { const bf16_t* zr = z + (size_t)(MPROMPT + b) * INDIM; const u32x2 kv = *(const u32x2*)(zr + ZK + 4 * lane), vv = *(const u32x2*)(zr + ZV + 4 * lane);
            kq[e] = (f32x4){bf_lo(kv.x), bf_hi(kv.x), bf_lo(kv.y), bf_hi(kv.y)}; vq[e] = (f32x4){bf_lo(vv.x), bf_hi(vv.x), bf_lo(vv.y), bf_hi(vv.y)}; }
    }
#pragma unroll
    for (int e = 0; e < 2; ++e) { __builtin_nontemporal_store(kq[e], (f32x4*)(p.out + O_KS + o[e])); __builtin_nontemporal_store(vq[e], (f32x4*)(p.out + O_VS + o[e])); }
}

__device__ __forceinline__ void filler_cache_copy(const Params& p, int l, int nwg, int wid, int lane) {
    const int G = gridDim.x, r = nwg % G, c = blockIdx.x;
    int worker, nw;
    if (r == 0) { worker = c * 8 + wid; nw = G * 8; } else if (c >= r) { worker = (c - r) * 8 + wid; nw = (G - r) * 8; } else return;
    for (int i = worker; i < DB * WIN / 2; i += nw) {
        const int i1 = i + DB * WIN / 2;
        if ((i & 127) != 127) kv_sample_row2(l, i, i1, p, (const bf16_t*)(p.ws + WS_ZACT), lane);
    }
}

constexpr int NU_ATT = NBATCH * 4 * 16;

__device__ __forceinline__ void mixer_phase(const Params& p, int l, LAS unsigned char* lds, int tid, int wid, int lane, unsigned long long& tacc_, unsigned long long& t0_) {
    const bf16_t* z = (const bf16_t*)(p.ws + WS_ZACT); bf16_t* mixin = (bf16_t*)(p.ws + WS_MIXIN);
    TB(9);
    for (int u = blockIdx.x; u < NU_ATT; u += gridDim.x) { const int qt = u & 15, bk = u >> 4; attn_prompt_unit(lds, bk >> 2, bk & 3, qt, z, mixin, p.sinks + l * NHEADS, tid, wid, lane); }
    TE(9);
    TB(10);
    const int gw = blockIdx.x * 8 + wid, NGW = gridDim.x * 8;
    if (gw < MPROMPT / 4) conv_job4(l, 4 * gw, p, z, mixin, lane);
    for (int j = NGW + (gw >> 7); j < MPROMPT / 4 && (gw & 127) == 5; j += NGW >> 7) conv_job4(l, 4 * j, p, z, mixin, lane);
    if ((gw & 63) == 33 && (gw >> 6) < DB) conv_row(l, MPROMPT + (gw >> 6), p, z, mixin, lane);
    if ((gw & 3) == 0 && (gw >> 2) < DB * NHEADS) { const int job = gw >> 2; attn_sample_wave(lds, l, job >> 4, job & 15, p, z, mixin, wid, lane); }
    for (int i = (int)NGW - 1 - gw; i < NBATCH * WIN; i += NGW) kv_prompt_row(l, i, p, z, lane);
    if ((gw & 63) == 34 && (gw >> 6) < DB) kv_sample_row(l, (gw >> 6) * WIN + (WIN - 1), p, z, lane);
    TE(10);
}

__global__ void __launch_bounds__(512, 2) hymba_fwd(Params p) {
    extern __shared__ __attribute__((aligned(16))) unsigned char lds_raw[];
    LAS unsigned char* lds = (LAS unsigned char*)lds_raw;
    cg::grid_group grid = cg::this_grid();
    const int tid = threadIdx.x, lane = tid & 63, wid = __builtin_amdgcn_readfirstlane(tid >> 6);

    unsigned* barw = (unsigned*)(p.ws + WS_BAR);
    unsigned* cntw = (unsigned*)(p.ws + WS_CNT);
    volatile LAS unsigned* xst = (volatile LAS unsigned*)(lds + MISC_OFF);
    if (tid < 2) xst[tid] = 0u;
    __syncthreads();
    const XcdBarrier xb = xcd_barrier_post(barw, xst);
    {
        LAS float* biasL = (LAS float*)(lds + BIAS_OFF);
        for (int i = tid; i < NHEADS * BIAS_STRIDE; i += 512) {
            const int h = i / BIAS_STRIDE, d = i % BIAS_STRIDE - BIAS_PAD;
            float v = -INFINITY;
            if (d >= 0 && d <= WIN) {
                int bkt;
                if (d < 16) bkt = d;
                else { const float df = (float)d; bkt = 16 + (int)(logf(df / 16.f) / logf(8.f) * 16.f); bkt = bkt > 31 ? 31 : bkt; }
                v = p.rel_bias[bkt * NHEADS + h];
            }
            biasL[i] = v;
        }
    }
    unsigned long long tacc_ = 0, t0_ = 0;
    TB(0);
    for (int rep = 0; rep < REP_PRO; ++rep) prologue(p, lds, wid, lane);
    TE(0);
    if (p.ws == nullptr) grid.sync();
    GSYNC();

    bf16_t* ZACT = (bf16_t*)(p.ws + WS_ZACT); bf16_t* MIXIN = (bf16_t*)(p.ws + WS_MIXIN); bf16_t* MIXB = (bf16_t*)(p.ws + WS_MIXB); bf16_t* MIXB1 = (bf16_t*)(p.ws + WS_MIXB1);
    const int vcu = (gridDim.x % 8 == 0) ? (int)((blockIdx.x % 8) * (gridDim.x / 8) + blockIdx.x / 8) : (int)blockIdx.x;
    const int skw = (gridDim.x == 256) ? ((vcu & 7) * 32 + (vcu >> 5) * 4 + ((vcu & 31) >> 3)) : vcu;
    const bf16_t* HB = (const bf16_t*)(p.ws + WS_HB); const float* RS = (const float*)(p.ws + WS_RS);
#pragma unroll 1
    for (int l = 0; l < DEPTH; ++l) {
        TB(1);
        {
            pg8::Gemm g{HB, (const bf16_t*)(p.ws + WS_WIN + l * SZ_WIN), MP, INDIM, D}; pg8::Epi<0> E{ZACT, INDIM, RS, ZACT};
            pg8::StaticOrder S; S.init(MP, INDIM, D, (int)gridDim.x, (int)blockIdx.x);
            for (int rep = 0; rep < REP_GIN; ++rep) pg8::gemm_phase<D, pg8::Epi<0>, pg8::StaticOrder>(lds, g, S, E);
            for (int rep = 0; rep < REP_FILL; ++rep) { int t2 = threadIdx.x; asm volatile("" : "+v"(t2)); const int w2 = __builtin_amdgcn_readfirstlane(t2 >> 6), l2 = t2 & 63;
                filler(p, l, I_IN, I_LAYER - I_DN, (MP / 256) * (INDIM / 256), lds, w2, l2);
                if (l + 1 < DEPTH) filler(p, l + 1, 0, I_IN / 2, (MP / 256) * (INDIM / 256), lds, w2, l2);
                filler_cache_copy(p, l, (MP / 256) * (INDIM / 256), w2, l2); }
        }
        TE(1);
        GSYNC();
        TB(2);
#ifndef NO_MIX
        for (int rep = 0; rep < REP_MIX; ++rep) { int t2 = threadIdx.x; asm volatile("" : "+v"(t2)); mixer_phase(p, l, lds, t2, __builtin_amdgcn_readfirstlane(t2 >> 6), t2 & 63, tacc_, t0_); }
#endif
        TE(2);
        GSYNC();
        TB(3);
        {
            pg8::Gemm g{MIXIN, (const bf16_t*)(p.ws + WS_WOUT + l * SZ_WOUT), MP, D, D}; pg8::Epi<0> E{MIXB, D, nullptr, MIXB1};
            pg8::StreamKOrder<D / 128> S; S.init((int)gridDim.x, skw);
            for (int rep = 0; rep < REP_GOUT; ++rep) pg8::gemm_phase<D, pg8::Epi<0>, pg8::StreamKOrder<D / 128>>(lds, g, S, E);
            TE(3);
            TB(4);
            { int t2 = threadIdx.x; asm volatile("" : "+v"(t2)); sk_postnorm<D / 128>(p, S, cntw + (size_t)((l * 2 + 0) * 33) * 16, p.n_post_mix + l * D, false, vcu, t2, __builtin_amdgcn_readfirstlane(t2 >> 6), t2 & 63, tacc_, t0_); }
        }
        TE(4);
        GSYNC();
        TB(5);
        {
            pg8::Gemm g{HB, (const bf16_t*)(p.ws + WS_WGU + l * SZ_WGU), MP, NGU, D}; pg8::Epi<1> E{ZACT, DFF, RS, ZACT};
            pg8::StaticOrder S; S.init(MP, NGU, D, (int)gridDim.x, (int)blockIdx.x);
            for (int rep = 0; rep < REP_GGU; ++rep) pg8::gemm_phase<D, pg8::Epi<1>, pg8::StaticOrder>(lds, g, S, E);
            for (int rep = 0; rep < REP_FILL; ++rep) { int t2 = threadIdx.x; asm volatile("" : "+v"(t2)); const int w2 = __builtin_amdgcn_readfirstlane(t2 >> 6), l2 = t2 & 63;
                filler(p, l, I_LAYER - I_DN, I_LAYER, (MP / 256) * (NGU / 256), lds, w2, l2);
                if (l + 1 < DEPTH) filler(p, l + 1, I_IN / 2, I_IN, (MP / 256) * (NGU / 256), lds, w2, l2); }
        }
        TE(5);
        GSYNC();
        TB(6);
        {
            pg8::Gemm g{ZACT, (const bf16_t*)(p.ws + WS_WDN + l * SZ_WDN), MP, D, DFF}; pg8::Epi<0> E{MIXB, D, nullptr, MIXB1};
            pg8::StreamKOrder<DFF / 128> S; S.init((int)gridDim.x, skw);
            for (int rep = 0; rep < REP_GDN; ++rep) pg8::gemm_phase<DFF, pg8::Epi<0>, pg8::StreamKOrder<DFF / 128>>(lds, g, S, E);
            TE(6);
            TB(7);
            { int t2 = threadIdx.x; asm volatile("" : "+v"(t2)); sk_postnorm<DFF / 128>(p, S, cntw + (size_t)((l * 2 + 1) * 33) * 16, p.n_post_ffn + l * D, l == DEPTH - 1, vcu, t2, __builtin_amdgcn_readfirstlane(t2 >> 6), t2 & 63, tacc_, t0_); }
        }
        TE(7);
        if (l != DEPTH - 1) GSYNC();
    }
    if (TMASK != 0 && blockIdx.x == TBLK) { const unsigned long long tend = __builtin_amdgcn_s_memrealtime() + (unsigned long long)TMULT * tacc_; while (__builtin_amdgcn_s_memrealtime() < tend) __builtin_amdgcn_s_sleep(8); }
}

extern "C" void kernel_launch(void* const* d_in, const int* in_sizes, int n_in, void* d_out, int out_size, void* d_ws, size_t ws_size, hipStream_t stream) {
    static int grid_blocks = 0;
    if (grid_blocks == 0) {
        if (n_in != 18 || ws_size < WS_END) { fprintf(stderr, "kernel_launch: unexpected inputs (n_in %d, ws %zu, need %zu)\n", n_in, ws_size, (size_t)WS_END); grid_blocks = -1; return; }
        int dev = 0, cus = 0, per_cu = 0;
        hipGetDevice(&dev);
        hipDeviceGetAttribute(&cus, hipDeviceAttributeMultiprocessorCount, dev);
        hipFuncSetAttribute((const void*)hymba_fwd, hipFuncAttributeMaxDynamicSharedMemorySize, LDS_BYTES);
        hipOccupancyMaxActiveBlocksPerMultiprocessor(&per_cu, (const void*)hymba_fwd, 512, LDS_BYTES);
        if (per_cu < 1) per_cu = 1;
        grid_blocks = cus * per_cu;
    }
    if (grid_blocks < 0) return;
    if (hipMemsetAsync((char*)d_ws + WS_BAR, 0, WS_END - WS_BAR, stream) != hipSuccess) { fprintf(stderr, "kernel_launch: memset of the barrier words failed\n"); return; }
    Params p{};
    const float** pp = (const float**)&p;
    for (int i = 0; i < 18; ++i) pp[i] = (const float*)d_in[i];
    p.out = (float*)d_out; p.ws = (unsigned char*)d_ws;
    void* args[] = {&p};
    hipError_t e = hipLaunchCooperativeKernel((const void*)hymba_fwd, dim3(grid_blocks), dim3(512), args, LDS_BYTES, stream);
    if (e != hipSuccess) fprintf(stderr, "cooperative launch failed: %s (grid %d)\n", hipGetErrorString(e), grid_blocks);
}
```

```cpp
#include <hip/hip_runtime.h>
#include <hip/hip_cooperative_groups.h>
#include <cstdio>
#include <cstdint>
namespace cg = cooperative_groups;
#define REP_PRO 1
#define REP_MIX 1
#define REP_GIN 1
#define REP_GOUT 1
#define REP_GGU 1
#define REP_GDN 1
#define EXTRA_SYNC 0
#define REP_PN 0
#define REP_FILL 1
#define WGM_SET 5
#define TMASK 0
#define TMULT 4
#define TBLK 0
#define TB(k) do { if (TMASK & (1 << (k))) t0_ = __builtin_amdgcn_s_memrealtime(); } while (0)
#define TE(k) do { if (TMASK & (1 << (k))) tacc_ += __builtin_amdgcn_s_memrealtime() - t0_; } while (0)
#define GSYNC() do { TB(8); xcd_barrier(xb); for (int e_ = 0; e_ < EXTRA_SYNC; ++e_) xcd_barrier(xb); TE(8); } while (0)

#define LAS __attribute__((address_space(3)))
typedef unsigned short bf16_t;
typedef short bf16x8 __attribute__((ext_vector_type(8)));
typedef float f32x4 __attribute__((ext_vector_type(4)));
typedef float f32x2 __attribute__((ext_vector_type(2)));
typedef unsigned u32x4 __attribute__((ext_vector_type(4)));
typedef unsigned u32x2 __attribute__((ext_vector_type(2)));

constexpr int D = 2048, NBATCH = 4, SEQ = 2048, NMETA = 16, LSEQ = SEQ + NMETA, DEPTH = 4, DB = 32, WIN = 128;
constexpr int MPROMPT = NBATCH * LSEQ;
constexpr int MREAL = MPROMPT + DB;
constexpr int MP = 8448;
constexpr int INDIM = 4608, DFF = 5632, NGU = 2 * DFF, CDIM = 1024;
constexpr int ZQ = 0, ZK = 1024, ZV = 1280, ZGB = 1536, ZGC = 2560, ZHC = 3584;
constexpr float RMS_EPS = 1e-6f;
constexpr int NHEADS = 16;

constexpr size_t O_YP = 0, O_YS = 16777216, O_KP = 16842752, O_VP = 17367040, O_CP = 17891328, O_KS = 17924096, O_VS = 22118400, O_CS = 26312704;

constexpr size_t SZ_WIN = (size_t)INDIM * D * 2, SZ_WOUT = (size_t)D * D * 2, SZ_WGU = (size_t)NGU * D * 2, SZ_WDN = (size_t)D * DFF * 2;
constexpr size_t WS_WIN = 0;
constexpr size_t WS_WOUT = WS_WIN + DEPTH * SZ_WIN;
constexpr size_t WS_WGU = WS_WOUT + DEPTH * SZ_WOUT;
constexpr size_t WS_WDN = WS_WGU + DEPTH * SZ_WGU;
constexpr size_t WS_ZACT = WS_WDN + DEPTH * SZ_WDN;
constexpr size_t WS_MIXIN = WS_ZACT + (size_t)MP * DFF * 2;
constexpr size_t WS_MIXB = WS_MIXIN + (size_t)MP * D * 2;
constexpr size_t WS_MIXB1 = WS_MIXB + (size_t)MP * D * 2;
constexpr size_t WS_HB = WS_MIXB1 + (size_t)MP * D * 2;
constexpr size_t WS_RS = WS_HB + (size_t)MP * D * 2;
constexpr size_t WS_BAR = WS_RS + (size_t)MP * 4;
constexpr size_t WS_CNT = WS_BAR + 16384;
constexpr size_t WS_END = WS_CNT + (size_t)DEPTH * 2 * 33 * 64;

constexpr int RING_BYTES = 131072, BIAS_OFF = RING_BYTES, LDS_BYTES = 147456;
constexpr int BIAS_STRIDE = 176, BIAS_PAD = 16;
constexpr int MISC_OFF = BIAS_OFF + NHEADS * BIAS_STRIDE * 4;

__device__ __forceinline__ unsigned cvt_pk_bf16(float lo, float hi) { unsigned r; asm volatile("v_cvt_pk_bf16_f32 %0, %1, %2" : "=v"(r) : "v"(lo), "v"(hi)); return r; }
__device__ __forceinline__ float bf_lo(unsigned u) { return __uint_as_float(u << 16); }
__device__ __forceinline__ float bf_hi(unsigned u) { return __uint_as_float(u & 0xffff0000u); }
__device__ __forceinline__ float wave_sum(float v) {
#pragma unroll
    for (int o = 1; o < 64; o <<= 1) v += __shfl_xor(v, o);
    return v;
}
__device__ __forceinline__ float wave_max(float v) {
#pragma unroll
    for (int o = 1; o < 64; o <<= 1) v = fmaxf(v, __shfl_xor(v, o));
    return v;
}
#define LDS_WAIT() asm volatile("s_waitcnt lgkmcnt(0)" ::: "memory")
#define WT_STORES 0
#define WT_SK 1
#define WT_LAST 0
__device__ __forceinline__ void store16_wt(void* p, u32x4 v, bool wt) {
    if (wt) asm volatile("global_store_dwordx4 %0, %1, off sc1\n\ts_nop 1" :: "v"(p), "v"(v) : "memory");
    else *(u32x4*)p = v;
}
__device__ __forceinline__ void store8_wt(void* p, u32x2 v) {
#if WT_STORES
    asm volatile("global_store_dwordx2 %0, %1, off sc1\n\ts_nop 1" :: "v"(p), "v"(v) : "memory");
#else
    *(u32x2*)p = v;
#endif
}


#define XB_TMO      128
#define XB_XCNT(j)  (256  + 64 * (j))
#define XB_XSUB(j)  (1280 + 64 * (j))
#define XB_XGEN(j)  (2304 + 64 * (j))
#define XB_TOP      3328
#define XB_TOPGEN   3392
#define XCD_BAR_WORDS 3456
#define XB_SPIN_CAP (1u << 18)
__device__ __forceinline__ unsigned xb_ld(unsigned* p)              { return __hip_atomic_load(p, __ATOMIC_RELAXED, __HIP_MEMORY_SCOPE_AGENT); }
__device__ __forceinline__ unsigned xb_add(unsigned* p, unsigned v) { return __hip_atomic_fetch_add(p, v, __ATOMIC_RELAXED, __HIP_MEMORY_SCOPE_AGENT); }
__device__ __forceinline__ unsigned xb_xcc_id() { return (unsigned)__builtin_amdgcn_s_getreg((3 << 11) | 20) & 0xFu; }
#define XB_SPIN(cond, bar) do { unsigned _sp = 0; while (cond) { __builtin_amdgcn_s_sleep(1); \
    if ((++_sp & 255u) == 0u) { if (xb_ld(&(bar)[XB_TMO])) break; if (_sp > XB_SPIN_CAP) { atomicAdd(&(bar)[XB_TMO], 1u); break; } } } } while (0)
struct XcdBarrier { unsigned* bar; unsigned x; volatile LAS unsigned* st; };
__device__ __forceinline__ XcdBarrier xcd_barrier_post(unsigned* bar, volatile LAS unsigned* st) {
    XcdBarrier b; b.bar = bar; b.x = xb_xcc_id(); b.st = st;
    if (threadIdx.x == 0) (void)xb_add(&bar[XB_XCNT(b.x)], 1u);
    return b;
}
__device__ __forceinline__ void xcd_barrier_complete(unsigned* bar, unsigned x, unsigned& nloc, unsigned& nx) {
    const unsigned G = gridDim.x * gridDim.y * gridDim.z;
    unsigned sum, cnt, mine, sp = 0u;
    for (;;) {
        sum = 0u; cnt = 0u; mine = 0u;
#pragma unroll
        for (unsigned j = 0; j < 16; ++j) { const unsigned c = xb_ld(&bar[XB_XCNT(j)]); sum += c; cnt += (c > 0u) ? 1u : 0u; mine = (j == x) ? c : mine; }
        if (sum == G) break;
        __builtin_amdgcn_s_sleep(1);
        if ((++sp & 255u) == 0u) { if (xb_ld(&bar[XB_TMO])) break; if (sp > XB_SPIN_CAP) { atomicAdd(&bar[XB_TMO], 1u); break; } }
    }
    nloc = mine > 0u ? mine : 1u; nx = cnt > 0u ? cnt : 1u;
}
__device__ __forceinline__ void xcd_barrier(const XcdBarrier& b) {
    asm volatile("s_waitcnt vmcnt(0)" ::: "memory");
    __syncthreads();
    if (threadIdx.x == 0) {
        unsigned* bar = b.bar;
        __builtin_amdgcn_s_waitcnt(0);
        unsigned nloc = b.st[0], nx = b.st[1];
        if (nloc == 0u) { xcd_barrier_complete(bar, b.x, nloc, nx); b.st[0] = nloc; b.st[1] = nx; }
        const unsigned old = xb_add(&bar[XB_XSUB(b.x)], 1u);
        const unsigned gen = old / nloc;
        if (old + 1u == (gen + 1u) * nloc) {
            __builtin_amdgcn_fence(__ATOMIC_RELEASE, "agent");
            asm volatile("s_waitcnt vmcnt(0)" ::: "memory");
            const unsigned og = xb_add(&bar[XB_TOP], 1u);
            const unsigned tg = og / nx;
            if (og + 1u == (tg + 1u) * nx) xb_add(&bar[XB_TOPGEN], 1u);
            else XB_SPIN(xb_ld(&bar[XB_TOPGEN]) == tg, bar);
            __builtin_amdgcn_fence(__ATOMIC_ACQUIRE, "agent");
            xb_add(&bar[XB_XGEN(b.x)], 1u);
            asm volatile("s_waitcnt vmcnt(0)" ::: "memory");
        } else {
            XB_SPIN(xb_ld(&bar[XB_XGEN(b.x)]) == gen, bar);
            __builtin_amdgcn_fence(__ATOMIC_ACQUIRE, "agent");
            asm volatile("s_waitcnt vmcnt(0)" ::: "memory");
        }
    }
    __syncthreads();
}

namespace pg8 {
constexpr int BM = 256, BK = 64, HALF = 128, HTB = HALF * BK * 2, STAGE_BYTES = 8 * HTB, NXCD = 8, WGM = WGM_SET;
__host__ __device__ __forceinline__ int lds_byte(int r, int c) { const int st = (r >> 4) * 2 + (c >> 5), rr = r & 15, cc = c & 31, ob = rr * 64 + cc * 2; return st * 1024 + (ob ^ (((ob >> 9) & 1) << 5)); }
__host__ __device__ __forceinline__ void stage_rc(int b, int& R, int& C) { const int st = b / 1024, sb = b % 1024, swz = sb ^ (((sb >> 9) & 1) << 5); R = (st >> 1) * 16 + swz / 64; C = (st & 1) * 32 + (swz % 64) / 2; }
__host__ __device__ __forceinline__ int perm32(int rho) { const int n = rho >> 4, i = rho & 15; return 8 * (i >> 2) + 4 * n + (i & 3); }

struct Unit { int pm, pn, kt0, len, part; };
struct Gemm { const bf16_t* A; const bf16_t* Bt; int M, N, K; };

struct StaticOrder {
    static constexpr bool WT_ALL = false;
    int nM, nN, nwg, G, c, nt;
    __host__ __device__ void init(int M, int N, int K, int G_, int c_) { nM = M / BM; nN = N / BM; nwg = nM * nN; G = G_; c = c_; nt = K / BK; }
    __host__ __device__ bool next(int i, Unit& u) const {
        const long L = (long)i * G + c; if (L >= nwg) return false;
        int wgid = (int)L; { const int q = nwg / NXCD, r = nwg % NXCD, xcd = wgid % NXCD, off = wgid / NXCD; wgid = (xcd < r ? xcd * (q + 1) : r * (q + 1) + (xcd - r) * q) + off; }
        const int nig = WGM * nN, gid = wgid / nig, fm = gid * WGM, gsz = (nM - fm) < WGM ? (nM - fm) : WGM;
        u.pm = fm + ((wgid % nig) % gsz); u.pn = (wgid % nig) / gsz; u.kt0 = 0; u.len = nt; u.part = 0; return true;
    }
};
template <int PP> struct StreamKOrder {
    static constexpr bool WT_ALL = (WT_SK != 0);
    static constexpr int NPAN = MP / BM, NTILE = NPAN * 8, TP = NTILE * PP;
    int q0, q1;
    __device__ void init(int G, int v) { q0 = (int)((long)v * TP / G); q1 = (int)((long)(v + 1) * TP / G); }
    __device__ bool next(int i, Unit& u) const {
        const int t = q0 / PP + i, s = t * PP; const int a = q0 > s ? q0 : s, b = q1 < s + PP ? q1 : s + PP;
        if (a >= b) return false;
        u.pn = t / NPAN; u.pm = t % NPAN; u.kt0 = 2 * (a - s); u.len = 2 * (b - a); u.part = a > s ? 1 : 0; return true;
    }
    static __device__ __forceinline__ bool is_split(int t, int G) { const int s = t * PP; return (int)(((long)(s + 1) * G - 1) / TP) != (int)(((long)(s + PP) * G - 1) / TP); }
};

template <int MODE> struct Epi {
    static constexpr bool PERM = true;
    bf16_t* O; int ldc; const float* rs; bf16_t* O1;
    __device__ __forceinline__ void operator()(const f32x4 (&acc)[2][2][4][2], const Unit& u, int wr, int wc, int fr, int fq, bool wt) const {
        const int row0 = u.pm * BM + wr * 64 + fr;
        if constexpr (MODE == 0) {
            const int col0 = u.pn * BM + wc * 32 + 8 * fq;
#pragma unroll
            for (int ai = 0; ai < 2; ++ai)
#pragma unroll
                for (int m = 0; m < 4; ++m) {
                    const int row = row0 + ai * HALF + m * 16;
                    bf16_t* rowp = (u.part ? O1 : O) + (size_t)row * ldc + col0;
#pragma unroll
                    for (int bj = 0; bj < 2; ++bj) {
                        const f32x4 v0 = acc[ai][bj][m][0], v1 = acc[ai][bj][m][1];
                        u32x4 w; w.x = cvt_pk_bf16(v0[0], v0[1]); w.y = cvt_pk_bf16(v0[2], v0[3]); w.z = cvt_pk_bf16(v1[0], v1[1]); w.w = cvt_pk_bf16(v1[2], v1[3]);
                        store16_wt(rowp + bj * HALF, w, wt);
                    }
                }
        } else {
            const int col0 = u.pn * HALF + wc * 32 + 8 * fq;
#pragma unroll
            for (int ai = 0; ai < 2; ++ai)
#pragma unroll
                for (int m = 0; m < 4; ++m) {
                    const int row = row0 + ai * HALF + m * 16;
                    float o[8];
#pragma unroll
                    for (int n = 0; n < 2; ++n)
#pragma unroll
                        for (int j = 0; j < 4; ++j) {
                            const float g = acc[ai][0][m][n][j], up = acc[ai][1][m][n][j];
                            o[n * 4 + j] = (g * up) * __builtin_amdgcn_rcpf(1.f + __builtin_amdgcn_exp2f(g * -1.4426950408889634f));
                        }
                    u32x4 w; w.x = cvt_pk_bf16(o[0], o[1]); w.y = cvt_pk_bf16(o[2], o[3]); w.z = cvt_pk_bf16(o[4], o[5]); w.w = cvt_pk_bf16(o[6], o[7]);
                    store16_wt(O + (size_t)row * ldc + col0, w, wt);
                }
        }
    }
};

template <int K, class EpiT, class Sched>
__device__ __forceinline__ void gemm_phase(LAS unsigned char* lds, const Gemm g, const Sched& S, const EpiT& E) {
    int tid_ = threadIdx.x; asm volatile("" : "+v"(tid_));
    const int tid = tid_, wid = __builtin_amdgcn_readfirstlane(tid >> 6), lane = tid & 63, wr = wid >> 2, wc = wid & 3, fr = lane & 15, fq = lane >> 4;
    unsigned voffA[2], voffB[2];
#pragma unroll
    for (int i = 0; i < 2; ++i) { int R, C; stage_rc(tid * 16 + i * 8192, R, C); const int Rb = EpiT::PERM ? ((R & ~31) + perm32(R & 31)) : R;
        voffA[i] = (unsigned)(R * K + C) * 2u; voffB[i] = (unsigned)(Rb * K + C) * 2u; }
    const size_t kstep = (size_t)(BK * 2);
    const size_t hstep = (size_t)HALF * K * 2;
    const size_t tstep = 2 * hstep;
    const unsigned ldsw = (unsigned)wid * 1024u;
    const int aoff = lds_byte(wr * 64 + fr, fq * 8), boff = lds_byte(wc * 32 + fr, fq * 8);
#define PG8_SA(b, h) (((b) * 2 + (h)) * HTB)
#define PG8_SB(b, h) ((4 + (b) * 2 + (h)) * HTB)
#define PG8_STAGE(bufoff, gbase, voff) do { _Pragma("unroll") for (int _i = 0; _i < 2; ++_i) \
        __builtin_amdgcn_global_load_lds((const unsigned*)((const char*)(gbase) + (voff)[_i]), (LAS unsigned*)(lds + (bufoff) + ldsw + _i * 8192), 16, 0, 0); } while (0)
#define PG8_LDA(dst, b, h) do { _Pragma("unroll") for (int m = 0; m < 4; ++m) _Pragma("unroll") for (int k = 0; k < 2; ++k) dst[m][k] = *(const LAS bf16x8*)(lds + PG8_SA(b, h) + aoff + m * 2048 + k * 1024); } while (0)
#define PG8_LDB(dst, b, h) do { _Pragma("unroll") for (int n = 0; n < 2; ++n) _Pragma("unroll") for (int k = 0; k < 2; ++k) dst[n][k] = *(const LAS bf16x8*)(lds + PG8_SB(b, h) + boff + n * 2048 + k * 1024); } while (0)
#define PG8_MMA(ai, bj, At, Bt) do { __builtin_amdgcn_s_setprio(1); _Pragma("unroll") for (int m = 0; m < 4; ++m) _Pragma("unroll") for (int n = 0; n < 2; ++n) _Pragma("unroll") for (int k = 0; k < 2; ++k) \
        acc[ai][bj][m][n] = __builtin_amdgcn_mfma_f32_16x16x32_bf16(Bt[n][k], At[m][k], acc[ai][bj][m][n], 0, 0, 0); __builtin_amdgcn_s_setprio(0); } while (0)
#define PG8_WAIT_V(n) asm volatile("s_waitcnt vmcnt(" #n ")" ::: "memory")
#define PG8_WAIT_L(n) asm volatile("s_waitcnt lgkmcnt(" #n ")" ::: "memory")
#define PG8_BAR __builtin_amdgcn_s_barrier()
#define PG8_SCHED __builtin_amdgcn_sched_barrier(0)
    Unit cur, nxt; int ui = 0;
    if (!S.next(0, cur)) return;
    f32x4 acc[2][2][4][2];
#pragma unroll
    for (int a = 0; a < 2; ++a)
#pragma unroll
        for (int b = 0; b < 2; ++b)
#pragma unroll
            for (int m = 0; m < 4; ++m)
#pragma unroll
                for (int n = 0; n < 2; ++n) acc[a][b][m][n] = (f32x4){0.f, 0.f, 0.f, 0.f};
    bf16x8 At[4][2], B0[2][2], B1[2][2];
    const char* cA = (const char*)g.A + (size_t)cur.pm * tstep + (size_t)cur.kt0 * kstep; const char* cB = (const char*)g.Bt + (size_t)cur.pn * tstep + (size_t)cur.kt0 * kstep;
    PG8_STAGE(PG8_SB(0, 0), cB, voffB); PG8_STAGE(PG8_SB(0, 1), cB + hstep, voffB); PG8_STAGE(PG8_SA(0, 0), cA, voffA); PG8_STAGE(PG8_SA(0, 1), cA + hstep, voffA);
    if (wr == 1) PG8_BAR;
    PG8_WAIT_V(2); PG8_BAR;
    PG8_STAGE(PG8_SB(1, 0), cB + kstep, voffB); PG8_STAGE(PG8_SA(1, 0), cA + kstep, voffA); PG8_STAGE(PG8_SB(1, 1), cB + hstep + kstep, voffB);
    PG8_WAIT_V(6); PG8_BAR;
    for (;;) {
        const bool has_next = S.next(ui + 1, nxt);
        const char* nA = has_next ? (const char*)g.A + (size_t)nxt.pm * tstep + (size_t)nxt.kt0 * kstep : cA; const char* nB = has_next ? (const char*)g.Bt + (size_t)nxt.pn * tstep + (size_t)nxt.kt0 * kstep : cB;
        const int nt = cur.len;
        for (int t = 0; t < nt; t += 2) {
            const bool last = (t == nt - 2);
            const char* a1 = cA + (size_t)(t + 1) * kstep;
            const char* a2 = last ? nA : cA + (size_t)(t + 2) * kstep; const char* b2 = last ? nB : cB + (size_t)(t + 2) * kstep;
            const char* a3 = a2 + kstep; const char* b3 = b2 + kstep;
            PG8_LDB(B0, 0, 0); PG8_LDB(B1, 0, 1); PG8_SCHED; PG8_LDA(At, 0, 0); PG8_STAGE(PG8_SA(1, 1), a1 + hstep, voffA);
            PG8_WAIT_V(8); PG8_WAIT_L(0); PG8_BAR; PG8_MMA(0, 0, At, B0); PG8_MMA(0, 1, At, B1); PG8_BAR; PG8_SCHED;
            PG8_LDA(At, 0, 1); PG8_STAGE(PG8_SB(0, 0), b2, voffB); PG8_STAGE(PG8_SB(0, 1), b2 + hstep, voffB); PG8_STAGE(PG8_SA(0, 0), a2, voffA);
            PG8_WAIT_V(8); PG8_WAIT_L(0); PG8_BAR; PG8_MMA(1, 0, At, B0); PG8_MMA(1, 1, At, B1); PG8_BAR; PG8_SCHED;
            PG8_LDB(B0, 1, 0); PG8_LDB(B1, 1, 1); PG8_SCHED; PG8_LDA(At, 1, 0); PG8_STAGE(PG8_SA(0, 1), a2 + hstep, voffA);
            PG8_WAIT_V(8); PG8_WAIT_L(0); PG8_BAR; PG8_MMA(0, 0, At, B0); PG8_MMA(0, 1, At, B1); PG8_BAR; PG8_SCHED;
            PG8_LDA(At, 1, 1); PG8_STAGE(PG8_SB(1, 0), b3, voffB); PG8_STAGE(PG8_SB(1, 1), b3 + hstep, voffB); PG8_STAGE(PG8_SA(1, 0), a3, voffA);
            PG8_WAIT_V(8); PG8_WAIT_L(0); PG8_BAR; PG8_MMA(1, 0, At, B0); PG8_MMA(1, 1, At, B1); PG8_BAR; PG8_SCHED;
        }
        if (wr == 0) PG8_BAR;
        E(acc, cur, wr, wc, fr, fq, Sched::WT_ALL ? true : (WT_LAST != 0 && !has_next));
        if (!has_next) break;
#pragma unroll
        for (int a = 0; a < 2; ++a)
#pragma unroll
            for (int b = 0; b < 2; ++b)
#pragma unroll
                for (int m = 0; m < 4; ++m)
#pragma unroll
                    for (int n = 0; n < 2; ++n) acc[a][b][m][n] = (f32x4){0.f, 0.f, 0.f, 0.f};
        cur = nxt; cA = nA; cB = nB; ++ui;
        if (wr == 1) PG8_BAR;
    }
    PG8_WAIT_V(0);
    PG8_BAR;
#undef PG8_SA
#undef PG8_SB
#undef PG8_STAGE
#undef PG8_LDA
#undef PG8_LDB
#undef PG8_MMA
#undef PG8_WAIT_V
#undef PG8_WAIT_L
#undef PG8_BAR
#undef PG8_SCHED
}
}

struct Params {
    const float *x_prompt, *x_sample, *cache_k, *cache_v, *state_conv, *meta, *rel_bias, *w_in, *conv_w, *sinks, *w_out,
        *n_pre_mix, *n_post_mix, *n_pre_ffn, *n_post_ffn, *w_gate, *w_up, *w_down;
    float* out; unsigned char* ws;
};

constexpr int I_IN = (D / 64) * (INDIM / 64), I_OUT = (D / 64) * (D / 64), I_G = (D / 64) * (DFF / 64), I_DN = (DFF / 64) * (D / 64);
constexpr int I_LAYER = I_IN + I_OUT + 2 * I_G + I_DN;
struct ItemDesc { const float* W; const float* gain; bf16_t* WT; int K, N, mode, k0, n0; };
struct ItemRegs { f32x4 v0[8], v1[8]; f32x2 gg[8]; };
__device__ __forceinline__ void item_decode(const Params& p, int l, int it, ItemDesc& d) {
    int r = it;
    if (r < I_IN) { d.W = p.w_in + (size_t)l * D * INDIM; d.K = D; d.N = INDIM; d.WT = (bf16_t*)(p.ws + WS_WIN) + (size_t)l * INDIM * D; d.gain = p.n_pre_mix + l * D; d.mode = 0; }
    else if ((r -= I_IN) < I_OUT) { d.W = p.w_out + (size_t)l * D * D; d.K = D; d.N = D; d.WT = (bf16_t*)(p.ws + WS_WOUT) + (size_t)l * D * D; d.gain = nullptr; d.mode = 0; }
    else if ((r -= I_OUT) < I_G) { d.W = p.w_gate + (size_t)l * D * DFF; d.K = D; d.N = DFF; d.WT = (bf16_t*)(p.ws + WS_WGU) + (size_t)l * NGU * D; d.gain = p.n_pre_ffn + l * D; d.mode = 1; }
    else if ((r -= I_G) < I_G) { d.W = p.w_up + (size_t)l * D * DFF; d.K = D; d.N = DFF; d.WT = (bf16_t*)(p.ws + WS_WGU) + (size_t)l * NGU * D; d.gain = p.n_pre_ffn + l * D; d.mode = 2; }
    else { r -= I_G; d.W = p.w_down + (size_t)l * DFF * D; d.K = DFF; d.N = D; d.WT = (bf16_t*)(p.ws + WS_WDN) + (size_t)l * D * DFF; d.gain = nullptr; d.mode = 0; }
    const int nblk = d.N / 64; d.k0 = 64 * (r / nblk); d.n0 = 64 * (r % nblk);
}
__device__ __forceinline__ void item_load(const ItemDesc& d, int lane, ItemRegs& R) {
    const int c4 = lane & 15, kq = lane >> 4;
#pragma unroll
    for (int i = 0; i < 8; ++i) { const int kp = kq + 4 * i; const float* s = d.W + (size_t)(d.k0 + 2 * kp) * d.N + d.n0 + 4 * c4; R.v0[i] = __builtin_nontemporal_load((const f32x4*)s); R.v1[i] = __builtin_nontemporal_load((const f32x4*)(s + d.N)); }
#pragma unroll
    for (int i = 0; i < 8; ++i) { const int kp = kq + 4 * i; R.gg[i] = d.gain ? *(const f32x2*)(d.gain + d.k0 + 2 * kp) : (f32x2){1.f, 1.f}; }
}
__device__ __forceinline__ void item_finish(const ItemDesc& d, LAS unsigned* scr, int lane, const ItemRegs& R) {
    const int c4 = lane & 15, kq = lane >> 4;
#pragma unroll
    for (int i = 0; i < 8; ++i) { const int kp = kq + 4 * i; const float g0 = R.gg[i].x, g1 = R.gg[i].y;
        LAS unsigned* q = scr + (4 * c4) * 33 + kp;
        q[0] = cvt_pk_bf16(R.v0[i].x * g0, R.v1[i].x * g1); q[33] = cvt_pk_bf16(R.v0[i].y * g0, R.v1[i].y * g1); q[66] = cvt_pk_bf16(R.v0[i].z * g0, R.v1[i].z * g1); q[99] = cvt_pk_bf16(R.v0[i].w * g0, R.v1[i].w * g1); }
    LDS_WAIT(); __builtin_amdgcn_wave_barrier(); asm volatile("" ::: "memory");
    int rbase = d.n0;
    if (d.mode) rbase = ((d.n0 >> 7) << 8) + (d.n0 & 127) + (d.mode == 2 ? 128 : 0);
    const int kc = lane & 7;
#pragma unroll
    for (int j = 0; j < 8; ++j) { const int n = (lane >> 3) + 8 * j; const LAS unsigned* s = scr + n * 33 + 4 * kc;
        u32x4 o; o.x = s[0]; o.y = s[1]; o.z = s[2]; o.w = s[3];
        __builtin_nontemporal_store(o, (u32x4*)(d.WT + (size_t)(rbase + n) * d.K + d.k0 + 8 * kc)); }
    LDS_WAIT(); __builtin_amdgcn_wave_barrier(); asm volatile("" ::: "memory");
}
__device__ __forceinline__ void convert_items(const Params& p, int l, int it0, int it1, int worker, int nw, LAS unsigned char* lds, int wid, int lane) {
    LAS unsigned* scr = (LAS unsigned*)(lds + wid * 16384);
    int it = it0 + worker;
    if (it >= it1) return;
    ItemDesc dA, dB; ItemRegs A, B;
    item_decode(p, l, it, dA); item_load(dA, lane, A);
    for (;;) {
        const int itB = it + nw; const bool hB = itB < it1;
        if (hB) { item_decode(p, l, itB, dB); item_load(dB, lane, B); }
        item_finish(dA, scr, lane, A);
        if (!hB) break;
        const int itA = itB + nw; const bool hA = itA < it1;
        if (hA) { item_decode(p, l, itA, dA); item_load(dA, lane, A); }
        item_finish(dB, scr, lane, B);
        if (!hA) break;
        it = itA;
    }
}
__device__ __forceinline__ void filler(const Params& p, int l, int it0, int it1, int nwg, LAS unsigned char* lds, int wid, int lane) {
    const int G = gridDim.x, r = nwg % G, c = blockIdx.x;
    if (r == 0) convert_items(p, l, it0, it1, c * 8 + wid, G * 8, lds, wid, lane);
    else if (c >= r) convert_items(p, l, it0, it1, (c - r) * 8 + wid, (G - r) * 8, lds, wid, lane);
}

__device__ __forceinline__ void prologue(const Params& p, LAS unsigned char* lds, int wid, int lane) {
    const int gw = blockIdx.x * 8 + wid, NGW = gridDim.x * 8;
    convert_items(p, 0, 0, I_IN, gw, NGW, lds, wid, lane);
    bf16_t* HB = (bf16_t*)(p.ws + WS_HB); float* RS = (float*)(p.ws + WS_RS);
    for (int m = gw; m < MREAL; m += NGW) {
        const float* src;
        if (m < MPROMPT) { const int b = m / LSEQ, t = m % LSEQ; src = t < NMETA ? p.meta + (size_t)t * D : p.x_prompt + ((size_t)b * SEQ + (t - NMETA)) * D; }
        else src = p.x_sample + (size_t)(m - MPROMPT) * D;
        const f32x4* xr = (const f32x4*)src + lane; u32x2* hb = (u32x2*)(HB + (size_t)m * D) + lane;
        float ss = 0.f; f32x4 v[8];
#pragma unroll
        for (int j = 0; j < 8; ++j) { v[j] = __builtin_nontemporal_load(xr + 64 * j); ss += (v[j].x * v[j].x + v[j].y * v[j].y) + (v[j].z * v[j].z + v[j].w * v[j].w); }
        ss = wave_sum(ss);
        const float r = 1.f / sqrtf(ss * (1.f / D) + RMS_EPS);
#pragma unroll
        for (int j = 0; j < 8; ++j) { u32x2 w; w.x = cvt_pk_bf16(v[j].x * r, v[j].y * r); w.y = cvt_pk_bf16(v[j].z * r, v[j].w * r); hb[64 * j] = w; }
        if (lane == 0) RS[m] = r;
    }
}

template <int PP> __device__ __forceinline__ void postnorm_row(const Params& p, const float* __restrict__ g, bool last, int m, int lane, bool dry) {
    bf16_t* HB = (bf16_t*)(p.ws + WS_HB); float* RS = (float*)(p.ws + WS_RS); const bf16_t* MIXB = (const bf16_t*)(p.ws + WS_MIXB); const bf16_t* MIXB1 = (const bf16_t*)(p.ws + WS_MIXB1);
    const u32x2* mr = (const u32x2*)(MIXB + (size_t)m * D) + lane; const u32x2* mr1 = (const u32x2*)(MIXB1 + (size_t)m * D) + lane;
    u32x2* hb = (u32x2*)(HB + (size_t)m * D) + lane; const f32x4* gr = (const f32x4*)g + lane;
    const int pmrow = m >> 8;
    u32x2 w0[8], w1[8], hw[8]; f32x4 gv[8];
#pragma unroll
    for (int j = 0; j < 8; ++j) { w0[j] = mr[64 * j]; w1[j] = mr1[64 * j]; hw[j] = hb[64 * j]; }
#pragma unroll
    for (int j = 0; j < 8; ++j) gv[j] = gr[64 * j];
    f32x4 mv[8]; float ss = 0.f;
#pragma unroll
    for (int j = 0; j < 8; ++j) { mv[j] = (f32x4){bf_lo(w0[j].x), bf_hi(w0[j].x), bf_lo(w0[j].y), bf_hi(w0[j].y)};
        if (pg8::StreamKOrder<PP>::is_split(j * (MP / 256) + pmrow, (int)gridDim.x)) mv[j] += (f32x4){bf_lo(w1[j].x), bf_hi(w1[j].x), bf_lo(w1[j].y), bf_hi(w1[j].y)};
        ss += (mv[j].x * mv[j].x + mv[j].y * mv[j].y) + (mv[j].z * mv[j].z + mv[j].w * mv[j].w); }
    ss = wave_sum(ss);
    const float r = 1.f / sqrtf(ss * (1.f / D) + RMS_EPS);
    float* yrow = nullptr;
    if (last) { if (m < MPROMPT) { const int b = m / LSEQ, t = m % LSEQ; if (t >= NMETA) yrow = p.out + O_YP + ((size_t)b * SEQ + (t - NMETA)) * D; } else yrow = p.out + O_YS + (size_t)(m - MPROMPT) * D; }
    const float rinv = 1.f / RS[m];
    float s2 = 0.f; f32x4 hn[8];
#pragma unroll
    for (int j = 0; j < 8; ++j) {
        const f32x4 hv = (f32x4){bf_lo(hw[j].x), bf_hi(hw[j].x), bf_lo(hw[j].y), bf_hi(hw[j].y)};
        hn[j] = hv * rinv + mv[j] * r * gv[j];
        s2 += (hn[j].x * hn[j].x + hn[j].y * hn[j].y) + (hn[j].z * hn[j].z + hn[j].w * hn[j].w);
        if (yrow) ((f32x4*)yrow)[lane + 64 * j] = hn[j];
    }
    s2 = wave_sum(s2);
    const float rn = 1.f / sqrtf(s2 * (1.f / D) + RMS_EPS);
#pragma unroll
    for (int j = 0; j < 8; ++j) { u32x2 w; w.x = cvt_pk_bf16(hn[j].x * rn, hn[j].y * rn); w.y = cvt_pk_bf16(hn[j].z * rn, hn[j].w * rn); (dry ? (u32x2*)(p.ws + WS_ZACT) + (size_t)m * (D / 4) + lane : hb)[64 * j] = w; }
    if (lane == 0 && !dry) RS[m] = rn;
}
struct Pn2Regs { u32x2 hw[2][8]; f32x4 gv[8]; float rs[2]; };
__device__ __forceinline__ void pn2_load_h(const Params& p, const float* __restrict__ g, int m0, int lane, Pn2Regs& R) {
    const bf16_t* HB = (const bf16_t*)(p.ws + WS_HB); const float* RS = (const float*)(p.ws + WS_RS);
    const f32x4* gr = (const f32x4*)g + lane;
#pragma unroll
    for (int e = 0; e < 2; ++e) { const u32x2* hb = (const u32x2*)(HB + (size_t)(m0 + e) * D) + lane;
#pragma unroll
        for (int j = 0; j < 8; ++j) R.hw[e][j] = hb[64 * j];
        R.rs[e] = RS[m0 + e]; }
#pragma unroll
    for (int j = 0; j < 8; ++j) R.gv[j] = gr[64 * j];
}
template <int PP> __device__ __forceinline__ void pn2_finish(const Params& p, bool last, int m0, int lane, const Pn2Regs& R) {
    bf16_t* HB = (bf16_t*)(p.ws + WS_HB); float* RS = (float*)(p.ws + WS_RS); const bf16_t* MIXB = (const bf16_t*)(p.ws + WS_MIXB); const bf16_t* MIXB1 = (const bf16_t*)(p.ws + WS_MIXB1);
    const int pmrow = m0 >> 8;
    u32x2 w0[2][8], w1[2][8];
#pragma unroll
    for (int e = 0; e < 2; ++e) {
        const u32x2* mr = (const u32x2*)(MIXB + (size_t)(m0 + e) * D) + lane; const u32x2* mr1 = (const u32x2*)(MIXB1 + (size_t)(m0 + e) * D) + lane;
#pragma unroll
        for (int j = 0; j < 8; ++j) { w0[e][j] = mr[64 * j]; w1[e][j] = mr1[64 * j]; }
    }
#pragma unroll
    for (int e = 0; e < 2; ++e) {
        const int m = m0 + e;
        f32x4 mv[8]; float ss = 0.f;
#pragma unroll
        for (int j = 0; j < 8; ++j) { mv[j] = (f32x4){bf_lo(w0[e][j].x), bf_hi(w0[e][j].x), bf_lo(w0[e][j].y), bf_hi(w0[e][j].y)};
            if (pg8::StreamKOrder<PP>::is_split(j * (MP / 256) + pmrow, (int)gridDim.x)) mv[j] += (f32x4){bf_lo(w1[e][j].x), bf_hi(w1[e][j].x), bf_lo(w1[e][j].y), bf_hi(w1[e][j].y)};
            ss += (mv[j].x * mv[j].x + mv[j].y * mv[j].y) + (mv[j].z * mv[j].z + mv[j].w * mv[j].w); }
        ss = wave_sum(ss);
        const float r = 1.f / sqrtf(ss * (1.f / D) + RMS_EPS);
        float* yrow = nullptr;
        if (last) { if (m < MPROMPT) { const int b = m / LSEQ, t = m % LSEQ; if (t >= NMETA) yrow = p.out + O_YP + ((size_t)b * SEQ + (t - NMETA)) * D; } else yrow = p.out + O_YS + (size_t)(m - MPROMPT) * D; }
        u32x2* hbw = (u32x2*)(HB + (size_t)m * D) + lane;
        const float rinv = 1.f / R.rs[e];
        float s2 = 0.f; f32x4 hn[8];
#pragma unroll
        for (int j = 0; j < 8; ++j) {
            const f32x4 hv = (f32x4){bf_lo(R.hw[e][j].x), bf_hi(R.hw[e][j].x), bf_lo(R.hw[e][j].y), bf_hi(R.hw[e][j].y)};
            hn[j] = hv * rinv + mv[j] * r * R.gv[j];
            s2 += (hn[j].x * hn[j].x + hn[j].y * hn[j].y) + (hn[j].z * hn[j].z + hn[j].w * hn[j].w);
            if (yrow) ((f32x4*)yrow)[lane + 64 * j] = hn[j];
        }
        s2 = wave_sum(s2);
        const float rn = 1.f / sqrtf(s2 * (1.f / D) + RMS_EPS);
        if (!last) {
#pragma unroll
            for (int j = 0; j < 8; ++j) { u32x2 w; w.x = cvt_pk_bf16(hn[j].x * rn, hn[j].y * rn); w.y = cvt_pk_bf16(hn[j].z * rn, hn[j].w * rn); hbw[64 * j] = w; }
            if (lane == 0) RS[m] = rn;
        }
    }
}
template <int PP> __device__ __forceinline__ void postnorm(const Params& p, const float* __restrict__ g, bool last, int wid, int lane, bool dry = false) {
    const int gw = blockIdx.x * 8 + wid, NGW = gridDim.x * 8;
    for (int m = gw; m < MREAL; m += NGW) postnorm_row<PP>(p, g, last, m, lane, dry);
}
template <int PP> __device__ __forceinline__ void sk_postnorm(const Params& p, const pg8::StreamKOrder<PP>& S, unsigned* cnt, const float* __restrict__ g, bool last, int vcu, int tid, int wid, int lane, unsigned long long& tacc_, unsigned long long& t0_) {
    const int G = gridDim.x, gwv = vcu * 8 + wid, NGW = G * 8;
    constexpr int NMAIN = 8192 / 32;
    TB(11);
    asm volatile("s_waitcnt vmcnt(0)" ::: "memory");
    __syncthreads();
    TE(11);
    Pn2Regs R0;
    const int mfirst = 32 * (vcu < NMAIN ? vcu : 0) + 4 * wid;
    pn2_load_h(p, g, mfirst, lane, R0);
    TB(12);
    if (tid == 0) {
#if !WT_SK
        __builtin_amdgcn_fence(__ATOMIC_RELEASE, "agent");
        asm volatile("s_waitcnt vmcnt(0)" ::: "memory");
#endif
        pg8::Unit u; for (int i = 0; S.next(i, u); ++i) (void)xb_add(cnt + 16 * u.pm, 1u);
        for (int c = vcu; c < NMAIN + 1; c += G) {
            int pm = c >> 3;
            if (c >= NMAIN) break;
            unsigned want = 0; for (int j = 0; j < 8; ++j) want += 1u + (pg8::StreamKOrder<PP>::is_split(j * (MP / 256) + pm, G) ? 1u : 0u);
            unsigned sp = 0; while (xb_ld(cnt + 16 * pm) < want) { __builtin_amdgcn_s_sleep(1); if (++sp > (1u << 22)) break; }
        }
        if (vcu * 8 < MREAL - 8192) {
            unsigned want = 0; for (int j = 0; j < 8; ++j) want += 1u + (pg8::StreamKOrder<PP>::is_split(j * (MP / 256) + 32, G) ? 1u : 0u);
            unsigned sp = 0; while (xb_ld(cnt + 16 * 32) < want) { __builtin_amdgcn_s_sleep(1); if (++sp > (1u << 22)) break; }
        }
        __builtin_amdgcn_fence(__ATOMIC_ACQUIRE, "agent");
        asm volatile("s_waitcnt vmcnt(0)" ::: "memory");
    }
    __syncthreads();
    TE(12);
    TB(13);
    if (vcu < NMAIN) {
        pn2_finish<PP>(p, last, mfirst, lane, R0);
        { Pn2Regs R1; pn2_load_h(p, g, mfirst + 2, lane, R1); pn2_finish<PP>(p, last, mfirst + 2, lane, R1); }
    }
    for (int c = vcu + G; c < NMAIN; c += G)
        for (int i = 0; i < 4; i += 2) { Pn2Regs R1; pn2_load_h(p, g, 32 * c + 4 * wid + i, lane, R1); pn2_finish<PP>(p, last, 32 * c + 4 * wid + i, lane, R1); }
    for (int i = gwv; i < MREAL - 8192; i += NGW) postnorm_row<PP>(p, g, last, 8192 + i, lane, false);
    TE(13);
}

constexpr int AT_QT = 128, AT_NT = 4, AT_KR = 304, AT_KS = 72, AT_VS = 312, AT_PS = 168;
constexpr int AT_K_OFF = 0, AT_V_OFF = AT_KR * AT_KS * 2  , AT_P_OFF = AT_V_OFF + 64 * AT_VS * 2  , AT_P_WAVE = 16 * AT_PS * 2  ;
static_assert(AT_P_OFF + 8 * AT_P_WAVE <= RING_BYTES && (AT_V_OFF % 16) == 0 && (AT_P_OFF % 16) == 0, "attention LDS map");

__device__ __forceinline__ void attn_prompt_unit(LAS unsigned char* lds, int b, int kvh, int qt, const bf16_t* __restrict__ z, bf16_t* mixin, const float* __restrict__ sinks, int tid, int wid, int lane) {
    LAS bf16_t* Ks = (LAS bf16_t*)(lds + AT_K_OFF);
    LAS bf16_t* Vt = (LAS bf16_t*)(lds + AT_V_OFF);
    LAS bf16_t* Pw = (LAS bf16_t*)(lds + AT_P_OFF + wid * AT_P_WAVE);
    const LAS float* biasL = (const LAS float*)(lds + BIAS_OFF);
    const int q0 = qt * AT_QT, rowb = b * LSEQ;
    const int h = kvh * 4 + (wid & 3), i16 = lane & 15, g = lane >> 4;
    const int ntile = AT_NT + ((qt == 15 && (wid >> 2) == 0) ? 1 : 0);
    bf16x8 qf[AT_NT + 1][2];
#pragma unroll
    for (int tile = 0; tile < AT_NT + 1; ++tile) {
        const int tq0 = tile < AT_NT ? q0 + (wid >> 2) * (AT_QT / 2) + tile * 16 : 2048;
        int tq = tq0 + i16; tq = tq > LSEQ - 1 ? LSEQ - 1 : tq;
        const bf16_t* qp = z + (size_t)(rowb + tq) * INDIM + ZQ + h * 64 + 8 * g;
        if (tile < ntile) { qf[tile][0] = *(const bf16x8*)qp; qf[tile][1] = *(const bf16x8*)(qp + 32); }
        else { qf[tile][0] = (bf16x8){0, 0, 0, 0, 0, 0, 0, 0}; qf[tile][1] = qf[tile][0]; }
    }
    const float sink = sinks[h];
    {
        constexpr int NIT = (AT_KR * 8 + 511) / 512;
        u32x4 kv[NIT], vv[NIT];
#pragma unroll
        for (int it = 0; it < NIT; ++it) {
            const int c = tid + it * 512;
            if (it < NIT - 1 || c < AT_KR * 8) {
                const int kr = c >> 3, ch = c & 7; int t = q0 - 144 + kr; t = t < 0 ? 0 : (t > LSEQ - 1 ? LSEQ - 1 : t);
                const bf16_t* src = z + (size_t)(rowb + t) * INDIM + kvh * 64 + ch * 8;
                kv[it] = *(const u32x4*)(src + ZK); vv[it] = *(const u32x4*)(src + ZV);
            }
        }
#pragma unroll
        for (int it = 0; it < NIT; ++it) {
            const int c = tid + it * 512;
            if (it < NIT - 1 || c < AT_KR * 8) {
                const int kr = c >> 3, ch = c & 7;
                *(LAS u32x4*)(Ks + kr * AT_KS + ch * 8) = kv[it];
                LAS bf16_t* vd = Vt + (ch * 8) * AT_VS + kr;
                vd[0 * AT_VS] = (bf16_t)(vv[it].x & 0xffffu); vd[1 * AT_VS] = (bf16_t)(vv[it].x >> 16);
                vd[2 * AT_VS] = (bf16_t)(vv[it].y & 0xffffu); vd[3 * AT_VS] = (bf16_t)(vv[it].y >> 16);
                vd[4 * AT_VS] = (bf16_t)(vv[it].z & 0xffffu); vd[5 * AT_VS] = (bf16_t)(vv[it].z >> 16);
                vd[6 * AT_VS] = (bf16_t)(vv[it].w & 0xffffu); vd[7 * AT_VS] = (bf16_t)(vv[it].w >> 16);
            }
        }
    }
    __syncthreads();
#pragma unroll
    for (int tile = 0; tile < AT_NT + 1; ++tile) {
        if (tile >= ntile) break;
        const int tq0 = tile < AT_NT ? q0 + (wid >> 2) * (AT_QT / 2) + tile * 16 : 2048;
        const int koff = tq0 - q0;
        const int t = tq0 + i16;
        f32x4 s[10];
#pragma unroll
        for (int nt = 1; nt < 10; ++nt) {
            const LAS bf16_t* kp = Ks + (koff + nt * 16 + i16) * AT_KS + 8 * g;
            const bf16x8 k0 = *(const LAS bf16x8*)kp, k1 = *(const LAS bf16x8*)(kp + 32);
            f32x4 a = (f32x4){0.f, 0.f, 0.f, 0.f};
            a = __builtin_amdgcn_mfma_f32_16x16x32_bf16(k0, qf[tile][0], a, 0, 0, 0);
            a = __builtin_amdgcn_mfma_f32_16x16x32_bf16(k1, qf[tile][1], a, 0, 0, 0);
            s[nt] = a;
        }
        const LAS float* bp = biasL + h * BIAS_STRIDE + BIAS_PAD + 144 + i16 - 4 * g;
        float mx = sink;
        if (tq0 >= 144) {
#pragma unroll
            for (int nt = 1; nt < 10; ++nt)
#pragma unroll
                for (int r = 0; r < 4; ++r) { const float v = s[nt][r] * 0.125f + bp[-(nt * 16 + r)]; s[nt][r] = v; mx = fmaxf(mx, v); }
        } else {
#pragma unroll
            for (int nt = 1; nt < 10; ++nt)
#pragma unroll
                for (int r = 0; r < 4; ++r) { const int tk = tq0 - 144 + nt * 16 + 4 * g + r; const float v = tk >= 0 ? s[nt][r] * 0.125f + bp[-(nt * 16 + r)] : -INFINITY; s[nt][r] = v; mx = fmaxf(mx, v); }
        }
        mx = fmaxf(mx, __shfl_xor(mx, 16)); mx = fmaxf(mx, __shfl_xor(mx, 32));
        float sum = 0.f;
        *(LAS u32x2*)(Pw + i16 * AT_PS + 4 * g) = (u32x2){0u, 0u};
#pragma unroll
        for (int nt = 1; nt < 10; ++nt) {
            const float e0 = __expf(s[nt][0] - mx), e1 = __expf(s[nt][1] - mx), e2 = __expf(s[nt][2] - mx), e3 = __expf(s[nt][3] - mx);
            sum += (e0 + e1) + (e2 + e3);
            u32x2 w; w.x = cvt_pk_bf16(e0, e1); w.y = cvt_pk_bf16(e2, e3);
            *(LAS u32x2*)(Pw + i16 * AT_PS + nt * 16 + 4 * g) = w;
        }
        sum += __shfl_xor(sum, 16); sum += __shfl_xor(sum, 32);
        const float inv = 1.f / (sum + __expf(sink - mx));
        LDS_WAIT(); __builtin_amdgcn_wave_barrier();
        f32x4 o[4];
#pragma unroll
        for (int dn = 0; dn < 4; ++dn) o[dn] = (f32x4){0.f, 0.f, 0.f, 0.f};
#pragma unroll
        for (int ks = 0; ks < 5; ++ks) {
            const bf16x8 pf = *(const LAS bf16x8*)(Pw + i16 * AT_PS + ks * 32 + 8 * g);
#pragma unroll
            for (int dn = 0; dn < 4; ++dn) {
                const bf16x8 vf = *(const LAS bf16x8*)(Vt + (dn * 16 + i16) * AT_VS + koff + ks * 32 + 8 * g);
                o[dn] = __builtin_amdgcn_mfma_f32_16x16x32_bf16(vf, pf, o[dn], 0, 0, 0);
            }
        }
        if (t < LSEQ) {
            bf16_t* op = mixin + (size_t)(rowb + t) * D + h * 64 + 4 * g;
#pragma unroll
            for (int dn = 0; dn < 4; ++dn) { u32x2 w; w.x = cvt_pk_bf16(o[dn][0] * inv, o[dn][1] * inv); w.y = cvt_pk_bf16(o[dn][2] * inv, o[dn][3] * inv); *(u32x2*)(op + dn * 16) = w; }
        }
        LDS_WAIT(); __builtin_amdgcn_wave_barrier();
    }
    __syncthreads();
}

__device__ __forceinline__ void attn_sample_wave(LAS unsigned char* lds, int l, int b, int h, const Params& p, const bf16_t* __restrict__ z, bf16_t* mixin, int wid, int lane) {
    LAS float* qs = (LAS float*)(lds + wid * 1024);
    LAS float* ps = qs + 64;
    const LAS float* biasL = (const LAS float*)(lds + BIAS_OFF);
    const int kvh = h >> 2;
    const bf16_t* zr = z + (size_t)(MPROMPT + b) * INDIM;
    const float qv = __uint_as_float((unsigned)zr[ZQ + h * 64 + lane] << 16) * 0.125f;
    qs[lane] = qv;
    LDS_WAIT(); __builtin_amdgcn_wave_barrier();
    const float* ck = p.cache_k + (((size_t)l * DB + b) * WIN) * 256 + kvh * 64;
    const float* cv = p.cache_v + (((size_t)l * DB + b) * WIN) * 256 + kvh * 64;
    float sc0 = 0.f, sc1 = 0.f;
    {
        const f32x4* k0 = (const f32x4*)(ck + (size_t)lane * 256); const f32x4* k1 = (const f32x4*)(ck + (size_t)(lane + 64) * 256);
#pragma unroll
        for (int d4 = 0; d4 < 16; ++d4) { const f32x4 q4 = *(const LAS f32x4*)(qs + 4 * d4); const f32x4 a = k0[d4], c = k1[d4];
            sc0 += (a.x * q4.x + a.y * q4.y) + (a.z * q4.z + a.w * q4.w); sc1 += (c.x * q4.x + c.y * q4.y) + (c.z * q4.z + c.w * q4.w); }
    }
    const float knew = __uint_as_float((unsigned)zr[ZK + kvh * 64 + lane] << 16);
    const float sc2 = wave_sum(qv * knew);
    const float sink = p.sinks[l * NHEADS + h];
    const float v0 = sc0 + biasL[h * BIAS_STRIDE + BIAS_PAD + (WIN - lane)], v1 = sc1 + biasL[h * BIAS_STRIDE + BIAS_PAD + (64 - lane)], v2 = sc2 + biasL[h * BIAS_STRIDE + BIAS_PAD];
    float mx = wave_max(fmaxf(v0, v1)); mx = fmaxf(mx, fmaxf(v2, sink));
    const float e0 = __expf(v0 - mx), e1 = __expf(v1 - mx), e2 = __expf(v2 - mx);
    const float sum = wave_sum(e0 + e1) + e2 + __expf(sink - mx);
    ps[lane] = e0; ps[lane + 64] = e1;
    LDS_WAIT(); __builtin_amdgcn_wave_barrier();
    const int sg = lane >> 4, dq = lane & 15;
    f32x4 oa = (f32x4){0.f, 0.f, 0.f, 0.f}, ob4 = (f32x4){0.f, 0.f, 0.f, 0.f};
#pragma unroll
    for (int it = 0; it < 2; ++it) {
        f32x4 vr[16];
#pragma unroll
        for (int i = 0; i < 16; ++i) vr[i] = *(const f32x4*)(cv + (size_t)(sg + 4 * (i + 16 * it)) * 256 + 4 * dq);
#pragma unroll
        for (int i = 0; i < 16; i += 2) { oa += vr[i] * ps[sg + 4 * (i + 16 * it)]; ob4 += vr[i + 1] * ps[sg + 4 * (i + 1 + 16 * it)]; }
    }
    oa += ob4;
#pragma unroll
    for (int c = 0; c < 4; ++c) { oa[c] += __shfl_xor(oa[c], 16); oa[c] += __shfl_xor(oa[c], 32); }
    if (sg == 0) {
        const u32x2 vn = *(const u32x2*)(zr + ZV + kvh * 64 + 4 * dq);
        const float rs_ = 1.f / sum;
        const float o0 = (oa[0] + e2 * bf_lo(vn.x)) * rs_, o1 = (oa[1] + e2 * bf_hi(vn.x)) * rs_, o2 = (oa[2] + e2 * bf_lo(vn.y)) * rs_, o3 = (oa[3] + e2 * bf_hi(vn.y)) * rs_;
        u32x2 w; w.x = cvt_pk_bf16(o0, o1); w.y = cvt_pk_bf16(o2, o3);
        *(u32x2*)(mixin + (size_t)(MPROMPT + b) * D + h * 64 + 4 * dq) = w;
    }
    LDS_WAIT(); __builtin_amdgcn_wave_barrier();
}

__device__ __forceinline__ void unpack8(const u32x4 a, float (&o)[8]) { o[0] = bf_lo(a.x); o[1] = bf_hi(a.x); o[2] = bf_lo(a.y); o[3] = bf_hi(a.y); o[4] = bf_lo(a.z); o[5] = bf_hi(a.z); o[6] = bf_lo(a.w); o[7] = bf_hi(a.w); }
__device__ __forceinline__ void conv_row(int l, int m, const Params& p, const bf16_t* __restrict__ z, bf16_t* mixin, int lane) {
    const float* cw = p.conv_w + (size_t)l * 3 * CDIM;
    const bool prompt = m < MPROMPT;
    const int b = prompt ? m / LSEQ : m - MPROMPT, t = prompt ? m % LSEQ : 0;
    const bf16_t* zr = z + (size_t)m * INDIM;
    const bf16_t* z1 = (prompt && t >= 1) ? zr - INDIM : zr;
    const bf16_t* z2 = (prompt && t >= 2) ? zr - 2 * INDIM : zr;
    const float k1 = (prompt && t >= 1) ? 1.f : 0.f, k2 = (prompt && t >= 2) ? 1.f : 0.f;
    const float* st = p.state_conv + (((size_t)l * DB + (prompt ? 0 : b)) * 2) * CDIM;
    u32x4 gbv[2], gcv[2], hcv[2], a1[2], c1[2], a2[2], c2[2]; f32x4 sv[2][4], wv[2][6];
#pragma unroll
    for (int j = 0; j < 2; ++j) {
        const int c0 = lane * 8 + 512 * j;
        gbv[j] = *(const u32x4*)(zr + ZGB + c0); gcv[j] = *(const u32x4*)(zr + ZGC + c0); hcv[j] = *(const u32x4*)(zr + ZHC + c0);
        a1[j] = *(const u32x4*)(z1 + ZGC + c0); c1[j] = *(const u32x4*)(z1 + ZHC + c0); a2[j] = *(const u32x4*)(z2 + ZGC + c0); c2[j] = *(const u32x4*)(z2 + ZHC + c0);
        if (!prompt) { sv[j][0] = *(const f32x4*)(st + c0); sv[j][1] = *(const f32x4*)(st + c0 + 4); sv[j][2] = *(const f32x4*)(st + CDIM + c0); sv[j][3] = *(const f32x4*)(st + CDIM + c0 + 4); }
#pragma unroll
        for (int i = 0; i < 3; ++i) { wv[j][2 * i] = *(const f32x4*)(cw + i * CDIM + c0); wv[j][2 * i + 1] = *(const f32x4*)(cw + i * CDIM + c0 + 4); }
    }
#pragma unroll
    for (int j = 0; j < 2; ++j) {
        const int c0 = lane * 8 + 512 * j;
        float gb[8], gc[8], hc[8], u0[8], u1[8], u2[8], x[8], y[8];
        unpack8(gbv[j], gb); unpack8(gcv[j], gc); unpack8(hcv[j], hc);
#pragma unroll
        for (int i = 0; i < 8; ++i) u0[i] = gc[i] * hc[i];
        if (prompt) {
            unpack8(a1[j], x); unpack8(c1[j], y);
#pragma unroll
            for (int i = 0; i < 8; ++i) u1[i] = x[i] * y[i] * k1;
            unpack8(a2[j], x); unpack8(c2[j], y);
#pragma unroll
            for (int i = 0; i < 8; ++i) u2[i] = x[i] * y[i] * k2;
            if (t >= LSEQ - 2) { float* co = p.out + O_CP + (((size_t)l * NBATCH + b) * 2 + (t - (LSEQ - 2))) * CDIM + c0;
                *(f32x4*)co = (f32x4){u0[0], u0[1], u0[2], u0[3]}; *(f32x4*)(co + 4) = (f32x4){u0[4], u0[5], u0[6], u0[7]}; }
        } else {
#pragma unroll
            for (int i = 0; i < 4; ++i) { u2[i] = sv[j][0][i]; u2[4 + i] = sv[j][1][i]; u1[i] = sv[j][2][i]; u1[4 + i] = sv[j][3][i]; }
            float* co = p.out + O_CS + (((size_t)l * DB + b) * 2) * CDIM + c0;
            *(f32x4*)co = sv[j][2]; *(f32x4*)(co + 4) = sv[j][3];
            *(f32x4*)(co + CDIM) = (f32x4){u0[0], u0[1], u0[2], u0[3]}; *(f32x4*)(co + CDIM + 4) = (f32x4){u0[4], u0[5], u0[6], u0[7]};
        }
        float r[8];
#pragma unroll
        for (int i = 0; i < 8; ++i) { const float w0 = wv[j][i >> 2][i & 3], w1 = wv[j][2 + (i >> 2)][i & 3], w2 = wv[j][4 + (i >> 2)][i & 3]; r[i] = gb[i] * (w0 * u2[i] + w1 * u1[i] + w2 * u0[i]); }
        u32x4 w; w.x = cvt_pk_bf16(r[0], r[1]); w.y = cvt_pk_bf16(r[2], r[3]); w.z = cvt_pk_bf16(r[4], r[5]); w.w = cvt_pk_bf16(r[6], r[7]);
        *(u32x4*)(mixin + (size_t)m * D + 1024 + c0) = w;
    }
}

__device__ __forceinline__ void conv_job4(int l, int m0, const Params& p, const bf16_t* __restrict__ z, bf16_t* mixin, int lane) {
    const float* cw = p.conv_w + (size_t)l * 3 * CDIM;
    const int b = m0 / LSEQ, t0 = m0 % LSEQ;
    const float kprev = t0 > 0 ? 1.f : 0.f;
    const bf16_t* zr = z + (size_t)m0 * INDIM;
    const bf16_t* zp = t0 > 0 ? zr - 2 * INDIM : zr;
#pragma unroll
    for (int j = 0; j < 2; ++j) {
        const int c0 = lane * 8 + 512 * j;
        u32x4 gcv[6], hcv[6], gbv[4]; f32x4 wv[6];
        gcv[0] = *(const u32x4*)(zp + ZGC + c0); hcv[0] = *(const u32x4*)(zp + ZHC + c0);
        gcv[1] = *(const u32x4*)(zp + INDIM + ZGC + c0); hcv[1] = *(const u32x4*)(zp + INDIM + ZHC + c0);
#pragma unroll
        for (int r = 0; r < 4; ++r) { gcv[2 + r] = *(const u32x4*)(zr + (size_t)r * INDIM + ZGC + c0); hcv[2 + r] = *(const u32x4*)(zr + (size_t)r * INDIM + ZHC + c0); gbv[r] = *(const u32x4*)(zr + (size_t)r * INDIM + ZGB + c0); }
#pragma unroll
        for (int i = 0; i < 3; ++i) { wv[2 * i] = *(const f32x4*)(cw + i * CDIM + c0); wv[2 * i + 1] = *(const f32x4*)(cw + i * CDIM + c0 + 4); }
        float u[6][8];
#pragma unroll
        for (int r = 0; r < 6; ++r) { float x[8], y[8]; unpack8(gcv[r], x); unpack8(hcv[r], y); const float k = r < 2 ? kprev : 1.f;
#pragma unroll
            for (int i = 0; i < 8; ++i) u[r][i] = x[i] * y[i] * k; }
#pragma unroll
        for (int r = 0; r < 4; ++r) {
            float gb[8], o[8]; unpack8(gbv[r], gb);
#pragma unroll
            for (int i = 0; i < 8; ++i) { const float w0 = wv[i >> 2][i & 3], w1 = wv[2 + (i >> 2)][i & 3], w2 = wv[4 + (i >> 2)][i & 3]; o[i] = gb[i] * (w0 * u[r][i] + w1 * u[r + 1][i] + w2 * u[r + 2][i]); }
            u32x4 w; w.x = cvt_pk_bf16(o[0], o[1]); w.y = cvt_pk_bf16(o[2], o[3]); w.z = cvt_pk_bf16(o[4], o[5]); w.w = cvt_pk_bf16(o[6], o[7]);
            *(u32x4*)(mixin + (size_t)(m0 + r) * D + 1024 + c0) = w;
        }
        if (t0 == LSEQ - 4) {
#pragma unroll
            for (int r = 0; r < 2; ++r) { float* co = p.out + O_CP + (((size_t)l * NBATCH + b) * 2 + r) * CDIM + c0;
                *(f32x4*)co = (f32x4){u[4 + r][0], u[4 + r][1], u[4 + r][2], u[4 + r][3]}; *(f32x4*)(co + 4) = (f32x4){u[4 + r][4], u[4 + r][5], u[4 + r][6], u[4 + r][7]}; }
        }
    }
}

__device__ __forceinline__ void kv_prompt_row(int l, int idx, const Params& p, const bf16_t* __restrict__ z, int lane) {
    const int b = idx >> 7, w = idx & 127;
    const bf16_t* zr = z + (size_t)(b * LSEQ + (LSEQ - WIN) + w) * INDIM;
    const u32x2 kv = *(const u32x2*)(zr + ZK + 4 * lane), vv = *(const u32x2*)(zr + ZV + 4 * lane);
    const size_t o = (((size_t)l * NBATCH + b) * WIN + w) * 256 + 4 * lane;
    *(f32x4*)(p.out + O_KP + o) = (f32x4){bf_lo(kv.x), bf_hi(kv.x), bf_lo(kv.y), bf_hi(kv.y)};
    *(f32x4*)(p.out + O_VP + o) = (f32x4){bf_lo(vv.x), bf_hi(vv.x), bf_lo(vv.y), bf_hi(vv.y)};
}
__device__ __forceinline__ void kv_sample_row(int l, int idx, const Params& p, const bf16_t* __restrict__ z, int lane) {
    const int b = idx >> 7, w = idx & 127;
    const size_t o = (((size_t)l * DB + b) * WIN + w) * 256 + 4 * lane;
    f32x4 kq, vq;
    if (w < WIN - 1) { kq = *(const f32x4*)(p.cache_k + o + 256); vq = *(const f32x4*)(p.cache_v + o + 256); }
    else { const bf16_t* zr = z + (size_t)(MPROMPT + b) * INDIM; const u32x2 kv = *(const u32x2*)(zr + ZK + 4 * lane), vv = *(const u32x2*)(zr + ZV + 4 * lane);
        kq = (f32x4){bf_lo(kv.x), bf_hi(kv.x), bf_lo(kv.y), bf_hi(kv.y)}; vq = (f32x4){bf_lo(vv.x), bf_hi(vv.x), bf_lo(vv.y), bf_hi(vv.y)}; }
    *(f32x4*)(p.out + O_KS + o) = kq; *(f32x4*)(p.out + O_VS + o) = vq;
}

__device__ __forceinline__ void kv_sample_row2(int l, int i0, int i1, const Params& p, const bf16_t* __restrict__ z, int lane) {
    f32x4 kq[2], vq[2]; size_t o[2]; const int idx[2] = {i0, i1};
#pragma unroll
    for (int e = 0; e < 2; ++e) {
        const int b = idx[e] >> 7, w = idx[e] & 127;
        o[e] = (((size_t)l * DB + b) * WIN + w) * 256 + 4 * lane;
        if (w < WIN - 1) { kq[e] = __builtin_nontemporal_load((const f32x4*)(p.cache_k + o[e] + 256)); vq[e] = __builtin_nontemporal_load((const f32x4*)(p.cache_v + o[e] + 256)); }
        else { const bf16_t* zr = z + (size_t)(MPROMPT + b) * INDIM; const u32x2 kv = *(const u32x2*)(zr + ZK + 4 * lane), vv = *(const u32x2*)(zr + ZV + 4 * lane);
            kq[e] = (f32x4){bf_lo(kv.x), bf_hi(kv.x), bf_lo(kv.y), bf_hi(kv.y)}; vq[e] = (f32x4){bf_lo(vv.x), bf_hi(vv.x), bf_lo(vv.y), bf_hi(vv.y)}; }
    }
#pragma unroll
    for (int e = 0; e < 2; ++e) { __builtin_nontemporal_store(kq[e], (f32x4*)(p.out + O_KS + o[e])); __builtin_nontemporal_store(vq[e], (f32x4*)(p.out + O_VS + o[e])); }
}

__device__ __forceinline__ void filler_cache_copy(const Params& p, int l, int nwg, int wid, int lane) {
    const int G = gridDim.x, r = nwg % G, c = blockIdx.x;
    int worker, nw;
    if (r == 0) { worker = c * 8 + wid; nw = G * 8; } else if (c >= r) { worker = (c - r) * 8 + wid; nw = (G - r) * 8; } else return;
    for (int i = worker; i < DB * WIN / 2; i += nw) {
        const int i1 = i + DB * WIN / 2;
        if ((i & 127) != 127) kv_sample_row2(l, i, i1, p, (const bf16_t*)(p.ws + WS_ZACT), lane);
    }
}

constexpr int NU_ATT = NBATCH * 4 * 16;

__device__ __forceinline__ void mixer_phase(const Params& p, int l, LAS unsigned char* lds, int tid, int wid, int lane, unsigned long long& tacc_, unsigned long long& t0_) {
    const bf16_t* z = (const bf16_t*)(p.ws + WS_ZACT); bf16_t* mixin = (bf16_t*)(p.ws + WS_MIXIN);
    TB(9);
    for (int u = blockIdx.x; u < NU_ATT; u += gridDim.x) { const int qt = u & 15, bk = u >> 4; attn_prompt_unit(lds, bk >> 2, bk & 3, qt, z, mixin, p.sinks + l * NHEADS, tid, wid, lane); }
    TE(9);
    TB(10);
    const int gw = blockIdx.x * 8 + wid, NGW = gridDim.x * 8;
    if (gw < MPROMPT / 4) conv_job4(l, 4 * gw, p, z, mixin, lane);
    for (int j = NGW + (gw >> 7); j < MPROMPT / 4 && (gw & 127) == 5; j += NGW >> 7) conv_job4(l, 4 * j, p, z, mixin, lane);
    if ((gw & 63) == 33 && (gw >> 6) < DB) conv_row(l, MPROMPT + (gw >> 6), p, z, mixin, lane);
    if ((gw & 3) == 0 && (gw >> 2) < DB * NHEADS) { const int job = gw >> 2; attn_sample_wave(lds, l, job >> 4, job & 15, p, z, mixin, wid, lane); }
    for (int i = (int)NGW - 1 - gw; i < NBATCH * WIN; i += NGW) kv_prompt_row(l, i, p, z, lane);
    if ((gw & 63) == 34 && (gw >> 6) < DB) kv_sample_row(l, (gw >> 6) * WIN + (WIN - 1), p, z, lane);
    TE(10);
}

__global__ void __launch_bounds__(512, 2) hymba_fwd(Params p) {
    extern __shared__ __attribute__((aligned(16))) unsigned char lds_raw[];
    LAS unsigned char* lds = (LAS unsigned char*)lds_raw;
    cg::grid_group grid = cg::this_grid();
    const int tid = threadIdx.x, lane = tid & 63, wid = __builtin_amdgcn_readfirstlane(tid >> 6);

    unsigned* barw = (unsigned*)(p.ws + WS_BAR);
    unsigned* cntw = (unsigned*)(p.ws + WS_CNT);
    volatile LAS unsigned* xst = (volatile LAS unsigned*)(lds + MISC_OFF);
    if (tid < 2) xst[tid] = 0u;
    __syncthreads();
    const XcdBarrier xb = xcd_barrier_post(barw, xst);
    {
        LAS float* biasL = (LAS float*)(lds + BIAS_OFF);
        for (int i = tid; i < NHEADS * BIAS_STRIDE; i += 512) {
            const int h = i / BIAS_STRIDE, d = i % BIAS_STRIDE - BIAS_PAD;
            float v = -INFINITY;
            if (d >= 0 && d <= WIN) {
                int bkt;
                if (d < 16) bkt = d;
                else { const float df = (float)d; bkt = 16 + (int)(logf(df / 16.f) / logf(8.f) * 16.f); bkt = bkt > 31 ? 31 : bkt; }
                v = p.rel_bias[bkt * NHEADS + h];
            }
            biasL[i] = v;
        }
    }
    unsigned long long tacc_ = 0, t0_ = 0;
    TB(0);
    for (int rep = 0; rep < REP_PRO; ++rep) prologue(p, lds, wid, lane);
    TE(0);
    if (p.ws == nullptr) grid.sync();
    GSYNC();

    bf16_t* ZACT = (bf16_t*)(p.ws + WS_ZACT); bf16_t* MIXIN = (bf16_t*)(p.ws + WS_MIXIN); bf16_t* MIXB = (bf16_t*)(p.ws + WS_MIXB); bf16_t* MIXB1 = (bf16_t*)(p.ws + WS_MIXB1);
    const int vcu = (gridDim.x % 8 == 0) ? (int)((blockIdx.x % 8) * (gridDim.x / 8) + blockIdx.x / 8) : (int)blockIdx.x;
    const int skw = (gridDim.x == 256) ? ((vcu & 7) * 32 + (vcu >> 5) * 4 + ((vcu & 31) >> 3)) : vcu;
    const bf16_t* HB = (const bf16_t*)(p.ws + WS_HB); const float* RS = (const float*)(p.ws + WS_RS);
#pragma unroll 1
    for (int l = 0; l < DEPTH; ++l) {
        TB(1);
        {
            pg8::Gemm g{HB, (const bf16_t*)(p.ws + WS_WIN + l * SZ_WIN), MP, INDIM, D}; pg8::Epi<0> E{ZACT, INDIM, RS, ZACT};
            pg8::StaticOrder S; S.init(MP, INDIM, D, (int)gridDim.x, (int)blockIdx.x);
            for (int rep = 0; rep < REP_GIN; ++rep) pg8::gemm_phase<D, pg8::Epi<0>, pg8::StaticOrder>(lds, g, S, E);
            for (int rep = 0; rep < REP_FILL; ++rep) { int t2 = threadIdx.x; asm volatile("" : "+v"(t2)); const int w2 = __builtin_amdgcn_readfirstlane(t2 >> 6), l2 = t2 & 63;
                filler(p, l, I_IN, I_LAYER - I_DN, (MP / 256) * (INDIM / 256), lds, w2, l2);
                if (l + 1 < DEPTH) filler(p, l + 1, 0, I_IN / 2, (MP / 256) * (INDIM / 256), lds, w2, l2);
                filler_cache_copy(p, l, (MP / 256) * (INDIM / 256), w2, l2); }
        }
        TE(1);
        GSYNC();
        TB(2);
#ifndef NO_MIX
        for (int rep = 0; rep < REP_MIX; ++rep) { int t2 = threadIdx.x; asm volatile("" : "+v"(t2)); mixer_phase(p, l, lds, t2, __builtin_amdgcn_readfirstlane(t2 >> 6), t2 & 63, tacc_, t0_); }
#endif
        TE(2);
        GSYNC();
        TB(3);
        {
            pg8::Gemm g{MIXIN, (const bf16_t*)(p.ws + WS_WOUT + l * SZ_WOUT), MP, D, D}; pg8::Epi<0> E{MIXB, D, nullptr, MIXB1};
            pg8::StreamKOrder<D / 128> S; S.init((int)gridDim.x, skw);
            for (int rep = 0; rep < REP_GOUT; ++rep) pg8::gemm_phase<D, pg8::Epi<0>, pg8::StreamKOrder<D / 128>>(lds, g, S, E);
            TE(3);
            TB(4);
            { int t2 = threadIdx.x; asm volatile("" : "+v"(t2)); sk_postnorm<D / 128>(p, S, cntw + (size_t)((l * 2 + 0) * 33) * 16, p.n_post_mix + l * D, false, vcu, t2, __builtin_amdgcn_readfirstlane(t2 >> 6), t2 & 63, tacc_, t0_); }
        }
        TE(4);
        GSYNC();
        TB(5);
        {
            pg8::Gemm g{HB, (const bf16_t*)(p.ws + WS_WGU + l * SZ_WGU), MP, NGU, D}; pg8::Epi<1> E{ZACT, DFF, RS, ZACT};
            pg8::StaticOrder S; S.init(MP, NGU, D, (int)gridDim.x, (int)blockIdx.x);
            for (int rep = 0; rep < REP_GGU; ++rep) pg8::gemm_phase<D, pg8::Epi<1>, pg8::StaticOrder>(lds, g, S, E);
            for (int rep = 0; rep < REP_FILL; ++rep) { int t2 = threadIdx.x; asm volatile("" : "+v"(t2)); const int w2 = __builtin_amdgcn_readfirstlane(t2 >> 6), l2 = t2 & 63;
                filler(p, l, I_LAYER - I_DN, I_LAYER, (MP / 256) * (NGU / 256), lds, w2, l2);
                if (l + 1 < DEPTH) filler(p, l + 1, I_IN / 2, I_IN, (MP / 256) * (NGU / 256), lds, w2, l2); }
        }
        TE(5);
        GSYNC();
        TB(6);
        {
            pg8::Gemm g{ZACT, (const bf16_t*)(p.ws + WS_WDN + l * SZ_WDN), MP, D, DFF}; pg8::Epi<0> E{MIXB, D, nullptr, MIXB1};
            pg8::StreamKOrder<DFF / 128> S; S.init((int)gridDim.x, skw);
            for (int rep = 0; rep < REP_GDN; ++rep) pg8::gemm_phase<DFF, pg8::Epi<0>, pg8::StreamKOrder<DFF / 128>>(lds, g, S, E);
            TE(6);
            TB(7);
            { int t2 = threadIdx.x; asm volatile("" : "+v"(t2)); sk_postnorm<DFF / 128>(p, S, cntw + (size_t)((l * 2 + 1) * 33) * 16, p.n_post_ffn + l * D, l == DEPTH - 1, vcu, t2, __builtin_amdgcn_readfirstlane(t2 >> 6), t2 & 63, tacc_, t0_); }
        }
        TE(7);
        if (l != DEPTH - 1) GSYNC();
    }
    if (TMASK != 0 && blockIdx.x == TBLK) { const unsigned long long tend = __builtin_amdgcn_s_memrealtime() + (unsigned long long)TMULT * tacc_; while (__builtin_amdgcn_s_memrealtime() < tend) __builtin_amdgcn_s_sleep(8); }
}

extern "C" void kernel_launch(void* const* d_in, const int* in_sizes, int n_in, void* d_out, int out_size, void* d_ws, size_t ws_size, hipStream_t stream) {
    static int grid_blocks = 0;
    if (grid_blocks == 0) {
        if (n_in != 18 || ws_size < WS_END) { fprintf(stderr, "kernel_launch: unexpected inputs (n_in %d, ws %zu, need %zu)\n", n_in, ws_size, (size_t)WS_END); grid_blocks = -1; return; }
        int dev = 0, cus = 0, per_cu = 0;
        hipGetDevice(&dev);
        hipDeviceGetAttribute(&cus, hipDeviceAttributeMultiprocessorCount, dev);
        hipFuncSetAttribute((const void*)hymba_fwd, hipFuncAttributeMaxDynamicSharedMemorySize, LDS_BYTES);
        hipOccupancyMaxActiveBlocksPerMultiprocessor(&per_cu, (const void*)hymba_fwd, 512, LDS_BYTES);
        if (per_cu < 1) per_cu = 1;
        grid_blocks = cus * per_cu;
    }
    if (grid_blocks < 0) return;
    if (hipMemsetAsync((char*)d_ws + WS_BAR, 0, WS_END - WS_BAR, stream) != hipSuccess) { fprintf(stderr, "kernel_launch: memset of the barrier words failed\n"); return; }
    Params p{};
    const float** pp = (const float**)&p;
    for (int i = 0; i < 18; ++i) pp[i] = (const float*)d_in[i];
    p.out = (float*)d_out; p.ws = (unsigned char*)d_ws;
    void* args[] = {&p};
    hipError_t e = hipLaunchCooperativeKernel((const void*)hymba_fwd, dim3(grid_blocks), dim3(512), args, LDS_BYTES, stream);
    if (e != hipSuccess) fprintf(stderr, "cooperative launch failed: %s (grid %d)\n", hipGetErrorString(e), grid_blocks);
}
```
